# Optimizing an MI355X kernel written in HIP

```python
import math
import jax, jax.numpy as jnp
from jax import lax
import numpy as np

D_MODEL = 1024
BATCH = 16
SEQ = 2048
DEPTH = 1

CHUNK = 64
EPS = 1e-6

MLA_HEADS = 8
MLA_Q_RANK = 384
MLA_KV_RANK = 256
MLA_NOPE = 64
MLA_ROPE = 32
MLA_V = 64
MLA_QK = MLA_NOPE + MLA_ROPE
ROPE_THETA = 10000.0
Q_BLOCK = 128

RWKV_HEADS = 8
RWKV_HEAD = 64
RWKV_DIM = RWKV_HEADS * RWKV_HEAD
W_LORA = 64
A_LORA = 64
G_LORA = 128
LN_X_EPS = 64e-5

MIX_WIDTH = MLA_HEADS * MLA_V + RWKV_DIM
MLA_COLS = MLA_Q_RANK + MLA_KV_RANK + MLA_ROPE
RWKV_COLS = 3 * RWKV_DIM + W_LORA + A_LORA + G_LORA
IN_COLS = MLA_COLS + RWKV_COLS
MLA_SPLITS = (MLA_Q_RANK, MLA_Q_RANK + MLA_KV_RANK)
RWKV_SPLITS = (RWKV_DIM, 2 * RWKV_DIM, 3 * RWKV_DIM, 3 * RWKV_DIM + W_LORA, 3 * RWKV_DIM + W_LORA + A_LORA)

PEER_HEADS = 8
N_KEYS = 128
N_EXPERTS = N_KEYS * N_KEYS
PEER_DQ = 256
PEER_DHALF = PEER_DQ // 2
PEER_TOPK = 16
TOK_BLOCK = 128

kernel_name = "hybrid_mla_rwkv7_peer_block"


def rms_norm(x, g, eps=EPS):
    xf = x.astype(jnp.float32)
    y = xf * lax.rsqrt(jnp.mean(xf * xf, axis=-1, keepdims=True) + eps)
    return (y * g.astype(jnp.float32)).astype(x.dtype)


def apply_rope(t, positions):
    half = MLA_ROPE // 2
    inv = ROPE_THETA ** (-jnp.arange(half, dtype=jnp.float32) / half)
    ang = positions.astype(jnp.float32)[..., None] * inv
    cos = jnp.cos(ang)[:, :, None, :]
    sin = jnp.sin(ang)[:, :, None, :]
    tf = t.astype(jnp.float32)
    t1, t2 = tf[..., :half], tf[..., half:]
    out = jnp.concatenate([t1 * cos - t2 * sin, t1 * sin + t2 * cos], axis=-1)
    return out.astype(t.dtype)


def mla_group(p_mla, positions, g_cq, g_ckv, w_uq, w_uk, w_uv, g_qnorm, g_knorm, g_attn_out):
    B, S, _ = p_mla.shape
    c_q, c_kv, k_rope = jnp.split(p_mla, MLA_SPLITS, axis=-1)
    q = (rms_norm(c_q, g_cq) @ w_uq).reshape(B, S, MLA_HEADS, MLA_QK)
    c_kv = rms_norm(c_kv, g_ckv)
    k_nope = (c_kv @ w_uk).reshape(B, S, MLA_HEADS, MLA_NOPE)
    v = (c_kv @ w_uv).reshape(B, S, MLA_HEADS, MLA_V)
    k = jnp.concatenate([k_nope, jnp.broadcast_to(k_rope[:, :, None, :], (B, S, MLA_HEADS, MLA_ROPE))], axis=-1)
    q = rms_norm(q, g_qnorm)
    k = rms_norm(k, g_knorm)
    q = jnp.concatenate([q[..., :MLA_NOPE], apply_rope(q[..., MLA_NOPE:], positions)], axis=-1)
    k = jnp.concatenate([k[..., :MLA_NOPE], apply_rope(k[..., MLA_NOPE:], positions)], axis=-1)
    scale = MLA_QK ** -0.5
    n_blk = S // Q_BLOCK
    q_blocks = q.reshape(B, n_blk, Q_BLOCK, MLA_HEADS, MLA_QK).transpose(1, 0, 2, 3, 4)
    key_chunk = jnp.arange(S) // CHUNK

    def attend(args):
        qb, bi = args
        q_chunk = (bi * Q_BLOCK + jnp.arange(Q_BLOCK)) // CHUNK
        s = jnp.einsum('bqhd,bkhd->bhqk', qb, k).astype(jnp.float32) * scale
        mask = key_chunk[None, :] <= q_chunk[:, None]
        s = jnp.where(mask[None, None], s, -jnp.inf)
        pr = jax.nn.softmax(s, axis=-1).astype(v.dtype)
        return jnp.einsum('bhqk,bkhd->bqhd', pr, v)

    o = lax.map(attend, (q_blocks, jnp.arange(n_blk)))
    o = o.transpose(1, 0, 2, 3, 4).reshape(B, S, MLA_HEADS, MLA_V)
    o = rms_norm(o, g_attn_out.reshape(MLA_HEADS, MLA_V))
    return o.reshape(B, S, MLA_HEADS * MLA_V)


def rwkv7_step(state, inp):
    r_t, w_t, k_t, v_t, kk_t, a_t = inp
    sk = jnp.einsum('bhij,bhj->bhi', state, kk_t)
    state = (state * w_t[:, :, None, :]
             - sk[..., None] * (kk_t * a_t)[:, :, None, :]
             + v_t[..., None] * k_t[:, :, None, :])
    y = jnp.einsum('bhij,bhj->bhi', state, r_t)
    return state, y


def rwkv7_group(p_rwkv, rwkv_mu, w0, w2, a0, a2, g2, k_k, k_a, r_k, ln_x_w, ln_x_b):
    B, S, _ = p_rwkv.shape
    prev = jnp.pad(p_rwkv, ((0, 0), (1, 0), (0, 0)))[:, :S]
    p = p_rwkv + (prev - p_rwkv) * rwkv_mu
    r, k, v, wl, al, gl = jnp.split(p, RWKV_SPLITS, axis=-1)
    w = -jax.nn.softplus(-(w0 + jnp.tanh(wl) @ w2)) - 0.5
    decay = jnp.exp(-jnp.exp(w.astype(jnp.float32)))
    a = jax.nn.sigmoid(a0 + al @ a2)
    g = jax.nn.sigmoid(gl) @ g2
    heads = lambda t: t.astype(jnp.float32).reshape(B, S, RWKV_HEADS, RWKV_HEAD)
    kk = heads(k * k_k)
    kk = kk / jnp.maximum(jnp.sqrt(jnp.sum(kk * kk, axis=-1, keepdims=True)), 1e-12)
    k = k * (1.0 + (a - 1.0) * k_a)
    r_h, k_h, v_h, a_h, w_h = heads(r), heads(k), heads(v), heads(a), heads(decay)
    xs = tuple(jnp.moveaxis(t, 1, 0) for t in (r_h, w_h, k_h, v_h, kk, a_h))
    state0 = jnp.zeros((B, RWKV_HEADS, RWKV_HEAD, RWKV_HEAD), jnp.float32)
    _, y = lax.scan(rwkv7_step, state0, xs)
    y = jnp.moveaxis(y, 0, 1)
    mu = jnp.mean(y, axis=-1, keepdims=True)
    var = jnp.mean(jnp.square(y - mu), axis=-1, keepdims=True)
    y = ((y - mu) * lax.rsqrt(var + LN_X_EPS) * ln_x_w.astype(jnp.float32).reshape(RWKV_HEADS, RWKV_HEAD)
         + ln_x_b.astype(jnp.float32).reshape(RWKV_HEADS, RWKV_HEAD))
    bonus = jnp.sum(r_h * k_h * r_k.astype(jnp.float32), axis=-1, keepdims=True) * v_h
    y = (y + bonus).reshape(B, S, RWKV_DIM).astype(p_rwkv.dtype)
    return y * g


def peer_ffn(h, w_pq, sub_keys, expert_u, expert_v):
    B, S, D = h.shape
    hb_all = h.reshape(B * S // TOK_BLOCK, TOK_BLOCK, D)

    def block(hb):
        q = (hb @ w_pq).reshape(TOK_BLOCK, PEER_HEADS, 2, PEER_DHALF)
        s = jnp.einsum('thpd,hpnd->thpn', q, sub_keys).astype(jnp.float32)
        s1, i1 = lax.top_k(s[:, :, 0], PEER_TOPK)
        s2, i2 = lax.top_k(s[:, :, 1], PEER_TOPK)
        cand_s = (s1[..., :, None] + s2[..., None, :]).reshape(TOK_BLOCK, PEER_HEADS, PEER_TOPK * PEER_TOPK)
        cand_i = (i1[..., :, None] * N_KEYS + i2[..., None, :]).reshape(TOK_BLOCK, PEER_HEADS, PEER_TOPK * PEER_TOPK)
        top_s, pos = lax.top_k(cand_s, PEER_TOPK)
        idx = jnp.take_along_axis(cand_i, pos, axis=-1)
        gate = jax.nn.softmax(top_s, axis=-1).astype(hb.dtype)
        u = expert_u[idx]
        act = jax.nn.gelu(jnp.einsum('thkd,td->thk', u, hb), approximate=False)
        vv = expert_v[idx]
        return jnp.einsum('thk,thkd->td', gate * act, vv)

    out = lax.map(block, hb_all)
    return out.reshape(B, S, D)


def setup_inputs(seed: int = 0) -> dict:
    key = jax.random.key(seed)
    ks = iter(jax.random.split(key, 40))
    f32 = jnp.float32
    nrm = lambda shape, scale: jax.random.normal(next(ks), shape, f32) * scale
    gain = lambda shape: 1.0 + 0.02 * jax.random.normal(next(ks), shape, f32)
    L = DEPTH
    x = jax.random.normal(next(ks), (BATCH, SEQ, D_MODEL), f32)
    offset = jax.random.randint(next(ks), (BATCH, 1), 0, 64, dtype=jnp.int32) * CHUNK
    positions = offset + jnp.arange(SEQ, dtype=jnp.int32)[None, :]
    return {
        'x': x,
        'positions': positions,
        'g_mix': gain((L, D_MODEL)),
        'w_in': nrm((L, D_MODEL, IN_COLS), D_MODEL ** -0.5),
        'rwkv_mu': jax.random.uniform(next(ks), (L, RWKV_COLS), f32),
        'g_cq': gain((L, MLA_Q_RANK)),
        'g_ckv': gain((L, MLA_KV_RANK)),
        'w_uq': nrm((L, MLA_Q_RANK, MLA_HEADS * MLA_QK), MLA_Q_RANK ** -0.5),
        'w_uk': nrm((L, MLA_KV_RANK, MLA_HEADS * MLA_NOPE), MLA_KV_RANK ** -0.5),
        'w_uv': nrm((L, MLA_KV_RANK, MLA_HEADS * MLA_V), MLA_KV_RANK ** -0.5),
        'g_qnorm': gain((L, MLA_QK)),
        'g_knorm': gain((L, MLA_QK)),
        'g_attn_out': gain((L, MLA_HEADS * MLA_V)),
        'w0': -6.0 + 5.0 * jax.random.uniform(next(ks), (L, RWKV_DIM), f32),
        'w2': nrm((L, W_LORA, RWKV_DIM), 0.1),
        'a0': nrm((L, RWKV_DIM), 0.1),
        'a2': nrm((L, A_LORA, RWKV_DIM), 0.1),
        'g2': nrm((L, G_LORA, RWKV_DIM), G_LORA ** -0.5),
        'k_k': 0.85 + nrm((L, RWKV_DIM), 0.05),
        'k_a': 1.0 + nrm((L, RWKV_DIM), 0.05),
        'r_k': nrm((L, RWKV_HEADS, RWKV_HEAD), 0.1),
        'ln_x_w': gain((L, RWKV_DIM)),
        'ln_x_b': nrm((L, RWKV_DIM), 0.02),
        'w_o': nrm((L, MIX_WIDTH, D_MODEL), MIX_WIDTH ** -0.5),
        'g_ffn': gain((L, D_MODEL)),
        'w_pq': nrm((L, D_MODEL, PEER_HEADS * PEER_DQ), D_MODEL ** -0.5),
        'sub_keys': nrm((L, PEER_HEADS, 2, N_KEYS, PEER_DHALF), PEER_DHALF ** -0.5),
        'expert_u': nrm((L, N_EXPERTS, D_MODEL), D_MODEL ** -0.5),
        'expert_v': nrm((L, N_EXPERTS, D_MODEL), PEER_HEADS ** -0.5),
    }


def reference(x, positions, g_mix, w_in, rwkv_mu, g_cq, g_ckv, w_uq, w_uk, w_uv, g_qnorm, g_knorm,
              g_attn_out, w0, w2, a0, a2, g2, k_k, k_a, r_k, ln_x_w, ln_x_b, w_o, g_ffn, w_pq,
              sub_keys, expert_u, expert_v):
    for l in range(DEPTH):
        h = rms_norm(x, g_mix[l])
        p = h @ w_in[l]
        y_a = mla_group(p[..., :MLA_COLS], positions, g_cq[l], g_ckv[l], w_uq[l], w_uk[l], w_uv[l],
                        g_qnorm[l], g_knorm[l], g_attn_out[l])
        y_b = rwkv7_group(p[..., MLA_COLS:], rwkv_mu[l], w0[l], w2[l], a0[l], a2[l], g2[l], k_k[l], k_a[l],
                          r_k[l], ln_x_w[l], ln_x_b[l])
        x = x + jnp.concatenate([y_a, y_b], axis=-1) @ w_o[l]
        x = x + peer_ffn(rms_norm(x, g_ffn[l]), w_pq[l], sub_keys[l], expert_u[l], expert_v[l])
    return x
```

```cpp
#include <hip/hip_runtime.h>
#include <hip/hip_cooperative_groups.h>
#include <cstdio>
#include <cstdint>
namespace cg = cooperative_groups;

#ifndef MEGA
#define MEGA 0
#endif

typedef unsigned short u16;
using bf16x8 = __attribute__((ext_vector_type(8))) short;
using s16x4  = __attribute__((ext_vector_type(4))) short;
using f32x4  = __attribute__((ext_vector_type(4))) float;
using f32x16 = __attribute__((ext_vector_type(16))) float;
#define DI __device__ __forceinline__

constexpr int T = 32768, SEQ = 2048, DM = 1024;
constexpr int INC = 2464, MLAC = 672, RWC = 1792;
constexpr int NTHR = 256;
constexpr float EPS = 1e-6f;

constexpr size_t MiB = 1048576;
constexpr size_t OFF_WINT  = 0;
constexpr size_t OFF_WUQT  = OFF_WINT  + 2560 * 1024 * 2;
constexpr size_t OFF_WUKVT = OFF_WUQT  + 768 * 384 * 2;
constexpr size_t OFF_W2T   = OFF_WUKVT + 1024 * 256 * 2;
constexpr size_t OFF_A2T   = OFF_W2T   + 512 * 64 * 2;
constexpr size_t OFF_G2T   = OFF_A2T   + 512 * 64 * 2;
constexpr size_t OFF_WOT   = OFF_G2T   + 512 * 128 * 2;
constexpr size_t OFF_WPQT  = OFF_WOT   + 1024 * 1024 * 2;
constexpr size_t OFF_SUBK  = OFF_WPQT  + 2048 * 1024 * 2;
constexpr size_t OFF_ROPE  = OFF_SUBK  + 16 * 128 * 128 * 2;
constexpr size_t OFF_RSTD1 = OFF_ROPE  + (size_t)T * 32 * 4;
constexpr size_t OFF_RSTDQ = OFF_RSTD1 + (size_t)T * 4;
constexpr size_t OFF_RSTDKV= OFF_RSTDQ + (size_t)T * 4;
constexpr size_t OFF_RSTD2 = OFF_RSTDKV+ (size_t)T * 4;
constexpr size_t OFF_A_END = OFF_RSTD2 + (size_t)T * 4;
static_assert(OFF_A_END <= 20 * MiB, "region A");
constexpr size_t OFF_XB    = 20 * MiB;
constexpr size_t OFF_Y     = OFF_XB;
constexpr size_t OFF_PM    = 84 * MiB;
constexpr size_t OFF_PR    = 126 * MiB;
constexpr size_t OFF_U     = OFF_PR;
constexpr size_t OFF_G     = OFF_PR + 32 * MiB;
constexpr size_t OFF_KK    = OFF_PR + 64 * MiB;
constexpr size_t OFF_KVRAW = 238 * MiB;
constexpr size_t OFF_QRAW  = 302 * MiB;
constexpr size_t OFF_LORAIN= 350 * MiB;
constexpr size_t OFF_YRAW  = 302 * MiB;
constexpr size_t OFF_RS    = 366 * MiB;
constexpr size_t OFF_KS    = 398 * MiB;
constexpr size_t OFF_VS    = 430 * MiB;
constexpr size_t OFF_BB    = 462 * MiB;
constexpr size_t OFF_EU    = 84 * MiB;
constexpr size_t OFF_EV    = 116 * MiB;
constexpr size_t OFF_X2B   = 148 * MiB;
constexpr size_t OFF_QP    = 238 * MiB;
constexpr size_t OFF_IDX   = 366 * MiB;
constexpr size_t OFF_GATE  = 382 * MiB;
constexpr size_t DO_Q = 0, DO_K = (size_t)T * 768 * 2, DO_AA = (size_t)T * 768 * 4;

struct Params {
  const float* x; const int* pos;
  const float *g_mix, *w_in, *rwkv_mu, *g_cq, *g_ckv, *w_uq, *w_uk, *w_uv, *g_qnorm, *g_knorm, *g_attn_out;
  const float *w0, *w2, *a0, *a2, *g2, *k_k, *k_a, *r_k, *ln_x_w, *ln_x_b, *w_o, *g_ffn, *w_pq, *sub_keys, *expert_u, *expert_v;
  float* out; char* ws;
};

DI u16 f2bf(float x) { unsigned u = __float_as_uint(x); u += 0x7fffu + ((u >> 16) & 1u); return (u16)(u >> 16); }
DI float bf2f(u16 h) { return __uint_as_float(((unsigned)h) << 16); }
DI unsigned pack2(float a, float b) { return (unsigned)f2bf(a) | ((unsigned)f2bf(b) << 16); }
DI float bflo(unsigned u) { return __uint_as_float(u << 16); }
DI float bfhi(unsigned u) { return __uint_as_float(u & 0xffff0000u); }
DI float wave_allsum(float v) {
#pragma unroll
  for (int o = 32; o > 0; o >>= 1) v += __shfl_xor(v, o);
  return v;
}
DI float sigmoidf_(float x) { return 1.f / (1.f + __expf(-x)); }

DI void tconv(const float* __restrict__ src, int K, int N, const float* __restrict__ scale, u16* __restrict__ dst,
              int ldd, int noff, int bid, int nblk, float* tile) {
  const int tid = threadIdx.x, tx = tid & 31, ty = tid >> 5;
  const int nbn = N / 32, ntl = (K / 32) * nbn;
  for (int tl = bid; tl < ntl; tl += nblk) {
    const int kb = tl / nbn, nb = tl % nbn;
#pragma unroll
    for (int i = 0; i < 4; ++i) {
      const int k = kb * 32 + ty + 8 * i;
      float v = src[(size_t)k * N + nb * 32 + tx];
      if (scale) v *= scale[k];
      tile[(ty + 8 * i) * 33 + tx] = v;
    }
    __syncthreads();
#pragma unroll
    for (int i = 0; i < 4; ++i) {
      const int n = nb * 32 + ty + 8 * i;
      dst[(size_t)(noff + n) * ldd + kb * 32 + tx] = f2bf(tile[tx * 33 + ty + 8 * i]);
    }
    __syncthreads();
  }
}

DI void phase_prep(const Params& p, int bid, int nblk, char* smem) {
  float* tile = (float*)smem;
  char* ws = p.ws;
  const int tid = threadIdx.x;
  tconv(p.w_in, 1024, INC, p.g_mix, (u16*)(ws + OFF_WINT), 1024, 0, bid, nblk, tile);
  for (int i = bid * NTHR + tid; i < 96 * 1024; i += nblk * NTHR) ((u16*)(ws + OFF_WINT))[2464 * 1024 + i] = 0;
  tconv(p.w_uq, 384, 768, p.g_cq, (u16*)(ws + OFF_WUQT), 384, 0, bid, nblk, tile);
  tconv(p.w_uk, 256, 512, p.g_ckv, (u16*)(ws + OFF_WUKVT), 256, 0, bid, nblk, tile);
  tconv(p.w_uv, 256, 512, p.g_ckv, (u16*)(ws + OFF_WUKVT), 256, 512, bid, nblk, tile);
  tconv(p.w2, 64, 512, nullptr, (u16*)(ws + OFF_W2T), 64, 0, bid, nblk, tile);
  tconv(p.a2, 64, 512, nullptr, (u16*)(ws + OFF_A2T), 64, 0, bid, nblk, tile);
  tconv(p.g2, 128, 512, nullptr, (u16*)(ws + OFF_G2T), 128, 0, bid, nblk, tile);
  tconv(p.w_o, 1024, 1024, nullptr, (u16*)(ws + OFF_WOT), 1024, 0, bid, nblk, tile);
  tconv(p.w_pq, 1024, 2048, p.g_ffn, (u16*)(ws + OFF_WPQT), 1024, 0, bid, nblk, tile);
  for (int i = bid * NTHR + tid; i < 16 * 128 * 128; i += nblk * NTHR) ((u16*)(ws + OFF_SUBK))[i] = f2bf(p.sub_keys[i]);
  for (int i = bid * NTHR + tid; i < T * 16; i += nblk * NTHR) {
    const int t = i >> 4, j = i & 15;
    const float inv = powf(10000.0f, -(float)j / 16.0f);
    const float ang = (float)p.pos[t] * inv;
    float s, c; sincosf(ang, &s, &c);
    float* rp = (float*)(ws + OFF_ROPE) + (size_t)t * 32;
    rp[j] = c; rp[16 + j] = s;
  }
  const int wid = tid >> 6, lane = tid & 63;
  for (int row = bid * 4 + wid; row < T; row += nblk * 4) {
    const float4* xr = (const float4*)(p.x + (size_t)row * DM);
    uint2* xb = (uint2*)(ws + OFF_XB + (size_t)row * DM * 2);
    float ss = 0.f;
#pragma unroll
    for (int i = 0; i < 4; ++i) {
      const float4 v = xr[lane + 64 * i];
      ss += v.x * v.x + v.y * v.y + v.z * v.z + v.w * v.w;
      xb[lane + 64 * i] = make_uint2(pack2(v.x, v.y), pack2(v.z, v.w));
    }
    ss = wave_allsum(ss);
    if (lane == 0) ((float*)(ws + OFF_RSTD1))[row] = rsqrtf(ss * (1.f / DM) + EPS);
  }
}

template <class Epi>
DI void gemm_tile(const u16* __restrict__ A, int lda, const u16* __restrict__ Bt, int ldb, int K, int m0, int n0,
                  Epi epi, char* smem) {
  u16* SA = (u16*)smem;
  u16* SB = SA + 128 * 32;
  const int tid = threadIdx.x, wid = tid >> 6, lane = tid & 63, wr = wid >> 1, wc = wid & 1, fr = lane & 15, fq = lane >> 4;
  f32x4 acc[4][4];
#pragma unroll
  for (int m = 0; m < 4; ++m)
#pragma unroll
    for (int n = 0; n < 4; ++n) acc[m][n] = f32x4{0.f, 0.f, 0.f, 0.f};
  const int nk = K / 32;
  for (int kt = 0; kt < nk; ++kt) {
#pragma unroll
    for (int i = 0; i < 2; ++i) {
      const int b = tid * 16 + i * 4096, r = b / 64, c = (b % 64) / 2;
      __builtin_amdgcn_global_load_lds((const unsigned*)(A + (size_t)(m0 + r) * lda + kt * 32 + c),
                                       (__attribute__((address_space(3))) unsigned*)((char*)SA + b), 16, 0, 0);
      __builtin_amdgcn_global_load_lds((const unsigned*)(Bt + (size_t)(n0 + r) * ldb + kt * 32 + c),
                                       (__attribute__((address_space(3))) unsigned*)((char*)SB + b), 16, 0, 0);
    }
    asm volatile("s_waitcnt vmcnt(0)" ::: "memory");
    __syncthreads();
    bf16x8 af[4], bfr[4];
#pragma unroll
    for (int m = 0; m < 4; ++m) af[m] = *reinterpret_cast<const bf16x8*>((char*)SA + (wr * 64 + m * 16 + fr) * 64 + fq * 16);
#pragma unroll
    for (int n = 0; n < 4; ++n) bfr[n] = *reinterpret_cast<const bf16x8*>((char*)SB + (wc * 64 + n * 16 + fr) * 64 + fq * 16);
#pragma unroll
    for (int m = 0; m < 4; ++m)
#pragma unroll
      for (int n = 0; n < 4; ++n) acc[m][n] = __builtin_amdgcn_mfma_f32_16x16x32_bf16(af[m], bfr[n], acc[m][n], 0, 0, 0);
    __syncthreads();
  }
#pragma unroll
  for (int m = 0; m < 4; ++m)
#pragma unroll
    for (int n = 0; n < 4; ++n)
#pragma unroll
      for (int j = 0; j < 4; ++j) epi(m0 + wr * 64 + m * 16 + fq * 4 + j, n0 + wc * 64 + n * 16 + fr, acc[m][n][j]);
}

DI void phase_gemm1(const Params& p, int bid, int nblk, char* smem) {
  char* ws = p.ws;
  const u16* A = (const u16*)(ws + OFF_XB);
  const u16* Bt = (const u16*)(ws + OFF_WINT);
  const float* rstd = (const float*)(ws + OFF_RSTD1);
  u16* PM = (u16*)(ws + OFF_PM);
  u16* PR = (u16*)(ws + OFF_PR);
  const int NT = 20;
  for (int tl = bid; tl < 256 * NT; tl += nblk) {
    const int mt = tl / NT, nt = tl % NT;
    gemm_tile(A, 1024, Bt, 1024, 1024, mt * 128, nt * 128,
              [&](int r, int c, float v) {
                if (c < INC) {
                  const u16 o = f2bf(v * rstd[r]);
                  if (c < MLAC) PM[(size_t)r * MLAC + c] = o; else PR[(size_t)r * RWC + (c - MLAC)] = o;
                }
              }, smem);
  }
}

DI void phase_2a(const Params& p, int bid, int nblk, char* smem) {
  char* ws = p.ws;
  const u16* PM = (const u16*)(ws + OFF_PM);
  const u16* PR = (const u16*)(ws + OFF_PR);
  u16* RS = (u16*)(ws + OFF_RS); u16* KS = (u16*)(ws + OFF_KS); u16* VS = (u16*)(ws + OFF_VS);
  u16* LI = (u16*)(ws + OFF_LORAIN);
  float* red = (float*)smem;
  const int tid = threadIdx.x, wid = tid >> 6, lane = tid & 63;
  for (int t = bid; t < T; t += nblk) {
    const u16* pm = PM + (size_t)t * MLAC;
    float q0 = bf2f(pm[tid]); float sq = q0 * q0;
    if (tid < 128) { const float q1 = bf2f(pm[256 + tid]); sq += q1 * q1; }
    const float kv = bf2f(pm[384 + tid]); float skv = kv * kv;
    sq = wave_allsum(sq); skv = wave_allsum(skv);
    if (lane == 0) { red[wid] = sq; red[4 + wid] = skv; }
    __syncthreads();
    if (tid == 0) {
      ((float*)(ws + OFF_RSTDQ))[t] = rsqrtf((red[0] + red[1] + red[2] + red[3]) * (1.f / 384.f) + EPS);
      ((float*)(ws + OFF_RSTDKV))[t] = rsqrtf((red[4] + red[5] + red[6] + red[7]) * (1.f / 256.f) + EPS);
    }
    __syncthreads();
    const bool first = (t % SEQ) == 0;
    const u16* cur = PR + (size_t)t * RWC;
    const u16* prv = cur - RWC;
#pragma unroll
    for (int i = 0; i < 7; ++i) {
      const int c = tid + 256 * i;
      const float cv = bf2f(cur[c]);
      const float pv = first ? 0.f : bf2f(prv[c]);
      const float v = cv + (pv - cv) * p.rwkv_mu[c];
      if (c < 512) RS[(size_t)t * 512 + c] = f2bf(v);
      else if (c < 1024) KS[(size_t)t * 512 + c - 512] = f2bf(v);
      else if (c < 1536) VS[(size_t)t * 512 + c - 1024] = f2bf(v);
      else if (c < 1600) LI[(size_t)t * 256 + c - 1536] = f2bf(tanhf(v));
      else if (c < 1664) LI[(size_t)t * 256 + c - 1536] = f2bf(v);
      else LI[(size_t)t * 256 + c - 1536] = f2bf(sigmoidf_(v));
    }
  }
}

DI void phase_2b(const Params& p, int bid, int nblk, char* smem) {
  char* ws = p.ws;
  const u16* PM = (const u16*)(ws + OFF_PM);
  const u16* LI = (const u16*)(ws + OFF_LORAIN);
  const float* rq = (const float*)(ws + OFF_RSTDQ);
  const float* rkv = (const float*)(ws + OFF_RSTDKV);
  u16* QRAW = (u16*)(ws + OFF_QRAW); u16* KVRAW = (u16*)(ws + OFF_KVRAW);
  u16* U = (u16*)(ws + OFF_U); u16* G = (u16*)(ws + OFF_G);
  u16* AA = (u16*)((char*)p.out + DO_AA);
  const int NT = 26;
  for (int tl = bid; tl < 256 * NT; tl += nblk) {
    const int mt = tl / NT, j = tl % NT, m0 = mt * 128;
    if (j < 6) {
      gemm_tile(PM, MLAC, (const u16*)(ws + OFF_WUQT), 384, 384, m0, j * 128,
                [&](int r, int c, float v) { QRAW[(size_t)r * 768 + c] = f2bf(v * rq[r]); }, smem);
    } else if (j < 14) {
      gemm_tile(PM + 384, MLAC, (const u16*)(ws + OFF_WUKVT), 256, 256, m0, (j - 6) * 128,
                [&](int r, int c, float v) { KVRAW[(size_t)r * 1024 + c] = f2bf(v * rkv[r]); }, smem);
    } else if (j < 18) {
      gemm_tile(LI, 256, (const u16*)(ws + OFF_W2T), 64, 64, m0, (j - 14) * 128,
                [&](int r, int c, float v) {
                  const float sg = sigmoidf_(p.w0[c] + v);
                  U[(size_t)r * 512 + c] = f2bf(-expm1f(-0.6065306597126334f * sg));
                }, smem);
    } else if (j < 22) {
      gemm_tile(LI + 64, 256, (const u16*)(ws + OFF_A2T), 64, 64, m0, (j - 18) * 128,
                [&](int r, int c, float v) { AA[(size_t)r * 512 + c] = f2bf(sigmoidf_(p.a0[c] + v)); }, smem);
    } else {
      gemm_tile(LI + 128, 256, (const u16*)(ws + OFF_G2T), 128, 128, m0, (j - 22) * 128,
                [&](int r, int c, float v) { G[(size_t)r * 512 + c] = f2bf(v); }, smem);
    }
  }
}

DI void phase_2c(const Params& p, int bid, int nblk, char* smem) {
  char* ws = p.ws;
  const u16* PM = (const u16*)(ws + OFF_PM);
  const u16* QRAW = (const u16*)(ws + OFF_QRAW);
  const u16* KVRAW = (const u16*)(ws + OFF_KVRAW);
  u16* Q = (u16*)((char*)p.out + DO_Q); u16* Kd = (u16*)((char*)p.out + DO_K);
  const u16* AA = (const u16*)((char*)p.out + DO_AA);
  u16* KS = (u16*)(ws + OFF_KS); u16* KK = (u16*)(ws + OFF_KK); u16* BB = (u16*)(ws + OFF_BB);
  const float* rope = (const float*)(ws + OFF_ROPE);
  const int tid = threadIdx.x, wid = tid >> 6, lane = tid & 63;
  const float QSCALE = 0.10206207261596575f * 1.4426950408889634f;
  for (int t = bid * 4 + wid; t < T; t += nblk * 4) {
    const int e0 = 2 * lane;
    const bool act = lane < 48;
    const bool isrope = lane >= 32 && lane < 48;
    const bool second = lane >= 40;
    float cs0 = 0.f, cs1 = 0.f, sn0 = 0.f, sn1 = 0.f;
    if (isrope) {
      const int i0 = e0 - (second ? 80 : 64);
      cs0 = rope[(size_t)t * 32 + i0]; cs1 = rope[(size_t)t * 32 + i0 + 1];
      sn0 = rope[(size_t)t * 32 + 16 + i0]; sn1 = rope[(size_t)t * 32 + 16 + i0 + 1];
    }
    float gq0 = 0.f, gq1 = 0.f, gk0 = 0.f, gk1 = 0.f;
    if (act) { gq0 = p.g_qnorm[e0]; gq1 = p.g_qnorm[e0 + 1]; gk0 = p.g_knorm[e0]; gk1 = p.g_knorm[e0 + 1]; }
    for (int h = 0; h < 8; ++h) {
#pragma unroll
      for (int which = 0; which < 2; ++which) {
        float v0 = 0.f, v1 = 0.f;
        if (act) {
          unsigned raw;
          if (which == 0) raw = *(const unsigned*)(QRAW + (size_t)t * 768 + h * 96 + e0);
          else if (e0 < 64) raw = *(const unsigned*)(KVRAW + (size_t)t * 1024 + h * 64 + e0);
          else raw = *(const unsigned*)(PM + (size_t)t * MLAC + 640 + (e0 - 64));
          v0 = bflo(raw); v1 = bfhi(raw);
        }
        const float ss = wave_allsum(v0 * v0 + v1 * v1);
        const float rs = rsqrtf(ss * (1.f / 96.f) + EPS);
        v0 *= rs * (which == 0 ? gq0 : gk0);
        v1 *= rs * (which == 0 ? gq1 : gk1);
        const float o0 = __shfl_xor(v0, 8), o1 = __shfl_xor(v1, 8);
        if (isrope) {
          if (!second) { v0 = v0 * cs0 - o0 * sn0; v1 = v1 * cs1 - o1 * sn1; }
          else { v0 = o0 * sn0 + v0 * cs0; v1 = o1 * sn1 + v1 * cs1; }
        }
        if (act) {
          if (which == 0) *(unsigned*)(Q + (size_t)t * 768 + h * 96 + e0) = pack2(v0 * QSCALE, v1 * QSCALE);
          else *(unsigned*)(Kd + (size_t)t * 768 + h * 96 + e0) = pack2(v0, v1);
        }
      }
    }
    {
      const int c0 = 8 * lane;
      const uint4 kraw = *(const uint4*)(KS + (size_t)t * 512 + c0);
      const uint4 araw = *(const uint4*)(AA + (size_t)t * 512 + c0);
      float kv[8], av[8], kkv[8];
      kv[0] = bflo(kraw.x); kv[1] = bfhi(kraw.x); kv[2] = bflo(kraw.y); kv[3] = bfhi(kraw.y);
      kv[4] = bflo(kraw.z); kv[5] = bfhi(kraw.z); kv[6] = bflo(kraw.w); kv[7] = bfhi(kraw.w);
      av[0] = bflo(araw.x); av[1] = bfhi(araw.x); av[2] = bflo(araw.y); av[3] = bfhi(araw.y);
      av[4] = bflo(araw.z); av[5] = bfhi(araw.z); av[6] = bflo(araw.w); av[7] = bfhi(araw.w);
      float ss = 0.f;
#pragma unroll
      for (int i = 0; i < 8; ++i) { kkv[i] = kv[i] * p.k_k[c0 + i]; ss += kkv[i] * kkv[i]; }
      ss += __shfl_xor(ss, 1); ss += __shfl_xor(ss, 2); ss += __shfl_xor(ss, 4);
      const float inv = 1.f / fmaxf(sqrtf(ss), 1e-12f);
      float kn[8], bb[8], k2[8];
#pragma unroll
      for (int i = 0; i < 8; ++i) {
        kn[i] = kkv[i] * inv;
        bb[i] = kn[i] * av[i];
        k2[i] = kv[i] * (1.f + (av[i] - 1.f) * p.k_a[c0 + i]);
      }
      *(uint4*)(KK + (size_t)t * 512 + c0) = make_uint4(pack2(kn[0], kn[1]), pack2(kn[2], kn[3]), pack2(kn[4], kn[5]), pack2(kn[6], kn[7]));
      *(uint4*)(BB + (size_t)t * 512 + c0) = make_uint4(pack2(bb[0], bb[1]), pack2(bb[2], bb[3]), pack2(bb[4], bb[5]), pack2(bb[6], bb[7]));
      *(uint4*)(KS + (size_t)t * 512 + c0) = make_uint4(pack2(k2[0], k2[1]), pack2(k2[2], k2[3]), pack2(k2[4], k2[5]), pack2(k2[6], k2[7]));
    }
  }
}

DI s16x4 tr_read(unsigned lds_addr) {
  s16x4 r;
  asm volatile("ds_read_b64_tr_b16 %0, %1\n\ts_waitcnt lgkmcnt(0)" : "=&v"(r) : "v"(lds_addr) : "memory");
  return r;
}
#define MFMA32(a, b, c) __builtin_amdgcn_mfma_f32_32x32x16_bf16((a), (b), (c), 0, 0, 0)

constexpr int KLD = 208, VLD = 192;
constexpr int ATT_KOFF = 0, ATT_VOFF = 64 * KLD;
DI void phase_attn(const Params& p, int bid, int nblk, char* smem) {
  char* ws = p.ws;
  const u16* Q = (const u16*)((char*)p.out + DO_Q);
  const u16* Kd = (const u16*)((char*)p.out + DO_K);
  const u16* KVRAW = (const u16*)(ws + OFF_KVRAW);
  u16* Y = (u16*)(ws + OFF_Y);
  const int tid = threadIdx.x, w = tid >> 6, lane = tid & 63, r = lane & 31, hh = lane >> 5;
  const unsigned lds_base = (unsigned)(size_t)smem;
  for (int it = bid; it < 2048; it += nblk) {
    const int rd = it >> 9, pos = it & 511, g = pos >> 7, bh = pos & 127;
    const int m = rd == 0 ? 15 - g : rd == 1 ? 8 + g : rd == 2 ? 7 - g : g;
    const int b = bh >> 3, h = bh & 7;
    const int t0 = b * SEQ + 128 * m;
    const int cw = 2 * m + (w >> 1);
    const int tq = t0 + 32 * w + r;
    bf16x8 qf[6];
#pragma unroll
    for (int ks = 0; ks < 6; ++ks) qf[ks] = *reinterpret_cast<const bf16x8*>(Q + (size_t)tq * 768 + h * 96 + 16 * ks + 8 * hh);
    f32x16 O0, O1;
#pragma unroll
    for (int i = 0; i < 16; ++i) { O0[i] = 0.f; O1[i] = 0.f; }
    float mrun = -1e30f, lrun = 0.f;
    const int nkt = 2 * m + 2;
    for (int kt = 0; kt < nkt; ++kt) {
      __syncthreads();
      const int tk0 = b * SEQ + 64 * kt;
#pragma unroll
      for (int i = 0; i < 3; ++i) {
        const int c = tid + 256 * i, row = c / 12, cc = c % 12;
        const uint4 v = *(const uint4*)(Kd + (size_t)(tk0 + row) * 768 + h * 96 + cc * 8);
        *(uint4*)(smem + ATT_KOFF + row * KLD + cc * 16) = v;
      }
#pragma unroll
      for (int i = 0; i < 2; ++i) {
        const int c = tid + 256 * i, row = c >> 3, cc = c & 7;
        const uint4 v = *(const uint4*)(KVRAW + (size_t)(tk0 + row) * 1024 + 512 + h * 64 + cc * 8);
        *(uint4*)(smem + ATT_VOFF + row * VLD + cc * 16) = v;
      }
      __syncthreads();
      if (kt <= cw) {
        f32x16 X[2];
#pragma unroll
        for (int sub = 0; sub < 2; ++sub) {
#pragma unroll
          for (int i = 0; i < 16; ++i) X[sub][i] = 0.f;
#pragma unroll
          for (int ks = 0; ks < 6; ++ks) {
            const bf16x8 a = *reinterpret_cast<const bf16x8*>(smem + ATT_KOFF + (32 * sub + r) * KLD + (16 * ks + 8 * hh) * 2);
            X[sub] = MFMA32(a, qf[ks], X[sub]);
          }
        }
        float mx = X[0][0];
#pragma unroll
        for (int i = 0; i < 16; ++i) { mx = fmaxf(mx, X[0][i]); mx = fmaxf(mx, X[1][i]); }
        mx = fmaxf(mx, __shfl_xor(mx, 32));
        const float mnew = fmaxf(mrun, mx);
        const float alpha = exp2f(mrun - mnew);
        mrun = mnew;
        float rsum = 0.f;
#pragma unroll
        for (int sub = 0; sub < 2; ++sub)
#pragma unroll
          for (int i = 0; i < 16; ++i) { const float e = exp2f(X[sub][i] - mnew); X[sub][i] = e; rsum += e; }
        lrun = lrun * alpha + rsum;
#pragma unroll
        for (int i = 0; i < 16; ++i) { O0[i] *= alpha; O1[i] *= alpha; }
        const int i16 = lane & 15, q4 = i16 >> 2, p4 = i16 & 3, blk = (lane >> 4) & 1;
#pragma unroll
        for (int sub = 0; sub < 2; ++sub) {
#pragma unroll
          for (int s = 0; s < 2; ++s) {
            bf16x8 pb;
#pragma unroll
            for (int j = 0; j < 8; ++j) pb[j] = (short)f2bf(X[sub][8 * s + j]);
            const unsigned rowlo = 32 * sub + 16 * s + 4 * hh + q4;
#pragma unroll
            for (int dt = 0; dt < 2; ++dt) {
              const unsigned colb = (32 * dt + 16 * blk) * 2 + 8 * p4;
              const s16x4 lo = tr_read(lds_base + ATT_VOFF + rowlo * VLD + colb);
              const s16x4 hi = tr_read(lds_base + ATT_VOFF + (rowlo + 8) * VLD + colb);
              const bf16x8 a = __builtin_shufflevector(lo, hi, 0, 1, 2, 3, 4, 5, 6, 7);
              if (dt == 0) O0 = MFMA32(a, pb, O0); else O1 = MFMA32(a, pb, O1);
            }
          }
        }
      }
    }
    const float ltot = lrun + __shfl_xor(lrun, 32);
    const float inv = 1.f / ltot;
    float ss = 0.f;
#pragma unroll
    for (int i = 0; i < 16; ++i) { O0[i] *= inv; O1[i] *= inv; ss += O0[i] * O0[i] + O1[i] * O1[i]; }
    ss += __shfl_xor(ss, 32);
    const float rs = rsqrtf(ss * (1.f / 64.f) + EPS);
#pragma unroll
    for (int dt = 0; dt < 2; ++dt)
#pragma unroll
      for (int gq = 0; gq < 4; ++gq) {
        const int d = 32 * dt + 8 * gq + 4 * hh;
        const float* gp = p.g_attn_out + h * 64 + d;
        float o[4];
#pragma unroll
        for (int j = 0; j < 4; ++j) o[j] = (dt == 0 ? O0[4 * gq + j] : O1[4 * gq + j]) * rs * gp[j];
        *(uint2*)(Y + (size_t)tq * 1024 + h * 64 + d) = make_uint2(pack2(o[0], o[1]), pack2(o[2], o[3]));
      }
  }
}

DI float row16_allsum(float v) {
  v += __shfl_xor(v, 8); v += __shfl_xor(v, 4); v += __shfl_xor(v, 2); v += __shfl_xor(v, 1);
  return v;
}
struct ScanIn { uint2 kk, u, b, k, r; u16 v; };
DI void scan_load(ScanIn& s, const u16* KK, const u16* U, const u16* BB, const u16* KS, const u16* RS, const u16* VS,
                  size_t tok, int cj, int ci) {
  const size_t o = tok * 512;
  s.kk = *(const uint2*)(KK + o + cj); s.u = *(const uint2*)(U + o + cj); s.b = *(const uint2*)(BB + o + cj);
  s.k = *(const uint2*)(KS + o + cj); s.r = *(const uint2*)(RS + o + cj); s.v = VS[o + ci];
}
DI void phase_scan(const Params& p, int bid, int nblk, char* smem) {
  char* ws = p.ws;
  const u16* KK = (const u16*)(ws + OFF_KK); const u16* U = (const u16*)(ws + OFF_U); const u16* BB = (const u16*)(ws + OFF_BB);
  const u16* KS = (const u16*)(ws + OFF_KS); const u16* RS = (const u16*)(ws + OFF_RS); const u16* VS = (const u16*)(ws + OFF_VS);
  float* YRAW = (float*)(ws + OFF_YRAW);
  const int tid = threadIdx.x, w = tid >> 6, lane = tid & 63, jq = lane & 15;
  for (int unit = bid; unit < 512; unit += nblk) {
    const int bh = unit >> 2, rg = unit & 3, b = bh >> 3, h = bh & 7;
    const int i = 16 * rg + 4 * w + (lane >> 4);
    const int cj = h * 64 + 4 * jq, ci = h * 64 + i;
    const size_t tb = (size_t)b * SEQ;
    float S0 = 0.f, S1 = 0.f, S2 = 0.f, S3 = 0.f;
    constexpr int PF = 8;
    ScanIn cur[PF], nxt[PF];
#pragma unroll
    for (int q = 0; q < PF; ++q) scan_load(cur[q], KK, U, BB, KS, RS, VS, tb + q, cj, ci);
    for (int s0 = 0; s0 < SEQ; s0 += PF) {
      if (s0 + PF < SEQ) {
#pragma unroll
        for (int q = 0; q < PF; ++q) scan_load(nxt[q], KK, U, BB, KS, RS, VS, tb + s0 + PF + q, cj, ci);
      }
#pragma unroll
      for (int q = 0; q < PF; ++q) {
        const ScanIn& c = cur[q];
        const float kk0 = bflo(c.kk.x), kk1 = bfhi(c.kk.x), kk2 = bflo(c.kk.y), kk3 = bfhi(c.kk.y);
        float sk = S0 * kk0 + S1 * kk1 + S2 * kk2 + S3 * kk3;
        sk = row16_allsum(sk);
        const float v = bf2f(c.v);
        S0 = S0 * (1.f - bflo(c.u.x)) - sk * bflo(c.b.x) + v * bflo(c.k.x);
        S1 = S1 * (1.f - bfhi(c.u.x)) - sk * bfhi(c.b.x) + v * bfhi(c.k.x);
        S2 = S2 * (1.f - bflo(c.u.y)) - sk * bflo(c.b.y) + v * bflo(c.k.y);
        S3 = S3 * (1.f - bfhi(c.u.y)) - sk * bfhi(c.b.y) + v * bfhi(c.k.y);
        float y = S0 * bflo(c.r.x) + S1 * bfhi(c.r.x) + S2 * bflo(c.r.y) + S3 * bfhi(c.r.y);
        y = row16_allsum(y);
        if (jq == 0) YRAW[(tb + s0 + q) * 512 + ci] = y;
      }
#pragma unroll
      for (int q = 0; q < PF; ++q) cur[q] = nxt[q];
    }
  }
}

DI void phase_3c(const Params& p, int bid, int nblk, char* smem) {
  char* ws = p.ws;
  const float* YRAW = (const float*)(ws + OFF_YRAW);
  const u16* KS = (const u16*)(ws + OFF_KS); const u16* RS = (const u16*)(ws + OFF_RS); const u16* VS = (const u16*)(ws + OFF_VS);
  const u16* G = (const u16*)(ws + OFF_G);
  u16* Y = (u16*)(ws + OFF_Y);
  const int tid = threadIdx.x, wid = tid >> 6, lane = tid & 63;
  for (int t = bid * 4 + wid; t < T; t += nblk * 4) {
    const int c0 = 8 * lane;
    const float4 y0 = *(const float4*)(YRAW + (size_t)t * 512 + c0);
    const float4 y1 = *(const float4*)(YRAW + (size_t)t * 512 + c0 + 4);
    float y[8] = {y0.x, y0.y, y0.z, y0.w, y1.x, y1.y, y1.z, y1.w};
    const uint4 rr = *(const uint4*)(RS + (size_t)t * 512 + c0);
    const uint4 kr = *(const uint4*)(KS + (size_t)t * 512 + c0);
    const uint4 vr = *(const uint4*)(VS + (size_t)t * 512 + c0);
    const uint4 gr = *(const uint4*)(G + (size_t)t * 512 + c0);
    float rv[8] = {bflo(rr.x), bfhi(rr.x), bflo(rr.y), bfhi(rr.y), bflo(rr.z), bfhi(rr.z), bflo(rr.w), bfhi(rr.w)};
    float kv[8] = {bflo(kr.x), bfhi(kr.x), bflo(kr.y), bfhi(kr.y), bflo(kr.z), bfhi(kr.z), bflo(kr.w), bfhi(kr.w)};
    float vv[8] = {bflo(vr.x), bfhi(vr.x), bflo(vr.y), bfhi(vr.y), bflo(vr.z), bfhi(vr.z), bflo(vr.w), bfhi(vr.w)};
    float gv[8] = {bflo(gr.x), bfhi(gr.x), bflo(gr.y), bfhi(gr.y), bflo(gr.z), bfhi(gr.z), bflo(gr.w), bfhi(gr.w)};
    float sm = 0.f, bsum = 0.f;
#pragma unroll
    for (int i = 0; i < 8; ++i) { sm += y[i]; bsum += rv[i] * kv[i] * p.r_k[c0 + i]; }
    sm += __shfl_xor(sm, 1); sm += __shfl_xor(sm, 2); sm += __shfl_xor(sm, 4);
    bsum += __shfl_xor(bsum, 1); bsum += __shfl_xor(bsum, 2); bsum += __shfl_xor(bsum, 4);
    const float mu = sm * (1.f / 64.f);
    float var = 0.f;
#pragma unroll
    for (int i = 0; i < 8; ++i) { const float d = y[i] - mu; var += d * d; }
    var += __shfl_xor(var, 1); var += __shfl_xor(var, 2); var += __shfl_xor(var, 4);
    const float rs = rsqrtf(var * (1.f / 64.f) + 64e-5f);
    float o[8];
#pragma unroll
    for (int i = 0; i < 8; ++i) o[i] = ((y[i] - mu) * rs * p.ln_x_w[c0 + i] + p.ln_x_b[c0 + i] + bsum * vv[i]) * gv[i];
    *(uint4*)(Y + (size_t)t * 1024 + 512 + c0) = make_uint4(pack2(o[0], o[1]), pack2(o[2], o[3]), pack2(o[4], o[5]), pack2(o[6], o[7]));
  }
}

DI void phase_wo(const Params& p, int bid, int nblk, char* smem) {
  char* ws = p.ws;
  const int tid = threadIdx.x;
  {
    uint2* EU = (uint2*)(ws + OFF_EU); uint2* EV = (uint2*)(ws + OFF_EV);
    const float4* su = (const float4*)p.expert_u; const float4* sv = (const float4*)p.expert_v;
    const float4* gf = (const float4*)p.g_ffn;
    for (size_t i = (size_t)bid * NTHR + tid; i < (size_t)16384 * 256; i += (size_t)nblk * NTHR) {
      const float4 g = gf[i & 255];
      const float4 a = su[i], b = sv[i];
      EU[i] = make_uint2(pack2(a.x * g.x, a.y * g.y), pack2(a.z * g.z, a.w * g.w));
      EV[i] = make_uint2(pack2(b.x, b.y), pack2(b.z, b.w));
    }
  }
  const u16* Y = (const u16*)(ws + OFF_Y);
  const int NT = 8;
  for (int tl = bid; tl < 256 * NT; tl += nblk) {
    const int mt = tl / NT, nt = tl % NT;
    gemm_tile(Y, 1024, (const u16*)(ws + OFF_WOT), 1024, 1024, mt * 128, nt * 128,
              [&](int r, int c, float v) { p.out[(size_t)r * DM + c] = p.x[(size_t)r * DM + c] + v; }, smem);
  }
}

DI void phase_5(const Params& p, int bid, int nblk, char* smem) {
  char* ws = p.ws;
  const int tid = threadIdx.x, wid = tid >> 6, lane = tid & 63;
  for (int row = bid * 4 + wid; row < T; row += nblk * 4) {
    const float4* xr = (const float4*)(p.out + (size_t)row * DM);
    uint2* xb = (uint2*)(ws + OFF_X2B + (size_t)row * DM * 2);
    float ss = 0.f;
#pragma unroll
    for (int i = 0; i < 4; ++i) {
      const float4 v = xr[lane + 64 * i];
      ss += v.x * v.x + v.y * v.y + v.z * v.z + v.w * v.w;
      xb[lane + 64 * i] = make_uint2(pack2(v.x, v.y), pack2(v.z, v.w));
    }
    ss = wave_allsum(ss);
    if (lane == 0) ((float*)(ws + OFF_RSTD2))[row] = rsqrtf(ss * (1.f / DM) + EPS);
  }
}

DI void phase_6(const Params& p, int bid, int nblk, char* smem) {
  char* ws = p.ws;
  const float* rstd = (const float*)(ws + OFF_RSTD2);
  u16* QP = (u16*)(ws + OFF_QP);
  const int NT = 16;
  for (int tl = bid; tl < 256 * NT; tl += nblk) {
    const int mt = tl / NT, nt = tl % NT;
    gemm_tile((const u16*)(ws + OFF_X2B), 1024, (const u16*)(ws + OFF_WPQT), 1024, 1024, mt * 128, nt * 128,
              [&](int r, int c, float v) { QP[(size_t)r * 2048 + c] = f2bf(v * rstd[r]); }, smem);
  }
}

DI void ins16(float (&top)[16], float x) {
#pragma unroll
  for (int i = 0; i < 16; ++i) { const float hi = fmaxf(top[i], x); x = fminf(top[i], x); top[i] = hi; }
}
DI void phase_7(const Params& p, int bid, int nblk, char* smem) {
  char* ws = p.ws;
  const u16* QP = (const u16*)(ws + OFF_QP);
  const u16* SUBK = (const u16*)(ws + OFF_SUBK);
  int* IDX = (int*)(ws + OFF_IDX); float* GATE = (float*)(ws + OFF_GATE);
  float* lists = (float*)smem;
  const int tid = threadIdx.x, w = tid >> 6, lane = tid & 63, r = lane & 31, hh = lane >> 5;
  const int th = w & 1, pp = w >> 1;
  for (int it = bid; it < 512 * 8; it += nblk) {
    const int tt = it >> 3, h = it & 7;
    const int t = tt * 64 + 32 * th + r;
    bf16x8 qf[8];
#pragma unroll
    for (int ks = 0; ks < 8; ++ks) qf[ks] = *reinterpret_cast<const bf16x8*>(QP + (size_t)t * 2048 + h * 256 + pp * 128 + 16 * ks + 8 * hh);
    const u16* sk = SUBK + (size_t)(h * 2 + pp) * 128 * 128;
    float top[16];
#pragma unroll
    for (int i = 0; i < 16; ++i) top[i] = -INFINITY;
#pragma unroll
    for (int kt = 0; kt < 4; ++kt) {
      f32x16 acc;
#pragma unroll
      for (int i = 0; i < 16; ++i) acc[i] = 0.f;
#pragma unroll
      for (int ks = 0; ks < 8; ++ks) {
        const bf16x8 a = *reinterpret_cast<const bf16x8*>(sk + (size_t)(32 * kt + r) * 128 + 16 * ks + 8 * hh);
        acc = MFMA32(a, qf[ks], acc);
      }
#pragma unroll
      for (int i = 0; i < 16; ++i) {
        const unsigned key = 32 * kt + (i & 3) + 8 * (i >> 2) + 4 * hh;
        const float v = __uint_as_float((__float_as_uint(acc[i]) & ~127u) | key);
        ins16(top, v);
      }
    }
    float oth[16];
#pragma unroll
    for (int i = 0; i < 16; ++i) oth[i] = __shfl_xor(top[i], 32);
#pragma unroll
    for (int i = 0; i < 16; ++i) ins16(top, oth[i]);
    __syncthreads();
    if (hh == 0) {
      float* dst = lists + ((32 * th + r) * 2 + pp) * 16;
#pragma unroll
      for (int i = 0; i < 16; i += 4) *(float4*)(dst + i) = make_float4(top[i], top[i + 1], top[i + 2], top[i + 3]);
    }
    __syncthreads();
    if (tid < 64) {
      const float* l1 = lists + (tid * 2 + 0) * 16;
      const float* l2 = lists + (tid * 2 + 1) * 16;
      float s1[16], s2[16];
#pragma unroll
      for (int i = 0; i < 16; ++i) {
        s1[i] = __uint_as_float(__float_as_uint(l1[i]) & ~127u);
        s2[i] = __uint_as_float(__float_as_uint(l2[i]) & ~127u);
      }
      float ts[16];
#pragma unroll
      for (int i = 0; i < 16; ++i) ts[i] = -INFINITY;
#pragma unroll
      for (int a = 0; a < 16; ++a)
#pragma unroll
        for (int b = 0; b < 16; ++b)
          if ((a + 1) * (b + 1) <= 16) {
            const float sm = s1[a] + s2[b];
            ins16(ts, __uint_as_float((__float_as_uint(sm) & ~255u) | (unsigned)(a * 16 + b)));
          }
      const size_t ob = ((size_t)(tt * 64 + tid) * 8 + h) * 16;
      float e[16], esum = 0.f;
      const float mx = __uint_as_float(__float_as_uint(ts[0]) & ~255u);
#pragma unroll
      for (int i = 0; i < 16; ++i) {
        const unsigned bits = __float_as_uint(ts[i]);
        const unsigned cid = bits & 255u;
        const float val = __uint_as_float(bits & ~255u);
        e[i] = __expf(val - mx); esum += e[i];
        const unsigned i1 = __float_as_uint(l1[cid >> 4]) & 127u, i2 = __float_as_uint(l2[cid & 15]) & 127u;
        IDX[ob + i] = (int)(i1 * 128 + i2);
      }
      const float inv = 1.f / esum;
#pragma unroll
      for (int i = 0; i < 16; ++i) GATE[ob + i] = e[i] * inv;
    }
  }
}

DI void phase_8(const Params& p, int bid, int nblk, char* smem) {
  char* ws = p.ws;
  const u16* X2B = (const u16*)(ws + OFF_X2B);
  const u16* EU = (const u16*)(ws + OFF_EU); const u16* EV = (const u16*)(ws + OFF_EV);
  const int* IDX = (const int*)(ws + OFF_IDX); const float* GATE = (const float*)(ws + OFF_GATE);
  const float* rstd2 = (const float*)(ws + OFF_RSTD2);
  const int tid = threadIdx.x, wid = tid >> 6, lane = tid & 63;
  for (int t = bid * 4 + wid; t < T; t += nblk * 4) {
    float xh[16];
    {
      const uint4 a = *(const uint4*)(X2B + (size_t)t * DM + 16 * lane);
      const uint4 b = *(const uint4*)(X2B + (size_t)t * DM + 16 * lane + 8);
      xh[0] = bflo(a.x); xh[1] = bfhi(a.x); xh[2] = bflo(a.y); xh[3] = bfhi(a.y); xh[4] = bflo(a.z); xh[5] = bfhi(a.z); xh[6] = bflo(a.w); xh[7] = bfhi(a.w);
      xh[8] = bflo(b.x); xh[9] = bfhi(b.x); xh[10] = bflo(b.y); xh[11] = bfhi(b.y); xh[12] = bflo(b.z); xh[13] = bfhi(b.z); xh[14] = bflo(b.w); xh[15] = bfhi(b.w);
    }
    const float rs = rstd2[t];
    const int id0 = IDX[(size_t)t * 128 + lane], id1 = IDX[(size_t)t * 128 + 64 + lane];
    const float g0 = GATE[(size_t)t * 128 + lane], g1 = GATE[(size_t)t * 128 + 64 + lane];
    float acc[16];
#pragma unroll
    for (int i = 0; i < 16; ++i) acc[i] = 0.f;
    for (int k0 = 0; k0 < 128; k0 += 4) {
      uint4 ua[4], ub[4], va[4], vb[4];
      float gt[4];
#pragma unroll
      for (int q = 0; q < 4; ++q) {
        const int k = k0 + q;
        const int e = __shfl(k < 64 ? id0 : id1, k & 63);
        gt[q] = __shfl(k < 64 ? g0 : g1, k & 63);
        const u16* up = EU + (size_t)e * DM + 16 * lane;
        const u16* vp = EV + (size_t)e * DM + 16 * lane;
        ua[q] = *(const uint4*)up; ub[q] = *(const uint4*)(up + 8);
        va[q] = *(const uint4*)vp; vb[q] = *(const uint4*)(vp + 8);
      }
#pragma unroll
      for (int q = 0; q < 4; ++q) {
        float d = xh[0] * bflo(ua[q].x) + xh[1] * bfhi(ua[q].x) + xh[2] * bflo(ua[q].y) + xh[3] * bfhi(ua[q].y)
                + xh[4] * bflo(ua[q].z) + xh[5] * bfhi(ua[q].z) + xh[6] * bflo(ua[q].w) + xh[7] * bfhi(ua[q].w)
                + xh[8] * bflo(ub[q].x) + xh[9] * bfhi(ub[q].x) + xh[10] * bflo(ub[q].y) + xh[11] * bfhi(ub[q].y)
                + xh[12] * bflo(ub[q].z) + xh[13] * bfhi(ub[q].z) + xh[14] * bflo(ub[q].w) + xh[15] * bfhi(ub[q].w);
        d = wave_allsum(d) * rs;
        const float wg = gt[q] * 0.5f * d * (1.f + erff(d * 0.70710678118654752f));
        acc[0] += wg * bflo(va[q].x); acc[1] += wg * bfhi(va[q].x); acc[2] += wg * bflo(va[q].y); acc[3] += wg * bfhi(va[q].y);
        acc[4] += wg * bflo(va[q].z); acc[5] += wg * bfhi(va[q].z); acc[6] += wg * bflo(va[q].w); acc[7] += wg * bfhi(va[q].w);
        acc[8] += wg * bflo(vb[q].x); acc[9] += wg * bfhi(vb[q].x); acc[10] += wg * bflo(vb[q].y); acc[11] += wg * bfhi(vb[q].y);
        acc[12] += wg * bflo(vb[q].z); acc[13] += wg * bfhi(vb[q].z); acc[14] += wg * bflo(vb[q].w); acc[15] += wg * bfhi(vb[q].w);
      }
    }
    float4* op = (float4*)(p.out + (size_t)t * DM + 16 * lane);
#pragma unroll
    for (int i = 0; i < 4; ++i) {
      float4 v = op[i];
      v.x += acc[4 * i]; v.y += acc[4 * i + 1]; v.z += acc[4 * i + 2]; v.w += acc[4 * i + 3];
      op[i] = v;
    }
  }
}

constexpr int NPHASE = 12;
template <int PH>
DI void run_phase(const Params& p, int bid, int nblk, char* smem) {
  if constexpr (PH == 0) phase_prep(p, bid, nblk, smem);
  else if constexpr (PH == 1) phase_gemm1(p, bid, nblk, smem);
  else if constexpr (PH == 2) phase_2a(p, bid, nblk, smem);
  else if constexpr (PH == 3) phase_2b(p, bid, nblk, smem);
  else if constexpr (PH == 4) phase_2c(p, bid, nblk, smem);
  else if constexpr (PH == 5) phase_attn(p, bid, nblk, smem);
  else if constexpr (PH == 6) phase_scan(p, bid, nblk, smem);
  else if constexpr (PH == 7) phase_3c(p, bid, nblk, smem);
  else if constexpr (PH == 8) phase_wo(p, bid, nblk, smem);
  else if constexpr (PH == 9) phase_5(p, bid, nblk, smem);
  else if constexpr (PH == 10) phase_6(p, bid, nblk, smem);
  else if constexpr (PH == 11) { phase_7(p, bid, nblk, smem); }
  else phase_8(p, bid, nblk, smem);
}

constexpr int SMEM_BYTES = 32768;

#if MEGA
__global__ void __launch_bounds__(NTHR, 2) mega_kernel(Params p) {
  __shared__ __attribute__((aligned(16))) char smem[SMEM_BYTES];
  cg::grid_group grid = cg::this_grid();
  const int bid = blockIdx.x, nblk = gridDim.x;
  run_phase<0>(p, bid, nblk, smem); grid.sync();
  run_phase<1>(p, bid, nblk, smem); grid.sync();
  run_phase<2>(p, bid, nblk, smem); grid.sync();
  run_phase<3>(p, bid, nblk, smem); grid.sync();
  run_phase<4>(p, bid, nblk, smem); grid.sync();
  run_phase<5>(p, bid, nblk, smem); grid.sync();
  run_phase<6>(p, bid, nblk, smem); grid.sync();
  run_phase<7>(p, bid, nblk, smem); grid.sync();
  run_phase<8>(p, bid, nblk, smem); grid.sync();
  run_phase<9>(p, bid, nblk, smem); grid.sync();
  run_phase<10>(p, bid, nblk, smem); grid.sync();
  run_phase<11>(p, bid, nblk, smem); grid.sync();
  run_phase<12>(p, bid, nblk, smem);
}
#else
template <int PH>
__global__ void __launch_bounds__(NTHR, 2) phase_kernel(Params p) {
  __shared__ __attribute__((aligned(16))) char smem[SMEM_BYTES];
  run_phase<PH>(p, blockIdx.x, gridDim.x, smem);
}
#endif

extern "C" void kernel_launch(void* const* d_in, const int* in_sizes, int n_in, void* d_out, int out_size, void* d_ws,
                              size_t ws_size, hipStream_t stream) {
  Params p{};
  p.x = (const float*)d_in[0]; p.pos = (const int*)d_in[1];
  p.g_mix = (const float*)d_in[2]; p.w_in = (const float*)d_in[3]; p.rwkv_mu = (const float*)d_in[4];
  p.g_cq = (const float*)d_in[5]; p.g_ckv = (const float*)d_in[6]; p.w_uq = (const float*)d_in[7];
  p.w_uk = (const float*)d_in[8]; p.w_uv = (const float*)d_in[9]; p.g_qnorm = (const float*)d_in[10];
  p.g_knorm = (const float*)d_in[11]; p.g_attn_out = (const float*)d_in[12]; p.w0 = (const float*)d_in[13];
  p.w2 = (const float*)d_in[14]; p.a0 = (const float*)d_in[15]; p.a2 = (const float*)d_in[16];
  p.g2 = (const float*)d_in[17]; p.k_k = (const float*)d_in[18]; p.k_a = (const float*)d_in[19];
  p.r_k = (const float*)d_in[20]; p.ln_x_w = (const float*)d_in[21]; p.ln_x_b = (const float*)d_in[22];
  p.w_o = (const float*)d_in[23]; p.g_ffn = (const float*)d_in[24]; p.w_pq = (const float*)d_in[25];
  p.sub_keys = (const float*)d_in[26]; p.expert_u = (const float*)d_in[27]; p.expert_v = (const float*)d_in[28];
  p.out = (float*)d_out; p.ws = (char*)d_ws;
#if MEGA
  static int grid_blocks = 0;
  if (!grid_blocks) {
    int dev = 0, cus = 0, per_cu = 0;
    hipGetDevice(&dev);
    hipDeviceGetAttribute(&cus, hipDeviceAttributeMultiprocessorCount, dev);
    hipOccupancyMaxActiveBlocksPerMultiprocessor(&per_cu, mega_kernel, NTHR, 0);
    if (per_cu > 2) per_cu = 2;
    grid_blocks = cus * per_cu;
  }
  void* args[] = {&p};
  hipError_t e = hipLaunchCooperativeKernel((void*)mega_kernel, dim3(grid_blocks), dim3(NTHR), args, 0, stream);
  if (e != hipSuccess) fprintf(stderr, "cooperative launch failed: %s (grid %d)\n", hipGetErrorString(e), grid_blocks);
#else
  const int NB = 512;
  phase_kernel<0><<<NB, NTHR, 0, stream>>>(p);
  phase_kernel<1><<<NB, NTHR, 0, stream>>>(p);
  phase_kernel<2><<<NB, NTHR, 0, stream>>>(p);
  phase_kernel<3><<<NB, NTHR, 0, stream>>>(p);
  phase_kernel<4><<<NB, NTHR, 0, stream>>>(p);
  phase_kernel<5><<<NB, NTHR, 0, stream>>>(p);
  phase_kernel<6><<<NB, NTHR, 0, stream>>>(p);
  phase_kernel<7><<<NB, NTHR, 0, stream>>>(p);
  phase_kernel<8><<<NB, NTHR, 0, stream>>>(p);
  phase_kernel<9><<<NB, NTHR, 0, stream>>>(p);
  phase_kernel<10><<<NB, NTHR, 0, stream>>>(p);
  phase_kernel<11><<<NB, NTHR, 0, stream>>>(p);
  phase_kernel<12><<<NB, NTHR, 0, stream>>>(p);
#endif
}
```

```cpp
#include <hip/hip_runtime.h>
#include <hip/hip_cooperative_groups.h>
#include <cstdio>
#include <cstdint>
namespace cg = cooperative_groups;

#ifndef MEGA
#define MEGA 1
#endif

typedef unsigned short u16;
using bf16x8 = __attribute__((ext_vector_type(8))) short;
using s16x4  = __attribute__((ext_vector_type(4))) short;
using f32x4  = __attribute__((ext_vector_type(4))) float;
using f32x16 = __attribute__((ext_vector_type(16))) float;
#define DI __device__ __forceinline__

constexpr int T = 32768, SEQ = 2048, DM = 1024;
constexpr int INC = 2464, MLAC = 672, RWC = 1792;
constexpr int NTHR = 256;
constexpr float EPS = 1e-6f;

constexpr size_t MiB = 1048576;
constexpr size_t OFF_WINT  = 0;
constexpr size_t OFF_WUQT  = OFF_WINT  + 2560 * 1024 * 2;
constexpr size_t OFF_WUKVT = OFF_WUQT  + 768 * 384 * 2;
constexpr size_t OFF_W2T   = OFF_WUKVT + 1024 * 256 * 2;
constexpr size_t OFF_A2T   = OFF_W2T   + 512 * 64 * 2;
constexpr size_t OFF_G2T   = OFF_A2T   + 512 * 64 * 2;
constexpr size_t OFF_WOT   = OFF_G2T   + 512 * 128 * 2;
constexpr size_t OFF_WPQT  = OFF_WOT   + 1024 * 1024 * 2;
constexpr size_t OFF_SUBK  = OFF_WPQT  + 2048 * 1024 * 2;
constexpr size_t OFF_ROPE  = OFF_SUBK  + 16 * 128 * 128 * 2;
constexpr size_t OFF_RSTD1 = OFF_ROPE  + (size_t)T * 32 * 4;
constexpr size_t OFF_RSTDQ = OFF_RSTD1 + (size_t)T * 4;
constexpr size_t OFF_RSTDKV= OFF_RSTDQ + (size_t)T * 4;
constexpr size_t OFF_RSTD2 = OFF_RSTDKV+ (size_t)T * 4;
constexpr size_t OFF_A_END = OFF_RSTD2 + (size_t)T * 4;
static_assert(OFF_A_END <= 20 * MiB, "region A");
constexpr size_t OFF_XB    = 20 * MiB;
constexpr size_t OFF_Y     = OFF_XB;
constexpr size_t OFF_PM    = 84 * MiB;
constexpr size_t OFF_PR    = 126 * MiB;
constexpr size_t OFF_U     = OFF_PR;
constexpr size_t OFF_G     = OFF_PR + 32 * MiB;
constexpr size_t OFF_KK    = OFF_PR + 64 * MiB;
constexpr size_t OFF_KVRAW = 238 * MiB;
constexpr size_t OFF_QRAW  = 302 * MiB;
constexpr size_t OFF_LORAIN= 350 * MiB;
constexpr size_t OFF_YRAW  = 302 * MiB;
constexpr size_t OFF_RS    = 366 * MiB;
constexpr size_t OFF_KS    = 398 * MiB;
constexpr size_t OFF_VS    = 430 * MiB;
constexpr size_t OFF_BB    = 462 * MiB;
constexpr size_t OFF_EU    = 84 * MiB;
constexpr size_t OFF_EV    = 116 * MiB;
constexpr size_t OFF_X2B   = 148 * MiB;
constexpr size_t OFF_QP    = 238 * MiB;
constexpr size_t OFF_IDX   = 366 * MiB;
constexpr size_t OFF_GATE  = 382 * MiB;
constexpr size_t DO_Q = 0, DO_K = (size_t)T * 768 * 2, DO_AA = (size_t)T * 768 * 4;

struct Params {
  const float* x; const int* pos;
  const float *g_mix, *w_in, *rwkv_mu, *g_cq, *g_ckv, *w_uq, *w_uk, *w_uv, *g_qnorm, *g_knorm, *g_attn_out;
  const float *w0, *w2, *a0, *a2, *g2, *k_k, *k_a, *r_k, *ln_x_w, *ln_x_b, *w_o, *g_ffn, *w_pq, *sub_keys, *expert_u, *expert_v;
  float* out; char* ws;
};

DI u16 f2bf(float x) { unsigned u = __float_as_uint(x); u += 0x7fffu + ((u >> 16) & 1u); return (u16)(u >> 16); }
DI float bf2f(u16 h) { return __uint_as_float(((unsigned)h) << 16); }
DI unsigned pack2(float a, float b) { return (unsigned)f2bf(a) | ((unsigned)f2bf(b) << 16); }
DI float bflo(unsigned u) { return __uint_as_float(u << 16); }
DI float bfhi(unsigned u) { return __uint_as_float(u & 0xffff0000u); }
DI float wave_allsum(float v) {
#pragma unroll
  for (int o = 32; o > 0; o >>= 1) v += __shfl_xor(v, o);
  return v;
}
DI float sigmoidf_(float x) { return 1.f / (1.f + __expf(-x)); }

DI void tconv(const float* __restrict__ src, int K, int N, const float* __restrict__ scale, u16* __restrict__ dst,
              int ldd, int noff, int bid, int nblk, float* tile) {
  const int tid = threadIdx.x, tx = tid & 31, ty = tid >> 5;
  const int nbn = N / 32, ntl = (K / 32) * nbn;
  for (int tl = bid; tl < ntl; tl += nblk) {
    const int kb = tl / nbn, nb = tl % nbn;
#pragma unroll
    for (int i = 0; i < 4; ++i) {
      const int k = kb * 32 + ty + 8 * i;
      float v = src[(size_t)k * N + nb * 32 + tx];
      if (scale) v *= scale[k];
      tile[(ty + 8 * i) * 33 + tx] = v;
    }
    __syncthreads();
#pragma unroll
    for (int i = 0; i < 4; ++i) {
      const int n = nb * 32 + ty + 8 * i;
      dst[(size_t)(noff + n) * ldd + kb * 32 + tx] = f2bf(tile[tx * 33 + ty + 8 * i]);
    }
    __syncthreads();
  }
}

DI void phase_prep(const Params& p, int bid, int nblk, char* smem) {
  float* tile = (float*)smem;
  char* ws = p.ws;
  const int tid = threadIdx.x;
  tconv(p.w_in, 1024, INC, p.g_mix, (u16*)(ws + OFF_WINT), 1024, 0, bid, nblk, tile);
  for (int i = bid * NTHR + tid; i < 96 * 1024; i += nblk * NTHR) ((u16*)(ws + OFF_WINT))[2464 * 1024 + i] = 0;
  tconv(p.w_uq, 384, 768, p.g_cq, (u16*)(ws + OFF_WUQT), 384, 0, bid, nblk, tile);
  tconv(p.w_uk, 256, 512, p.g_ckv, (u16*)(ws + OFF_WUKVT), 256, 0, bid, nblk, tile);
  tconv(p.w_uv, 256, 512, p.g_ckv, (u16*)(ws + OFF_WUKVT), 256, 512, bid, nblk, tile);
  tconv(p.w2, 64, 512, nullptr, (u16*)(ws + OFF_W2T), 64, 0, bid, nblk, tile);
  tconv(p.a2, 64, 512, nullptr, (u16*)(ws + OFF_A2T), 64, 0, bid, nblk, tile);
  tconv(p.g2, 128, 512, nullptr, (u16*)(ws + OFF_G2T), 128, 0, bid, nblk, tile);
  tconv(p.w_o, 1024, 1024, nullptr, (u16*)(ws + OFF_WOT), 1024, 0, bid, nblk, tile);
  tconv(p.w_pq, 1024, 2048, p.g_ffn, (u16*)(ws + OFF_WPQT), 1024, 0, bid, nblk, tile);
  for (int i = bid * NTHR + tid; i < 16 * 128 * 128; i += nblk * NTHR) ((u16*)(ws + OFF_SUBK))[i] = f2bf(p.sub_keys[i]);
  for (int i = bid * NTHR + tid; i < T * 16; i += nblk * NTHR) {
    const int t = i >> 4, j = i & 15;
    const float inv = powf(10000.0f, -(float)j / 16.0f);
    const float ang = (float)p.pos[t] * inv;
    float s, c; sincosf(ang, &s, &c);
    float* rp = (float*)(ws + OFF_ROPE) + (size_t)t * 32;
    rp[j] = c; rp[16 + j] = s;
  }
  const int wid = tid >> 6, lane = tid & 63;
  for (int row = bid * 4 + wid; row < T; row += nblk * 4) {
    const float4* xr = (const float4*)(p.x + (size_t)row * DM);
    uint2* xb = (uint2*)(ws + OFF_XB + (size_t)row * DM * 2);
    float ss = 0.f;
#pragma unroll
    for (int i = 0; i < 4; ++i) {
      const float4 v = xr[lane + 64 * i];
      ss += v.x * v.x + v.y * v.y + v.z * v.z + v.w * v.w;
      xb[lane + 64 * i] = make_uint2(pack2(v.x, v.y), pack2(v.z, v.w));
    }
    ss = wave_allsum(ss);
    if (lane == 0) ((float*)(ws + OFF_RSTD1))[row] = rsqrtf(ss * (1.f / DM) + EPS);
  }
}

template <class Epi>
DI void gemm_tile(const u16* __restrict__ A, int lda, const u16* __restrict__ Bt, int ldb, int K, int m0, int n0,
                  Epi epi, char* smem) {
  u16* SA = (u16*)smem;
  u16* SB = SA + 128 * 32;
  const int tid = threadIdx.x, wid = tid >> 6, lane = tid & 63, wr = wid >> 1, wc = wid & 1, fr = lane & 15, fq = lane >> 4;
  f32x4 acc[4][4];
#pragma unroll
  for (int m = 0; m < 4; ++m)
#pragma unroll
    for (int n = 0; n < 4; ++n) acc[m][n] = f32x4{0.f, 0.f, 0.f, 0.f};
  const int nk = K / 32;
  for (int kt = 0; kt < nk; ++kt) {
#pragma unroll
    for (int i = 0; i < 2; ++i) {
      const int b = tid * 16 + i * 4096, r = b / 64, c = (b % 64) / 2;
      __builtin_amdgcn_global_load_lds((const unsigned*)(A + (size_t)(m0 + r) * lda + kt * 32 + c),
                                       (__attribute__((address_space(3))) unsigned*)((char*)SA + b), 16, 0, 0);
      __builtin_amdgcn_global_load_lds((const unsigned*)(Bt + (size_t)(n0 + r) * ldb + kt * 32 + c),
                                       (__attribute__((address_space(3))) unsigned*)((char*)SB + b), 16, 0, 0);
    }
    asm volatile("s_waitcnt vmcnt(0)" ::: "memory");
    __syncthreads();
    bf16x8 af[4], bfr[4];
#pragma unroll
    for (int m = 0; m < 4; ++m) af[m] = *reinterpret_cast<const bf16x8*>((char*)SA + (wr * 64 + m * 16 + fr) * 64 + fq * 16);
#pragma unroll
    for (int n = 0; n < 4; ++n) bfr[n] = *reinterpret_cast<const bf16x8*>((char*)SB + (wc * 64 + n * 16 + fr) * 64 + fq * 16);
#pragma unroll
    for (int m = 0; m < 4; ++m)
#pragma unroll
      for (int n = 0; n < 4; ++n) acc[m][n] = __builtin_amdgcn_mfma_f32_16x16x32_bf16(af[m], bfr[n], acc[m][n], 0, 0, 0);
    __syncthreads();
  }
#pragma unroll
  for (int m = 0; m < 4; ++m)
#pragma unroll
    for (int n = 0; n < 4; ++n)
#pragma unroll
      for (int j = 0; j < 4; ++j) epi(m0 + wr * 64 + m * 16 + fq * 4 + j, n0 + wc * 64 + n * 16 + fr, acc[m][n][j]);
}

DI void phase_gemm1(const Params& p, int bid, int nblk, char* smem) {
  char* ws = p.ws;
  const u16* A = (const u16*)(ws + OFF_XB);
  const u16* Bt = (const u16*)(ws + OFF_WINT);
  const float* rstd = (const float*)(ws + OFF_RSTD1);
  u16* PM = (u16*)(ws + OFF_PM);
  u16* PR = (u16*)(ws + OFF_PR);
  const int NT = 20;
  for (int tl = bid; tl < 256 * NT; tl += nblk) {
    const int mt = tl / NT, nt = tl % NT;
    gemm_tile(A, 1024, Bt, 1024, 1024, mt * 128, nt * 128,
              [&](int r, int c, float v) {
                if (c < INC) {
                  const u16 o = f2bf(v * rstd[r]);
                  if (c < MLAC) PM[(size_t)r * MLAC + c] = o; else PR[(size_t)r * RWC + (c - MLAC)] = o;
                }
              }, smem);
  }
}

DI void phase_2a(const Params& p, int bid, int nblk, char* smem) {
  char* ws = p.ws;
  const u16* PM = (const u16*)(ws + OFF_PM);
  const u16* PR = (const u16*)(ws + OFF_PR);
  u16* RS = (u16*)(ws + OFF_RS); u16* KS = (u16*)(ws + OFF_KS); u16* VS = (u16*)(ws + OFF_VS);
  u16* LI = (u16*)(ws + OFF_LORAIN);
  float* red = (float*)smem;
  const int tid = threadIdx.x, wid = tid >> 6, lane = tid & 63;
  for (int t = bid; t < T; t += nblk) {
    const u16* pm = PM + (size_t)t * MLAC;
    float q0 = bf2f(pm[tid]); float sq = q0 * q0;
    if (tid < 128) { const float q1 = bf2f(pm[256 + tid]); sq += q1 * q1; }
    const float kv = bf2f(pm[384 + tid]); float skv = kv * kv;
    sq = wave_allsum(sq); skv = wave_allsum(skv);
    if (lane == 0) { red[wid] = sq; red[4 + wid] = skv; }
    __syncthreads();
    if (tid == 0) {
      ((float*)(ws + OFF_RSTDQ))[t] = rsqrtf((red[0] + red[1] + red[2] + red[3]) * (1.f / 384.f) + EPS);
      ((float*)(ws + OFF_RSTDKV))[t] = rsqrtf((red[4] + red[5] + red[6] + red[7]) * (1.f / 256.f) + EPS);
    }
    __syncthreads();
    const bool first = (t % SEQ) == 0;
    const u16* cur = PR + (size_t)t * RWC;
    const u16* prv = cur - RWC;
#pragma unroll
    for (int i = 0; i < 7; ++i) {
      const int c = tid + 256 * i;
      const float cv = bf2f(cur[c]);
      const float pv = first ? 0.f : bf2f(prv[c]);
      const float v = cv + (pv - cv) * p.rwkv_mu[c];
      if (c < 512) RS[(size_t)t * 512 + c] = f2bf(v);
      else if (c < 1024) KS[(size_t)t * 512 + c - 512] = f2bf(v);
      else if (c < 1536) VS[(size_t)t * 512 + c - 1024] = f2bf(v);
      else if (c < 1600) LI[(size_t)t * 256 + c - 1536] = f2bf(tanhf(v));
      else if (c < 1664) LI[(size_t)t * 256 + c - 1536] = f2bf(v);
      else LI[(size_t)t * 256 + c - 1536] = f2bf(sigmoidf_(v));
    }
  }
}

DI void phase_2b(const Params& p, int bid, int nblk, char* smem) {
  char* ws = p.ws;
  const u16* PM = (const u16*)(ws + OFF_PM);
  const u16* LI = (const u16*)(ws + OFF_LORAIN);
  const float* rq = (const float*)(ws + OFF_RSTDQ);
  const float* rkv = (const float*)(ws + OFF_RSTDKV);
  u16* QRAW = (u16*)(ws + OFF_QRAW); u16* KVRAW = (u16*)(ws + OFF_KVRAW);
  u16* U = (u16*)(ws + OFF_U); u16* G = (u16*)(ws + OFF_G);
  u16* AA = (u16*)((char*)p.out + DO_AA);
  const int NT = 26;
  for (int tl = bid; tl < 256 * NT; tl += nblk) {
    const int mt = tl / NT, j = tl % NT, m0 = mt * 128;
    if (j < 6) {
      gemm_tile(PM, MLAC, (const u16*)(ws + OFF_WUQT), 384, 384, m0, j * 128,
                [&](int r, int c, float v) { QRAW[(size_t)r * 768 + c] = f2bf(v * rq[r]); }, smem);
    } else if (j < 14) {
      gemm_tile(PM + 384, MLAC, (const u16*)(ws + OFF_WUKVT), 256, 256, m0, (j - 6) * 128,
                [&](int r, int c, float v) { KVRAW[(size_t)r * 1024 + c] = f2bf(v * rkv[r]); }, smem);
    } else if (j < 18) {
      gemm_tile(LI, 256, (const u16*)(ws + OFF_W2T), 64, 64, m0, (j - 14) * 128,
                [&](int r, int c, float v) {
                  const float sg = sigmoidf_(p.w0[c] + v);
                  U[(size_t)r * 512 + c] = f2bf(-expm1f(-0.6065306597126334f * sg));
                }, smem);
    } else if (j < 22) {
      gemm_tile(LI + 64, 256, (const u16*)(ws + OFF_A2T), 64, 64, m0, (j - 18) * 128,
                [&](int r, int c, float v) { AA[(size_t)r * 512 + c] = f2bf(sigmoidf_(p.a0[c] + v)); }, smem);
    } else {
      gemm_tile(LI + 128, 256, (const u16*)(ws + OFF_G2T), 128, 128, m0, (j - 22) * 128,
                [&](int r, int c, float v) { G[(size_t)r * 512 + c] = f2bf(v); }, smem);
    }
  }
}

DI void phase_2c(const Params& p, int bid, int nblk, char* smem) {
  char* ws = p.ws;
  const u16* PM = (const u16*)(ws + OFF_PM);
  const u16* QRAW = (const u16*)(ws + OFF_QRAW);
  const u16* KVRAW = (const u16*)(ws + OFF_KVRAW);
  u16* Q = (u16*)((char*)p.out + DO_Q); u16* Kd = (u16*)((char*)p.out + DO_K);
  const u16* AA = (const u16*)((char*)p.out + DO_AA);
  u16* KS = (u16*)(ws + OFF_KS); u16* KK = (u16*)(ws + OFF_KK); u16* BB = (u16*)(ws + OFF_BB);
  const float* rope = (const float*)(ws + OFF_ROPE);
  const int tid = threadIdx.x, wid = tid >> 6, lane = tid & 63;
  const float QSCALE = 0.10206207261596575f * 1.4426950408889634f;
  for (int t = bid * 4 + wid; t < T; t += nblk * 4) {
    const int e0 = 2 * lane;
    const bool act = lane < 48;
    const bool isrope = lane >= 32 && lane < 48;
    const bool second = lane >= 40;
    float cs0 = 0.f, cs1 = 0.f, sn0 = 0.f, sn1 = 0.f;
    if (isrope) {
      const int i0 = e0 - (second ? 80 : 64);
      cs0 = rope[(size_t)t * 32 + i0]; cs1 = rope[(size_t)t * 32 + i0 + 1];
      sn0 = rope[(size_t)t * 32 + 16 + i0]; sn1 = rope[(size_t)t * 32 + 16 + i0 + 1];
    }
    float gq0 = 0.f, gq1 = 0.f, gk0 = 0.f, gk1 = 0.f;
    if (act) { gq0 = p.g_qnorm[e0]; gq1 = p.g_qnorm[e0 + 1]; gk0 = p.g_knorm[e0]; gk1 = p.g_knorm[e0 + 1]; }
    for (int h = 0; h < 8; ++h) {
#pragma unroll
      for (int which = 0; which < 2; ++which) {
        float v0 = 0.f, v1 = 0.f;
        if (act) {
          unsigned raw;
          if (which == 0) raw = *(const unsigned*)(QRAW + (size_t)t * 768 + h * 96 + e0);
          else if (e0 < 64) raw = *(const unsigned*)(KVRAW + (size_t)t * 1024 + h * 64 + e0);
          else raw = *(const unsigned*)(PM + (size_t)t * MLAC + 640 + (e0 - 64));
          v0 = bflo(raw); v1 = bfhi(raw);
        }
        const float ss = wave_allsum(v0 * v0 + v1 * v1);
        const float rs = rsqrtf(ss * (1.f / 96.f) + EPS);
        v0 *= rs * (which == 0 ? gq0 : gk0);
        v1 *= rs * (which == 0 ? gq1 : gk1);
        const float o0 = __shfl_xor(v0, 8), o1 = __shfl_xor(v1, 8);
        if (isrope) {
          if (!second) { v0 = v0 * cs0 - o0 * sn0; v1 = v1 * cs1 - o1 * sn1; }
          else { v0 = o0 * sn0 + v0 * cs0; v1 = o1 * sn1 + v1 * cs1; }
        }
        if (act) {
          if (which == 0) *(unsigned*)(Q + (size_t)t * 768 + h * 96 + e0) = pack2(v0 * QSCALE, v1 * QSCALE);
          else *(unsigned*)(Kd + (size_t)t * 768 + h * 96 + e0) = pack2(v0, v1);
        }
      }
    }
    {
      const int c0 = 8 * lane;
      const uint4 kraw = *(const uint4*)(KS + (size_t)t * 512 + c0);
      const uint4 araw = *(const uint4*)(AA + (size_t)t * 512 + c0);
      float kv[8], av[8], kkv[8];
      kv[0] = bflo(kraw.x); kv[1] = bfhi(kraw.x); kv[2] = bflo(kraw.y); kv[3] = bfhi(kraw.y);
      kv[4] = bflo(kraw.z); kv[5] = bfhi(kraw.z); kv[6] = bflo(kraw.w); kv[7] = bfhi(kraw.w);
      av[0] = bflo(araw.x); av[1] = bfhi(araw.x); av[2] = bflo(araw.y); av[3] = bfhi(araw.y);
      av[4] = bflo(araw.z); av[5] = bfhi(araw.z); av[6] = bflo(araw.w); av[7] = bfhi(araw.w);
      float ss = 0.f;
#pragma unroll
      for (int i = 0; i < 8; ++i) { kkv[i] = kv[i] * p.k_k[c0 + i]; ss += kkv[i] * kkv[i]; }
      ss += __shfl_xor(ss, 1); ss += __shfl_xor(ss, 2); ss += __shfl_xor(ss, 4);
      const float inv = 1.f / fmaxf(sqrtf(ss), 1e-12f);
      float kn[8], bb[8], k2[8];
#pragma unroll
      for (int i = 0; i < 8; ++i) {
        kn[i] = kkv[i] * inv;
        bb[i] = kn[i] * av[i];
        k2[i] = kv[i] * (1.f + (av[i] - 1.f) * p.k_a[c0 + i]);
      }
      *(uint4*)(KK + (size_t)t * 512 + c0) = make_uint4(pack2(kn[0], kn[1]), pack2(kn[2], kn[3]), pack2(kn[4], kn[5]), pack2(kn[6], kn[7]));
      *(uint4*)(BB + (size_t)t * 512 + c0) = make_uint4(pack2(bb[0], bb[1]), pack2(bb[2], bb[3]), pack2(bb[4], bb[5]), pack2(bb[6], bb[7]));
      *(uint4*)(KS + (size_t)t * 512 + c0) = make_uint4(pack2(k2[0], k2[1]), pack2(k2[2], k2[3]), pack2(k2[4], k2[5]), pack2(k2[6], k2[7]));
    }
  }
}

DI s16x4 tr_read(unsigned lds_addr) {
  s16x4 r;
  asm volatile("ds_read_b64_tr_b16 %0, %1\n\ts_waitcnt lgkmcnt(0)" : "=&v"(r) : "v"(lds_addr) : "memory");
  return r;
}
#define MFMA32(a, b, c) __builtin_amdgcn_mfma_f32_32x32x16_bf16((a), (b), (c), 0, 0, 0)

constexpr int KLD = 208, VLD = 192;
constexpr int ATT_KOFF = 0, ATT_VOFF = 64 * KLD;
DI void phase_attn(const Params& p, int bid, int nblk, char* smem) {
  char* ws = p.ws;
  const u16* Q = (const u16*)((char*)p.out + DO_Q);
  const u16* Kd = (const u16*)((char*)p.out + DO_K);
  const u16* KVRAW = (const u16*)(ws + OFF_KVRAW);
  u16* Y = (u16*)(ws + OFF_Y);
  const int tid = threadIdx.x, w = tid >> 6, lane = tid & 63, r = lane & 31, hh = lane >> 5;
  const unsigned lds_base = (unsigned)(size_t)smem;
  for (int it = bid; it < 2048; it += nblk) {
    const int rd = it >> 9, pos = it & 511, g = pos >> 7, bh = pos & 127;
    const int m = rd == 0 ? 15 - g : rd == 1 ? 8 + g : rd == 2 ? 7 - g : g;
    const int b = bh >> 3, h = bh & 7;
    const int t0 = b * SEQ + 128 * m;
    const int cw = 2 * m + (w >> 1);
    const int tq = t0 + 32 * w + r;
    bf16x8 qf[6];
#pragma unroll
    for (int ks = 0; ks < 6; ++ks) qf[ks] = *reinterpret_cast<const bf16x8*>(Q + (size_t)tq * 768 + h * 96 + 16 * ks + 8 * hh);
    f32x16 O0, O1;
#pragma unroll
    for (int i = 0; i < 16; ++i) { O0[i] = 0.f; O1[i] = 0.f; }
    float mrun = -1e30f, lrun = 0.f;
    const int nkt = 2 * m + 2;
    for (int kt = 0; kt < nkt; ++kt) {
      __syncthreads();
      const int tk0 = b * SEQ + 64 * kt;
#pragma unroll
      for (int i = 0; i < 3; ++i) {
        const int c = tid + 256 * i, row = c / 12, cc = c % 12;
        const uint4 v = *(const uint4*)(Kd + (size_t)(tk0 + row) * 768 + h * 96 + cc * 8);
        *(uint4*)(smem + ATT_KOFF + row * KLD + cc * 16) = v;
      }
#pragma unroll
      for (int i = 0; i < 2; ++i) {
        const int c = tid + 256 * i, row = c >> 3, cc = c & 7;
        const uint4 v = *(const uint4*)(KVRAW + (size_t)(tk0 + row) * 1024 + 512 + h * 64 + cc * 8);
        *(uint4*)(smem + ATT_VOFF + row * VLD + cc * 16) = v;
      }
      __syncthreads();
      if (kt <= cw) {
        f32x16 X[2];
#pragma unroll
        for (int sub = 0; sub < 2; ++sub) {
#pragma unroll
          for (int i = 0; i < 16; ++i) X[sub][i] = 0.f;
#pragma unroll
          for (int ks = 0; ks < 6; ++ks) {
            const bf16x8 a = *reinterpret_cast<const bf16x8*>(smem + ATT_KOFF + (32 * sub + r) * KLD + (16 * ks + 8 * hh) * 2);
            X[sub] = MFMA32(a, qf[ks], X[sub]);
          }
        }
        float mx = X[0][0];
#pragma unroll
        for (int i = 0; i < 16; ++i) { mx = fmaxf(mx, X[0][i]); mx = fmaxf(mx, X[1][i]); }
        mx = fmaxf(mx, __shfl_xor(mx, 32));
        const float mnew = fmaxf(mrun, mx);
        const float alpha = exp2f(mrun - mnew);
        mrun = mnew;
        float rsum = 0.f;
#pragma unroll
        for (int sub = 0; sub < 2; ++sub)
#pragma unroll
          for (int i = 0; i < 16; ++i) { const float e = exp2f(X[sub][i] - mnew); X[sub][i] = e; rsum += e; }
        lrun = lrun * alpha + rsum;
#pragma unroll
        for (int i = 0; i < 16; ++i) { O0[i] *= alpha; O1[i] *= alpha; }
        const int i16 = lane & 15, q4 = i16 >> 2, p4 = i16 & 3, blk = (lane >> 4) & 1;
#pragma unroll
        for (int sub = 0; sub < 2; ++sub) {
#pragma unroll
          for (int s = 0; s < 2; ++s) {
            bf16x8 pb;
#pragma unroll
            for (int j = 0; j < 8; ++j) pb[j] = (short)f2bf(X[sub][8 * s + j]);
            const unsigned rowlo = 32 * sub + 16 * s + 4 * hh + q4;
#pragma unroll
            for (int dt = 0; dt < 2; ++dt) {
              const unsigned colb = (32 * dt + 16 * blk) * 2 + 8 * p4;
              const s16x4 lo = tr_read(lds_base + ATT_VOFF + rowlo * VLD + colb);
              const s16x4 hi = tr_read(lds_base + ATT_VOFF + (rowlo + 8) * VLD + colb);
              const bf16x8 a = __builtin_shufflevector(lo, hi, 0, 1, 2, 3, 4, 5, 6, 7);
              if (dt == 0) O0 = MFMA32(a, pb, O0); else O1 = MFMA32(a, pb, O1);
            }
          }
        }
      }
    }
    const float ltot = lrun + __shfl_xor(lrun, 32);
    const float inv = 1.f / ltot;
    float ss = 0.f;
#pragma unroll
    for (int i = 0; i < 16; ++i) { O0[i] *= inv; O1[i] *= inv; ss += O0[i] * O0[i] + O1[i] * O1[i]; }
    ss += __shfl_xor(ss, 32);
    const float rs = rsqrtf(ss * (1.f / 64.f) + EPS);
#pragma unroll
    for (int dt = 0; dt < 2; ++dt)
#pragma unroll
      for (int gq = 0; gq < 4; ++gq) {
        const int d = 32 * dt + 8 * gq + 4 * hh;
        const float* gp = p.g_attn_out + h * 64 + d;
        float o[4];
#pragma unroll
        for (int j = 0; j < 4; ++j) o[j] = (dt == 0 ? O0[4 * gq + j] : O1[4 * gq + j]) * rs * gp[j];
        *(uint2*)(Y + (size_t)tq * 1024 + h * 64 + d) = make_uint2(pack2(o[0], o[1]), pack2(o[2], o[3]));
      }
  }
}

DI float row16_allsum(float v) {
  v += __shfl_xor(v, 8); v += __shfl_xor(v, 4); v += __shfl_xor(v, 2); v += __shfl_xor(v, 1);
  return v;
}
struct ScanIn { uint2 kk, u, b, k, r; u16 v; };
DI void scan_load(ScanIn& s, const u16* KK, const u16* U, const u16* BB, const u16* KS, const u16* RS, const u16* VS,
                  size_t tok, int cj, int ci) {
  const size_t o = tok * 512;
  s.kk = *(const uint2*)(KK + o + cj); s.u = *(const uint2*)(U + o + cj); s.b = *(const uint2*)(BB + o + cj);
  s.k = *(const uint2*)(KS + o + cj); s.r = *(const uint2*)(RS + o + cj); s.v = VS[o + ci];
}
DI void phase_scan(const Params& p, int bid, int nblk, char* smem) {
  char* ws = p.ws;
  const u16* KK = (const u16*)(ws + OFF_KK); const u16* U = (const u16*)(ws + OFF_U); const u16* BB = (const u16*)(ws + OFF_BB);
  const u16* KS = (const u16*)(ws + OFF_KS); const u16* RS = (const u16*)(ws + OFF_RS); const u16* VS = (const u16*)(ws + OFF_VS);
  float* YRAW = (float*)(ws + OFF_YRAW);
  const int tid = threadIdx.x, w = tid >> 6, lane = tid & 63, jq = lane & 15;
  for (int unit = bid; unit < 512; unit += nblk) {
    const int bh = unit >> 2, rg = unit & 3, b = bh >> 3, h = bh & 7;
    const int i = 16 * rg + 4 * w + (lane >> 4);
    const int cj = h * 64 + 4 * jq, ci = h * 64 + i;
    const size_t tb = (size_t)b * SEQ;
    float S0 = 0.f, S1 = 0.f, S2 = 0.f, S3 = 0.f;
    constexpr int PF = 8;
    ScanIn cur[PF], nxt[PF];
#pragma unroll
    for (int q = 0; q < PF; ++q) scan_load(cur[q], KK, U, BB, KS, RS, VS, tb + q, cj, ci);
    for (int s0 = 0; s0 < SEQ; s0 += PF) {
      if (s0 + PF < SEQ) {
#pragma unroll
        for (int q = 0; q < PF; ++q) scan_load(nxt[q], KK, U, BB, KS, RS, VS, tb + s0 + PF + q, cj, ci);
      }
#pragma unroll
      for (int q = 0; q < PF; ++q) {
        const ScanIn& c = cur[q];
        const float kk0 = bflo(c.kk.x), kk1 = bfhi(c.kk.x), kk2 = bflo(c.kk.y), kk3 = bfhi(c.kk.y);
        float sk = S0 * kk0 + S1 * kk1 + S2 * kk2 + S3 * kk3;
        sk = row16_allsum(sk);
        const float v = bf2f(c.v);
        S0 = S0 * (1.f - bflo(c.u.x)) - sk * bflo(c.b.x) + v * bflo(c.k.x);
        S1 = S1 * (1.f - bfhi(c.u.x)) - sk * bfhi(c.b.x) + v * bfhi(c.k.x);
        S2 = S2 * (1.f - bflo(c.u.y)) - sk * bflo(c.b.y) + v * bflo(c.k.y);
        S3 = S3 * (1.f - bfhi(c.u.y)) - sk * bfhi(c.b.y) + v * bfhi(c.k.y);
        float y = S0 * bflo(c.r.x) + S1 * bfhi(c.r.x) + S2 * bflo(c.r.y) + S3 * bfhi(c.r.y);
        y = row16_allsum(y);
        if (jq == 0) YRAW[(tb + s0 + q) * 512 + ci] = y;
      }
#pragma unroll
      for (int q = 0; q < PF; ++q) cur[q] = nxt[q];
    }
  }
}

DI void phase_3c(const Params& p, int bid, int nblk, char* smem) {
  char* ws = p.ws;
  const float* YRAW = (const float*)(ws + OFF_YRAW);
  const u16* KS = (const u16*)(ws + OFF_KS); const u16* RS = (const u16*)(ws + OFF_RS); const u16* VS = (const u16*)(ws + OFF_VS);
  const u16* G = (const u16*)(ws + OFF_G);
  u16* Y = (u16*)(ws + OFF_Y);
  const int tid = threadIdx.x, wid = tid >> 6, lane = tid & 63;
  for (int t = bid * 4 + wid; t < T; t += nblk * 4) {
    const int c0 = 8 * lane;
    const float4 y0 = *(const float4*)(YRAW + (size_t)t * 512 + c0);
    const float4 y1 = *(const float4*)(YRAW + (size_t)t * 512 + c0 + 4);
    float y[8] = {y0.x, y0.y, y0.z, y0.w, y1.x, y1.y, y1.z, y1.w};
    const uint4 rr = *(const uint4*)(RS + (size_t)t * 512 + c0);
    const uint4 kr = *(const uint4*)(KS + (size_t)t * 512 + c0);
    const uint4 vr = *(const uint4*)(VS + (size_t)t * 512 + c0);
    const uint4 gr = *(const uint4*)(G + (size_t)t * 512 + c0);
    float rv[8] = {bflo(rr.x), bfhi(rr.x), bflo(rr.y), bfhi(rr.y), bflo(rr.z), bfhi(rr.z), bflo(rr.w), bfhi(rr.w)};
    float kv[8] = {bflo(kr.x), bfhi(kr.x), bflo(kr.y), bfhi(kr.y), bflo(kr.z), bfhi(kr.z), bflo(kr.w), bfhi(kr.w)};
    float vv[8] = {bflo(vr.x), bfhi(vr.x), bflo(vr.y), bfhi(vr.y), bflo(vr.z), bfhi(vr.z), bflo(vr.w), bfhi(vr.w)};
    float gv[8] = {bflo(gr.x), bfhi(gr.x), bflo(gr.y), bfhi(gr.y), bflo(gr.z), bfhi(gr.z), bflo(gr.w), bfhi(gr.w)};
    float sm = 0.f, bsum = 0.f;
#pragma unroll
    for (int i = 0; i < 8; ++i) { sm += y[i]; bsum += rv[i] * kv[i] * p.r_k[c0 + i]; }
    sm += __shfl_xor(sm, 1); sm += __shfl_xor(sm, 2); sm += __shfl_xor(sm, 4);
    bsum += __shfl_xor(bsum, 1); bsum += __shfl_xor(bsum, 2); bsum += __shfl_xor(bsum, 4);
    const float mu = sm * (1.f / 64.f);
    float var = 0.f;
#pragma unroll
    for (int i = 0; i < 8; ++i) { const float d = y[i] - mu; var += d * d; }
    var += __shfl_xor(var, 1); var += __shfl_xor(var, 2); var += __shfl_xor(var, 4);
    const float rs = rsqrtf(var * (1.f / 64.f) + 64e-5f);
    float o[8];
#pragma unroll
    for (int i = 0; i < 8; ++i) o[i] = ((y[i] - mu) * rs * p.ln_x_w[c0 + i] + p.ln_x_b[c0 + i] + bsum * vv[i]) * gv[i];
    *(uint4*)(Y + (size_t)t * 1024 + 512 + c0) = make_uint4(pack2(o[0], o[1]), pack2(o[2], o[3]), pack2(o[4], o[5]), pack2(o[6], o[7]));
  }
}

DI void phase_wo(const Params& p, int bid, int nblk, char* smem) {
  char* ws = p.ws;
  const int tid = threadIdx.x;
  {
    uint2* EU = (uint2*)(ws + OFF_EU); uint2* EV = (uint2*)(ws + OFF_EV);
    const float4* su = (const float4*)p.expert_u; const float4* sv = (const float4*)p.expert_v;
    const float4* gf = (const float4*)p.g_ffn;
    for (size_t i = (size_t)bid * NTHR + tid; i < (size_t)16384 * 256; i += (size_t)nblk * NTHR) {
      const float4 g = gf[i & 255];
      const float4 a = su[i], b = sv[i];
      EU[i] = make_uint2(pack2(a.x * g.x, a.y * g.y), pack2(a.z * g.z, a.w * g.w));
      EV[i] = make_uint2(pack2(b.x, b.y), pack2(b.z, b.w));
    }
  }
  const u16* Y = (const u16*)(ws + OFF_Y);
  const int NT = 8;
  for (int tl = bid; tl < 256 * NT; tl += nblk) {
    const int mt = tl / NT, nt = tl % NT;
    gemm_tile(Y, 1024, (const u16*)(ws + OFF_WOT), 1024, 1024, mt * 128, nt * 128,
              [&](int r, int c, float v) { p.out[(size_t)r * DM + c] = p.x[(size_t)r * DM + c] + v; }, smem);
  }
}

DI void phase_5(const Params& p, int bid, int nblk, char* smem) {
  char* ws = p.ws;
  const int tid = threadIdx.x, wid = tid >> 6, lane = tid & 63;
  for (int row = bid * 4 + wid; row < T; row += nblk * 4) {
    const float4* xr = (const float4*)(p.out + (size_t)row * DM);
    uint2* xb = (uint2*)(ws + OFF_X2B + (size_t)row * DM * 2);
    float ss = 0.f;
#pragma unroll
    for (int i = 0; i < 4; ++i) {
      const float4 v = xr[lane + 64 * i];
      ss += v.x * v.x + v.y * v.y + v.z * v.z + v.w * v.w;
      xb[lane + 64 * i] = make_uint2(pack2(v.x, v.y), pack2(v.z, v.w));
    }
    ss = wave_allsum(ss);
    if (lane == 0) ((float*)(ws + OFF_RSTD2))[row] = rsqrtf(ss * (1.f / DM) + EPS);
  }
}

DI void phase_6(const Params& p, int bid, int nblk, char* smem) {
  char* ws = p.ws;
  const float* rstd = (const float*)(ws + OFF_RSTD2);
  u16* QP = (u16*)(ws + OFF_QP);
  const int NT = 16;
  for (int tl = bid; tl < 256 * NT; tl += nblk) {
    const int mt = tl / NT, nt = tl % NT;
    gemm_tile((const u16*)(ws + OFF_X2B), 1024, (const u16*)(ws + OFF_WPQT), 1024, 1024, mt * 128, nt * 128,
              [&](int r, int c, float v) { QP[(size_t)r * 2048 + c] = f2bf(v * rstd[r]); }, smem);
  }
}

DI void ins16(float (&top)[16], float x) {
#pragma unroll
  for (int i = 0; i < 16; ++i) { const float hi = fmaxf(top[i], x); x = fminf(top[i], x); top[i] = hi; }
}
DI void phase_7(const Params& p, int bid, int nblk, char* smem) {
  char* ws = p.ws;
  const u16* QP = (const u16*)(ws + OFF_QP);
  const u16* SUBK = (const u16*)(ws + OFF_SUBK);
  int* IDX = (int*)(ws + OFF_IDX); float* GATE = (float*)(ws + OFF_GATE);
  float* lists = (float*)smem;
  const int tid = threadIdx.x, w = tid >> 6, lane = tid & 63, r = lane & 31, hh = lane >> 5;
  const int th = w & 1, pp = w >> 1;
  for (int it = bid; it < 512 * 8; it += nblk) {
    const int tt = it >> 3, h = it & 7;
    const int t = tt * 64 + 32 * th + r;
    bf16x8 qf[8];
#pragma unroll
    for (int ks = 0; ks < 8; ++ks) qf[ks] = *reinterpret_cast<const bf16x8*>(QP + (size_t)t * 2048 + h * 256 + pp * 128 + 16 * ks + 8 * hh);
    const u16* sk = SUBK + (size_t)(h * 2 + pp) * 128 * 128;
    float top[16];
#pragma unroll
    for (int i = 0; i < 16; ++i) top[i] = -INFINITY;
#pragma unroll
    for (int kt = 0; kt < 4; ++kt) {
      f32x16 acc;
#pragma unroll
      for (int i = 0; i < 16; ++i) acc[i] = 0.f;
#pragma unroll
      for (int ks = 0; ks < 8; ++ks) {
        const bf16x8 a = *reinterpret_cast<const bf16x8*>(sk + (size_t)(32 * kt + r) * 128 + 16 * ks + 8 * hh);
        acc = MFMA32(a, qf[ks], acc);
      }
#pragma unroll
      for (int i = 0; i < 16; ++i) {
        const unsigned key = 32 * kt + (i & 3) + 8 * (i >> 2) + 4 * hh;
        const float v = __uint_as_float((__float_as_uint(acc[i]) & ~127u) | key);
        ins16(top, v);
      }
    }
    float oth[16];
#pragma unroll
    for (int i = 0; i < 16; ++i) oth[i] = __shfl_xor(top[i], 32);
#pragma unroll
    for (int i = 0; i < 16; ++i) ins16(top, oth[i]);
    __syncthreads();
    if (hh == 0) {
      float* dst = lists + ((32 * th + r) * 2 + pp) * 16;
#pragma unroll
      for (int i = 0; i < 16; i += 4) *(float4*)(dst + i) = make_float4(top[i], top[i + 1], top[i + 2], top[i + 3]);
    }
    __syncthreads();
    if (tid < 64) {
      const float* l1 = lists + (tid * 2 + 0) * 16;
      const float* l2 = lists + (tid * 2 + 1) * 16;
      float s1[16], s2[16];
#pragma unroll
      for (int i = 0; i < 16; ++i) {
        s1[i] = __uint_as_float(__float_as_uint(l1[i]) & ~127u);
        s2[i] = __uint_as_float(__float_as_uint(l2[i]) & ~127u);
      }
      float ts[16];
#pragma unroll
      for (int i = 0; i < 16; ++i) ts[i] = -INFINITY;
#pragma unroll
      for (int a = 0; a < 16; ++a)
#pragma unroll
        for (int b = 0; b < 16; ++b)
          if ((a + 1) * (b + 1) <= 16) {
            const float sm = s1[a] + s2[b];
            ins16(ts, __uint_as_float((__float_as_uint(sm) & ~255u) | (unsigned)(a * 16 + b)));
          }
      const size_t ob = ((size_t)(tt * 64 + tid) * 8 + h) * 16;
      float e[16], esum = 0.f;
      const float mx = __uint_as_float(__float_as_uint(ts[0]) & ~255u);
#pragma unroll
      for (int i = 0; i < 16; ++i) {
        const unsigned bits = __float_as_uint(ts[i]);
        const unsigned cid = bits & 255u;
        const float val = __uint_as_float(bits & ~255u);
        e[i] = __expf(val - mx); esum += e[i];
        const unsigned i1 = __float_as_uint(l1[cid >> 4]) & 127u, i2 = __float_as_uint(l2[cid & 15]) & 127u;
        IDX[ob + i] = (int)(i1 * 128 + i2);
      }
      const float inv = 1.f / esum;
#pragma unroll
      for (int i = 0; i < 16; ++i) GATE[ob + i] = e[i] * inv;
    }
  }
}

DI void phase_8(const Params& p, int bid, int nblk, char* smem) {
  char* ws = p.ws;
  const u16* X2B = (const u16*)(ws + OFF_X2B);
  const u16* EU = (const u16*)(ws + OFF_EU); const u16* EV = (const u16*)(ws + OFF_EV);
  const int* IDX = (const int*)(ws + OFF_IDX); const float* GATE = (const float*)(ws + OFF_GATE);
  const float* rstd2 = (const float*)(ws + OFF_RSTD2);
  const int tid = threadIdx.x, wid = tid >> 6, lane = tid & 63;
  for (int t = bid * 4 + wid; t < T; t += nblk * 4) {
    float xh[16];
    {
      const uint4 a = *(const uint4*)(X2B + (size_t)t * DM + 16 * lane);
      const uint4 b = *(const uint4*)(X2B + (size_t)t * DM + 16 * lane + 8);
      xh[0] = bflo(a.x); xh[1] = bfhi(a.x); xh[2] = bflo(a.y); xh[3] = bfhi(a.y); xh[4] = bflo(a.z); xh[5] = bfhi(a.z); xh[6] = bflo(a.w); xh[7] = bfhi(a.w);
      xh[8] = bflo(b.x); xh[9] = bfhi(b.x); xh[10] = bflo(b.y); xh[11] = bfhi(b.y); xh[12] = bflo(b.z); xh[13] = bfhi(b.z); xh[14] = bflo(b.w); xh[15] = bfhi(b.w);
    }
    const float rs = rstd2[t];
    const int id0 = IDX[(size_t)t * 128 + lane], id1 = IDX[(size_t)t * 128 + 64 + lane];
    const float g0 = GATE[(size_t)t * 128 + lane], g1 = GATE[(size_t)t * 128 + 64 + lane];
    float acc[16];
#pragma unroll
    for (int i = 0; i < 16; ++i) acc[i] = 0.f;
    for (int k0 = 0; k0 < 128; k0 += 4) {
      uint4 ua[4], ub[4], va[4], vb[4];
      float gt[4];
#pragma unroll
      for (int q = 0; q < 4; ++q) {
        const int k = k0 + q;
        const int e = __shfl(k < 64 ? id0 : id1, k & 63);
        gt[q] = __shfl(k < 64 ? g0 : g1, k & 63);
        const u16* up = EU + (size_t)e * DM + 16 * lane;
        const u16* vp = EV + (size_t)e * DM + 16 * lane;
        ua[q] = *(const uint4*)up; ub[q] = *(const uint4*)(up + 8);
        va[q] = *(const uint4*)vp; vb[q] = *(const uint4*)(vp + 8);
      }
#pragma unroll
      for (int q = 0; q < 4; ++q) {
        float d = xh[0] * bflo(ua[q].x) + xh[1] * bfhi(ua[q].x) + xh[2] * bflo(ua[q].y) + xh[3] * bfhi(ua[q].y)
                + xh[4] * bflo(ua[q].z) + xh[5] * bfhi(ua[q].z) + xh[6] * bflo(ua[q].w) + xh[7] * bfhi(ua[q].w)
                + xh[8] * bflo(ub[q].x) + xh[9] * bfhi(ub[q].x) + xh[10] * bflo(ub[q].y) + xh[11] * bfhi(ub[q].y)
                + xh[12] * bflo(ub[q].z) + xh[13] * bfhi(ub[q].z) + xh[14] * bflo(ub[q].w) + xh[15] * bfhi(ub[q].w);
        d = wave_allsum(d) * rs;
        const float wg = gt[q] * 0.5f * d * (1.f + erff(d * 0.70710678118654752f));
        acc[0] += wg * bflo(va[q].x); acc[1] += wg * bfhi(va[q].x); acc[2] += wg * bflo(va[q].y); acc[3] += wg * bfhi(va[q].y);
        acc[4] += wg * bflo(va[q].z); acc[5] += wg * bfhi(va[q].z); acc[6] += wg * bflo(va[q].w); acc[7] += wg * bfhi(va[q].w);
        acc[8] += wg * bflo(vb[q].x); acc[9] += wg * bfhi(vb[q].x); acc[10] += wg * bflo(vb[q].y); acc[11] += wg * bfhi(vb[q].y);
        acc[12] += wg * bflo(vb[q].z); acc[13] += wg * bfhi(vb[q].z); acc[14] += wg * bflo(vb[q].w); acc[15] += wg * bfhi(vb[q].w);
      }
    }
    float4* op = (float4*)(p.out + (size_t)t * DM + 16 * lane);
#pragma unroll
    for (int i = 0; i < 4; ++i) {
      float4 v = op[i];
      v.x += acc[4 * i]; v.y += acc[4 * i + 1]; v.z += acc[4 * i + 2]; v.w += acc[4 * i + 3];
      op[i] = v;
    }
  }
}

constexpr int NPHASE = 12;
template <int PH>
DI void run_phase(const Params& p, int bid, int nblk, char* smem) {
  if constexpr (PH == 0) phase_prep(p, bid, nblk, smem);
  else if constexpr (PH == 1) phase_gemm1(p, bid, nblk, smem);
  else if constexpr (PH == 2) phase_2a(p, bid, nblk, smem);
  else if constexpr (PH == 3) phase_2b(p, bid, nblk, smem);
  else if constexpr (PH == 4) phase_2c(p, bid, nblk, smem);
  else if constexpr (PH == 5) phase_attn(p, bid, nblk, smem);
  else if constexpr (PH == 6) phase_scan(p, bid, nblk, smem);
  else if constexpr (PH == 7) phase_3c(p, bid, nblk, smem);
  else if constexpr (PH == 8) phase_wo(p, bid, nblk, smem);
  else if constexpr (PH == 9) phase_5(p, bid, nblk, smem);
  else if constexpr (PH == 10) phase_6(p, bid, nblk, smem);
  else if constexpr (PH == 11) { phase_7(p, bid, nblk, smem); }
  else phase_8(p, bid, nblk, smem);
}

constexpr int SMEM_BYTES = 32768;

#if MEGA
__global__ void __launch_bounds__(NTHR, 2) mega_kernel(Params p) {
  __shared__ __attribute__((aligned(16))) char smem[SMEM_BYTES];
  cg::grid_group grid = cg::this_grid();
  const int bid = blockIdx.x, nblk = gridDim.x;
  run_phase<0>(p, bid, nblk, smem); grid.sync();
  run_phase<1>(p, bid, nblk, smem); grid.sync();
  run_phase<2>(p, bid, nblk, smem); grid.sync();
  run_phase<3>(p, bid, nblk, smem); grid.sync();
  run_phase<4>(p, bid, nblk, smem); grid.sync();
  run_phase<5>(p, bid, nblk, smem); grid.sync();
  run_phase<6>(p, bid, nblk, smem); grid.sync();
  run_phase<7>(p, bid, nblk, smem); grid.sync();
  run_phase<8>(p, bid, nblk, smem); grid.sync();
  run_phase<9>(p, bid, nblk, smem); grid.sync();
  run_phase<10>(p, bid, nblk, smem); grid.sync();
  run_phase<11>(p, bid, nblk, smem); grid.sync();
  run_phase<12>(p, bid, nblk, smem);
}
#else
template <int PH>
__global__ void __launch_bounds__(NTHR, 2) phase_kernel(Params p) {
  __shared__ __attribute__((aligned(16))) char smem[SMEM_BYTES];
  run_phase<PH>(p, blockIdx.x, gridDim.x, smem);
}
#endif

extern "C" void kernel_launch(void* const* d_in, const int* in_sizes, int n_in, void* d_out, int out_size, void* d_ws,
                              size_t ws_size, hipStream_t stream) {
  Params p{};
  p.x = (const float*)d_in[0]; p.pos = (const int*)d_in[1];
  p.g_mix = (const float*)d_in[2]; p.w_in = (const float*)d_in[3]; p.rwkv_mu = (const float*)d_in[4];
  p.g_cq = (const float*)d_in[5]; p.g_ckv = (const float*)d_in[6]; p.w_uq = (const float*)d_in[7];
  p.w_uk = (const float*)d_in[8]; p.w_uv = (const float*)d_in[9]; p.g_qnorm = (const float*)d_in[10];
  p.g_knorm = (const float*)d_in[11]; p.g_attn_out = (const float*)d_in[12]; p.w0 = (const float*)d_in[13];
  p.w2 = (const float*)d_in[14]; p.a0 = (const float*)d_in[15]; p.a2 = (const float*)d_in[16];
  p.g2 = (const float*)d_in[17]; p.k_k = (const float*)d_in[18]; p.k_a = (const float*)d_in[19];
  p.r_k = (const float*)d_in[20]; p.ln_x_w = (const float*)d_in[21]; p.ln_x_b = (const float*)d_in[22];
  p.w_o = (const float*)d_in[23]; p.g_ffn = (const float*)d_in[24]; p.w_pq = (const float*)d_in[25];
  p.sub_keys = (const float*)d_in[26]; p.expert_u = (const float*)d_in[27]; p.expert_v = (const float*)d_in[28];
  p.out = (float*)d_out; p.ws = (char*)d_ws;
#if MEGA
  static int grid_blocks = 0;
  if (!grid_blocks) {
    int dev = 0, cus = 0, per_cu = 0;
    hipGetDevice(&dev);
    hipDeviceGetAttribute(&cus, hipDeviceAttributeMultiprocessorCount, dev);
    hipOccupancyMaxActiveBlocksPerMultiprocessor(&per_cu, mega_kernel, NTHR, 0);
    if (per_cu > 2) per_cu = 2;
    grid_blocks = cus * per_cu;
  }
  void* args[] = {&p};
  hipError_t e = hipLaunchCooperativeKernel((void*)mega_kernel, dim3(grid_blocks), dim3(NTHR), args, 0, stream);
  if (e != hipSuccess) fprintf(stderr, "cooperative launch failed: %s (grid %d)\n", hipGetErrorString(e), grid_blocks);
#else
  const int NB = 512;
  phase_kernel<0><<<NB, NTHR, 0, stream>>>(p);
  phase_kernel<1><<<NB, NTHR, 0, stream>>>(p);
  phase_kernel<2><<<NB, NTHR, 0, stream>>>(p);
  phase_kernel<3><<<NB, NTHR, 0, stream>>>(p);
  phase_kernel<4><<<NB, NTHR, 0, stream>>>(p);
  phase_kernel<5><<<NB, NTHR, 0, stream>>>(p);
  phase_kernel<6><<<NB, NTHR, 0, stream>>>(p);
  phase_kernel<7><<<NB, NTHR, 0, stream>>>(p);
  phase_kernel<8><<<NB, NTHR, 0, stream>>>(p);
  phase_kernel<9><<<NB, NTHR, 0, stream>>>(p);
  phase_kernel<10><<<NB, NTHR, 0, stream>>>(p);
  phase_kernel<11><<<NB, NTHR, 0, stream>>>(p);
  phase_kernel<12><<<NB, NTHR, 0, stream>>>(p);
#endif
}
```

```cpp
#include <hip/hip_runtime.h>
#include <hip/hip_cooperative_groups.h>
#include <cstdio>
#include <cstdint>
namespace cg = cooperative_groups;

#ifndef MEGA
#define MEGA 1
#endif

typedef unsigned short u16;
using bf16x8 = __attribute__((ext_vector_type(8))) short;
using s16x4  = __attribute__((ext_vector_type(4))) short;
using f32x4  = __attribute__((ext_vector_type(4))) float;
using f32x16 = __attribute__((ext_vector_type(16))) float;
#define DI __device__ __forceinline__

constexpr int T = 32768, SEQ = 2048, DM = 1024;
constexpr int INC = 2464, MLAC = 672, RWC = 1792;
constexpr int NTHR = 256;
constexpr float EPS = 1e-6f;

constexpr size_t MiB = 1048576;
constexpr size_t OFF_WINT  = 0;
constexpr size_t OFF_WUQT  = OFF_WINT  + 2560 * 1024 * 2;
constexpr size_t OFF_WUKVT = OFF_WUQT  + 768 * 384 * 2;
constexpr size_t OFF_W2T   = OFF_WUKVT + 1024 * 256 * 2;
constexpr size_t OFF_A2T   = OFF_W2T   + 512 * 64 * 2;
constexpr size_t OFF_G2T   = OFF_A2T   + 512 * 64 * 2;
constexpr size_t OFF_WOT   = OFF_G2T   + 512 * 128 * 2;
constexpr size_t OFF_WPQT  = OFF_WOT   + 1024 * 1024 * 2;
constexpr size_t OFF_SUBK  = OFF_WPQT  + 2048 * 1024 * 2;
constexpr size_t OFF_ROPE  = OFF_SUBK  + 16 * 128 * 128 * 2;
constexpr size_t OFF_RSTD1 = OFF_ROPE  + (size_t)T * 32 * 4;
constexpr size_t OFF_RSTDQ = OFF_RSTD1 + (size_t)T * 4;
constexpr size_t OFF_RSTDKV= OFF_RSTDQ + (size_t)T * 4;
constexpr size_t OFF_RSTD2 = OFF_RSTDKV+ (size_t)T * 4;
constexpr size_t OFF_A_END = OFF_RSTD2 + (size_t)T * 4;
static_assert(OFF_A_END <= 19 * MiB, "region A");
constexpr size_t OFF_BAR   = 19 * MiB;
constexpr size_t OFF_XB    = 20 * MiB;
constexpr size_t OFF_Y     = OFF_XB;
constexpr size_t OFF_PM    = 84 * MiB;
constexpr size_t OFF_PR    = 126 * MiB;
constexpr size_t OFF_U     = OFF_PR;
constexpr size_t OFF_G     = OFF_PR + 32 * MiB;
constexpr size_t OFF_KK    = OFF_PR + 64 * MiB;
constexpr size_t OFF_KVRAW = 238 * MiB;
constexpr size_t OFF_QRAW  = 302 * MiB;
constexpr size_t OFF_LORAIN= 350 * MiB;
constexpr size_t OFF_YRAW  = 302 * MiB;
constexpr size_t OFF_RS    = 366 * MiB;
constexpr size_t OFF_KS    = 398 * MiB;
constexpr size_t OFF_VS    = 430 * MiB;
constexpr size_t OFF_BB    = 462 * MiB;
constexpr size_t OFF_EU    = 84 * MiB;
constexpr size_t OFF_EV    = 116 * MiB;
constexpr size_t OFF_X2B   = 148 * MiB;
constexpr size_t OFF_QP    = 238 * MiB;
constexpr size_t OFF_IDX   = 366 * MiB;
constexpr size_t OFF_GATE  = 382 * MiB;
constexpr size_t DO_Q = 0, DO_K = (size_t)T * 768 * 2, DO_AA = (size_t)T * 768 * 4;

struct Params {
  const float* x; const int* pos;
  const float *g_mix, *w_in, *rwkv_mu, *g_cq, *g_ckv, *w_uq, *w_uk, *w_uv, *g_qnorm, *g_knorm, *g_attn_out;
  const float *w0, *w2, *a0, *a2, *g2, *k_k, *k_a, *r_k, *ln_x_w, *ln_x_b, *w_o, *g_ffn, *w_pq, *sub_keys, *expert_u, *expert_v;
  float* out; char* ws;
};

DI u16 f2bf(float x) { unsigned u = __float_as_uint(x); u += 0x7fffu + ((u >> 16) & 1u); return (u16)(u >> 16); }
DI float bf2f(u16 h) { return __uint_as_float(((unsigned)h) << 16); }
DI unsigned pack2(float a, float b) { return (unsigned)f2bf(a) | ((unsigned)f2bf(b) << 16); }
DI float bflo(unsigned u) { return __uint_as_float(u << 16); }
DI float bfhi(unsigned u) { return __uint_as_float(u & 0xffff0000u); }
DI float wave_allsum(float v) {
#pragma unroll
  for (int o = 32; o > 0; o >>= 1) v += __shfl_xor(v, o);
  return v;
}
DI float sigmoidf_(float x) { return 1.f / (1.f + __expf(-x)); }

DI void tconv(const float* __restrict__ src, int K, int N, const float* __restrict__ scale, u16* __restrict__ dst,
              int ldd, int noff, int bid, int nblk, float* tile) {
  const int tid = threadIdx.x, tx = tid & 31, ty = tid >> 5;
  const int nbn = N / 32, ntl = (K / 32) * nbn;
  for (int tl = bid; tl < ntl; tl += nblk) {
    const int kb = tl / nbn, nb = tl % nbn;
#pragma unroll
    for (int i = 0; i < 4; ++i) {
      const int k = kb * 32 + ty + 8 * i;
      float v = src[(size_t)k * N + nb * 32 + tx];
      if (scale) v *= scale[k];
      tile[(ty + 8 * i) * 33 + tx] = v;
    }
    __syncthreads();
#pragma unroll
    for (int i = 0; i < 4; ++i) {
      const int n = nb * 32 + ty + 8 * i;
      dst[(size_t)(noff + n) * ldd + kb * 32 + tx] = f2bf(tile[tx * 33 + ty + 8 * i]);
    }
    __syncthreads();
  }
}

DI void phase_prep(const Params& p, int bid, int nblk, char* smem) {
  float* tile = (float*)smem;
  char* ws = p.ws;
  const int tid = threadIdx.x;
  tconv(p.w_in, 1024, INC, p.g_mix, (u16*)(ws + OFF_WINT), 1024, 0, bid, nblk, tile);
  for (int i = bid * NTHR + tid; i < 96 * 1024; i += nblk * NTHR) ((u16*)(ws + OFF_WINT))[2464 * 1024 + i] = 0;
  tconv(p.w_uq, 384, 768, p.g_cq, (u16*)(ws + OFF_WUQT), 384, 0, bid, nblk, tile);
  tconv(p.w_uk, 256, 512, p.g_ckv, (u16*)(ws + OFF_WUKVT), 256, 0, bid, nblk, tile);
  tconv(p.w_uv, 256, 512, p.g_ckv, (u16*)(ws + OFF_WUKVT), 256, 512, bid, nblk, tile);
  tconv(p.w2, 64, 512, nullptr, (u16*)(ws + OFF_W2T), 64, 0, bid, nblk, tile);
  tconv(p.a2, 64, 512, nullptr, (u16*)(ws + OFF_A2T), 64, 0, bid, nblk, tile);
  tconv(p.g2, 128, 512, nullptr, (u16*)(ws + OFF_G2T), 128, 0, bid, nblk, tile);
  tconv(p.w_o, 1024, 1024, nullptr, (u16*)(ws + OFF_WOT), 1024, 0, bid, nblk, tile);
  tconv(p.w_pq, 1024, 2048, p.g_ffn, (u16*)(ws + OFF_WPQT), 1024, 0, bid, nblk, tile);
  for (int i = bid * NTHR + tid; i < 16 * 128 * 128; i += nblk * NTHR) ((u16*)(ws + OFF_SUBK))[i] = f2bf(p.sub_keys[i]);
  for (int i = bid * NTHR + tid; i < T * 16; i += nblk * NTHR) {
    const int t = i >> 4, j = i & 15;
    const float inv = powf(10000.0f, -(float)j / 16.0f);
    const float ang = (float)p.pos[t] * inv;
    float s, c; sincosf(ang, &s, &c);
    float* rp = (float*)(ws + OFF_ROPE) + (size_t)t * 32;
    rp[j] = c; rp[16 + j] = s;
  }
  const int wid = tid >> 6, lane = tid & 63;
  for (int row = bid * 4 + wid; row < T; row += nblk * 4) {
    const float4* xr = (const float4*)(p.x + (size_t)row * DM);
    uint2* xb = (uint2*)(ws + OFF_XB + (size_t)row * DM * 2);
    float ss = 0.f;
#pragma unroll
    for (int i = 0; i < 4; ++i) {
      const float4 v = xr[lane + 64 * i];
      ss += v.x * v.x + v.y * v.y + v.z * v.z + v.w * v.w;
      xb[lane + 64 * i] = make_uint2(pack2(v.x, v.y), pack2(v.z, v.w));
    }
    ss = wave_allsum(ss);
    if (lane == 0) ((float*)(ws + OFF_RSTD1))[row] = rsqrtf(ss * (1.f / DM) + EPS);
  }
}

template <class Epi>
DI void gemm_tile(const u16* __restrict__ A, int lda, const u16* __restrict__ Bt, int ldb, int K, int m0, int n0,
                  Epi epi, char* smem) {
  u16* SA = (u16*)smem;
  u16* SB = SA + 128 * 32;
  const int tid = threadIdx.x, wid = tid >> 6, lane = tid & 63, wr = wid >> 1, wc = wid & 1, fr = lane & 15, fq = lane >> 4;
  f32x4 acc[4][4];
#pragma unroll
  for (int m = 0; m < 4; ++m)
#pragma unroll
    for (int n = 0; n < 4; ++n) acc[m][n] = f32x4{0.f, 0.f, 0.f, 0.f};
  const int nk = K / 32;
  for (int kt = 0; kt < nk; ++kt) {
#pragma unroll
    for (int i = 0; i < 2; ++i) {
      const int b = tid * 16 + i * 4096, r = b / 64, c = (b % 64) / 2;
      __builtin_amdgcn_global_load_lds((const unsigned*)(A + (size_t)(m0 + r) * lda + kt * 32 + c),
                                       (__attribute__((address_space(3))) unsigned*)((char*)SA + b), 16, 0, 0);
      __builtin_amdgcn_global_load_lds((const unsigned*)(Bt + (size_t)(n0 + r) * ldb + kt * 32 + c),
                                       (__attribute__((address_space(3))) unsigned*)((char*)SB + b), 16, 0, 0);
    }
    asm volatile("s_waitcnt vmcnt(0)" ::: "memory");
    __syncthreads();
    bf16x8 af[4], bfr[4];
#pragma unroll
    for (int m = 0; m < 4; ++m) af[m] = *reinterpret_cast<const bf16x8*>((char*)SA + (wr * 64 + m * 16 + fr) * 64 + fq * 16);
#pragma unroll
    for (int n = 0; n < 4; ++n) bfr[n] = *reinterpret_cast<const bf16x8*>((char*)SB + (wc * 64 + n * 16 + fr) * 64 + fq * 16);
#pragma unroll
    for (int m = 0; m < 4; ++m)
#pragma unroll
      for (int n = 0; n < 4; ++n) acc[m][n] = __builtin_amdgcn_mfma_f32_16x16x32_bf16(af[m], bfr[n], acc[m][n], 0, 0, 0);
    __syncthreads();
  }
#pragma unroll
  for (int m = 0; m < 4; ++m)
#pragma unroll
    for (int n = 0; n < 4; ++n)
#pragma unroll
      for (int j = 0; j < 4; ++j) epi(m0 + wr * 64 + m * 16 + fq * 4 + j, n0 + wc * 64 + n * 16 + fr, acc[m][n][j]);
}

DI void phase_gemm1(const Params& p, int bid, int nblk, char* smem) {
  char* ws = p.ws;
  const u16* A = (const u16*)(ws + OFF_XB);
  const u16* Bt = (const u16*)(ws + OFF_WINT);
  const float* rstd = (const float*)(ws + OFF_RSTD1);
  u16* PM = (u16*)(ws + OFF_PM);
  u16* PR = (u16*)(ws + OFF_PR);
  const int NT = 20;
  for (int tl = bid; tl < 256 * NT; tl += nblk) {
    const int mt = tl / NT, nt = tl % NT;
    gemm_tile(A, 1024, Bt, 1024, 1024, mt * 128, nt * 128,
              [&](int r, int c, float v) {
                if (c < INC) {
                  const u16 o = f2bf(v * rstd[r]);
                  if (c < MLAC) PM[(size_t)r * MLAC + c] = o; else PR[(size_t)r * RWC + (c - MLAC)] = o;
                }
              }, smem);
  }
}

DI void phase_2a(const Params& p, int bid, int nblk, char* smem) {
  char* ws = p.ws;
  const u16* PM = (const u16*)(ws + OFF_PM);
  const u16* PR = (const u16*)(ws + OFF_PR);
  u16* RS = (u16*)(ws + OFF_RS); u16* KS = (u16*)(ws + OFF_KS); u16* VS = (u16*)(ws + OFF_VS);
  u16* LI = (u16*)(ws + OFF_LORAIN);
  float* red = (float*)smem;
  const int tid = threadIdx.x, wid = tid >> 6, lane = tid & 63;
  for (int t = bid; t < T; t += nblk) {
    const u16* pm = PM + (size_t)t * MLAC;
    float q0 = bf2f(pm[tid]); float sq = q0 * q0;
    if (tid < 128) { const float q1 = bf2f(pm[256 + tid]); sq += q1 * q1; }
    const float kv = bf2f(pm[384 + tid]); float skv = kv * kv;
    sq = wave_allsum(sq); skv = wave_allsum(skv);
    if (lane == 0) { red[wid] = sq; red[4 + wid] = skv; }
    __syncthreads();
    if (tid == 0) {
      ((float*)(ws + OFF_RSTDQ))[t] = rsqrtf((red[0] + red[1] + red[2] + red[3]) * (1.f / 384.f) + EPS);
      ((float*)(ws + OFF_RSTDKV))[t] = rsqrtf((red[4] + red[5] + red[6] + red[7]) * (1.f / 256.f) + EPS);
    }
    __syncthreads();
    const bool first = (t % SEQ) == 0;
    const u16* cur = PR + (size_t)t * RWC;
    const u16* prv = cur - RWC;
#pragma unroll
    for (int i = 0; i < 7; ++i) {
      const int c = tid + 256 * i;
      const float cv = bf2f(cur[c]);
      const float pv = first ? 0.f : bf2f(prv[c]);
      const float v = cv + (pv - cv) * p.rwkv_mu[c];
      if (c < 512) RS[(size_t)t * 512 + c] = f2bf(v);
      else if (c < 1024) KS[(size_t)t * 512 + c - 512] = f2bf(v);
      else if (c < 1536) VS[(size_t)t * 512 + c - 1024] = f2bf(v);
      else if (c < 1600) LI[(size_t)t * 256 + c - 1536] = f2bf(tanhf(v));
      else if (c < 1664) LI[(size_t)t * 256 + c - 1536] = f2bf(v);
      else LI[(size_t)t * 256 + c - 1536] = f2bf(sigmoidf_(v));
    }
  }
}

DI void phase_2b(const Params& p, int bid, int nblk, char* smem) {
  char* ws = p.ws;
  const u16* PM = (const u16*)(ws + OFF_PM);
  const u16* LI = (const u16*)(ws + OFF_LORAIN);
  const float* rq = (const float*)(ws + OFF_RSTDQ);
  const float* rkv = (const float*)(ws + OFF_RSTDKV);
  u16* QRAW = (u16*)(ws + OFF_QRAW); u16* KVRAW = (u16*)(ws + OFF_KVRAW);
  u16* U = (u16*)(ws + OFF_U); u16* G = (u16*)(ws + OFF_G);
  u16* AA = (u16*)((char*)p.out + DO_AA);
  const int NT = 26;
  for (int tl = bid; tl < 256 * NT; tl += nblk) {
    const int mt = tl / NT, j = tl % NT, m0 = mt * 128;
    if (j < 6) {
      gemm_tile(PM, MLAC, (const u16*)(ws + OFF_WUQT), 384, 384, m0, j * 128,
                [&](int r, int c, float v) { QRAW[(size_t)r * 768 + c] = f2bf(v * rq[r]); }, smem);
    } else if (j < 14) {
      gemm_tile(PM + 384, MLAC, (const u16*)(ws + OFF_WUKVT), 256, 256, m0, (j - 6) * 128,
                [&](int r, int c, float v) { KVRAW[(size_t)r * 1024 + c] = f2bf(v * rkv[r]); }, smem);
    } else if (j < 18) {
      gemm_tile(LI, 256, (const u16*)(ws + OFF_W2T), 64, 64, m0, (j - 14) * 128,
                [&](int r, int c, float v) {
                  const float sg = sigmoidf_(p.w0[c] + v);
                  U[(size_t)r * 512 + c] = f2bf(-expm1f(-0.6065306597126334f * sg));
                }, smem);
    } else if (j < 22) {
      gemm_tile(LI + 64, 256, (const u16*)(ws + OFF_A2T), 64, 64, m0, (j - 18) * 128,
                [&](int r, int c, float v) { AA[(size_t)r * 512 + c] = f2bf(sigmoidf_(p.a0[c] + v)); }, smem);
    } else {
      gemm_tile(LI + 128, 256, (const u16*)(ws + OFF_G2T), 128, 128, m0, (j - 22) * 128,
                [&](int r, int c, float v) { G[(size_t)r * 512 + c] = f2bf(v); }, smem);
    }
  }
}

DI void phase_2c(const Params& p, int bid, int nblk, char* smem) {
  char* ws = p.ws;
  const u16* PM = (const u16*)(ws + OFF_PM);
  const u16* QRAW = (const u16*)(ws + OFF_QRAW);
  const u16* KVRAW = (const u16*)(ws + OFF_KVRAW);
  u16* Q = (u16*)((char*)p.out + DO_Q); u16* Kd = (u16*)((char*)p.out + DO_K);
  const u16* AA = (const u16*)((char*)p.out + DO_AA);
  u16* KS = (u16*)(ws + OFF_KS); u16* KK = (u16*)(ws + OFF_KK); u16* BB = (u16*)(ws + OFF_BB);
  const float* rope = (const float*)(ws + OFF_ROPE);
  const int tid = threadIdx.x, wid = tid >> 6, lane = tid & 63;
  const float QSCALE = 0.10206207261596575f * 1.4426950408889634f;
  for (int t = bid * 4 + wid; t < T; t += nblk * 4) {
    const int e0 = 2 * lane;
    const bool act = lane < 48;
    const bool isrope = lane >= 32 && lane < 48;
    const bool second = lane >= 40;
    float cs0 = 0.f, cs1 = 0.f, sn0 = 0.f, sn1 = 0.f;
    if (isrope) {
      const int i0 = e0 - (second ? 80 : 64);
      cs0 = rope[(size_t)t * 32 + i0]; cs1 = rope[(size_t)t * 32 + i0 + 1];
      sn0 = rope[(size_t)t * 32 + 16 + i0]; sn1 = rope[(size_t)t * 32 + 16 + i0 + 1];
    }
    float gq0 = 0.f, gq1 = 0.f, gk0 = 0.f, gk1 = 0.f;
    if (act) { gq0 = p.g_qnorm[e0]; gq1 = p.g_qnorm[e0 + 1]; gk0 = p.g_knorm[e0]; gk1 = p.g_knorm[e0 + 1]; }
    for (int h = 0; h < 8; ++h) {
#pragma unroll
      for (int which = 0; which < 2; ++which) {
        float v0 = 0.f, v1 = 0.f;
        if (act) {
          unsigned raw;
          if (which == 0) raw = *(const unsigned*)(QRAW + (size_t)t * 768 + h * 96 + e0);
          else if (e0 < 64) raw = *(const unsigned*)(KVRAW + (size_t)t * 1024 + h * 64 + e0);
          else raw = *(const unsigned*)(PM + (size_t)t * MLAC + 640 + (e0 - 64));
          v0 = bflo(raw); v1 = bfhi(raw);
        }
        const float ss = wave_allsum(v0 * v0 + v1 * v1);
        const float rs = rsqrtf(ss * (1.f / 96.f) + EPS);
        v0 *= rs * (which == 0 ? gq0 : gk0);
        v1 *= rs * (which == 0 ? gq1 : gk1);
        const float o0 = __shfl_xor(v0, 8), o1 = __shfl_xor(v1, 8);
        if (isrope) {
          if (!second) { v0 = v0 * cs0 - o0 * sn0; v1 = v1 * cs1 - o1 * sn1; }
          else { v0 = o0 * sn0 + v0 * cs0; v1 = o1 * sn1 + v1 * cs1; }
        }
        if (act) {
          if (which == 0) *(unsigned*)(Q + (size_t)t * 768 + h * 96 + e0) = pack2(v0 * QSCALE, v1 * QSCALE);
          else *(unsigned*)(Kd + (size_t)t * 768 + h * 96 + e0) = pack2(v0, v1);
        }
      }
    }
    {
      const int c0 = 8 * lane;
      const uint4 kraw = *(const uint4*)(KS + (size_t)t * 512 + c0);
      const uint4 araw = *(const uint4*)(AA + (size_t)t * 512 + c0);
      float kv[8], av[8], kkv[8];
      kv[0] = bflo(kraw.x); kv[1] = bfhi(kraw.x); kv[2] = bflo(kraw.y); kv[3] = bfhi(kraw.y);
      kv[4] = bflo(kraw.z); kv[5] = bfhi(kraw.z); kv[6] = bflo(kraw.w); kv[7] = bfhi(kraw.w);
      av[0] = bflo(araw.x); av[1] = bfhi(araw.x); av[2] = bflo(araw.y); av[3] = bfhi(araw.y);
      av[4] = bflo(araw.z); av[5] = bfhi(araw.z); av[6] = bflo(araw.w); av[7] = bfhi(araw.w);
      float ss = 0.f;
#pragma unroll
      for (int i = 0; i < 8; ++i) { kkv[i] = kv[i] * p.k_k[c0 + i]; ss += kkv[i] * kkv[i]; }
      ss += __shfl_xor(ss, 1); ss += __shfl_xor(ss, 2); ss += __shfl_xor(ss, 4);
      const float inv = 1.f / fmaxf(sqrtf(ss), 1e-12f);
      float kn[8], bb[8], k2[8];
#pragma unroll
      for (int i = 0; i < 8; ++i) {
        kn[i] = kkv[i] * inv;
        bb[i] = kn[i] * av[i];
        k2[i] = kv[i] * (1.f + (av[i] - 1.f) * p.k_a[c0 + i]);
      }
      *(uint4*)(KK + (size_t)t * 512 + c0) = make_uint4(pack2(kn[0], kn[1]), pack2(kn[2], kn[3]), pack2(kn[4], kn[5]), pack2(kn[6], kn[7]));
      *(uint4*)(BB + (size_t)t * 512 + c0) = make_uint4(pack2(bb[0], bb[1]), pack2(bb[2], bb[3]), pack2(bb[4], bb[5]), pack2(bb[6], bb[7]));
      *(uint4*)(KS + (size_t)t * 512 + c0) = make_uint4(pack2(k2[0], k2[1]), pack2(k2[2], k2[3]), pack2(k2[4], k2[5]), pack2(k2[6], k2[7]));
    }
  }
}

DI s16x4 tr_read(unsigned lds_addr) {
  s16x4 r;
  asm volatile("ds_read_b64_tr_b16 %0, %1\n\ts_waitcnt lgkmcnt(0)" : "=&v"(r) : "v"(lds_addr) : "memory");
  return r;
}
#define MFMA32(a, b, c) __builtin_amdgcn_mfma_f32_32x32x16_bf16((a), (b), (c), 0, 0, 0)

constexpr int KLD = 208, VLD = 192;
constexpr int ATT_KOFF = 0, ATT_VOFF = 64 * KLD;
DI void phase_attn(const Params& p, int bid, int nblk, char* smem) {
  char* ws = p.ws;
  const u16* Q = (const u16*)((char*)p.out + DO_Q);
  const u16* Kd = (const u16*)((char*)p.out + DO_K);
  const u16* KVRAW = (const u16*)(ws + OFF_KVRAW);
  u16* Y = (u16*)(ws + OFF_Y);
  const int tid = threadIdx.x, w = tid >> 6, lane = tid & 63, r = lane & 31, hh = lane >> 5;
  const unsigned lds_base = (unsigned)(size_t)smem;
  for (int it = bid; it < 2048; it += nblk) {
    const int rd = it >> 9, pos = it & 511, g = pos >> 7, bh = pos & 127;
    const int m = rd == 0 ? 15 - g : rd == 1 ? 8 + g : rd == 2 ? 7 - g : g;
    const int b = bh >> 3, h = bh & 7;
    const int t0 = b * SEQ + 128 * m;
    const int cw = 2 * m + (w >> 1);
    const int tq = t0 + 32 * w + r;
    bf16x8 qf[6];
#pragma unroll
    for (int ks = 0; ks < 6; ++ks) qf[ks] = *reinterpret_cast<const bf16x8*>(Q + (size_t)tq * 768 + h * 96 + 16 * ks + 8 * hh);
    f32x16 O0, O1;
#pragma unroll
    for (int i = 0; i < 16; ++i) { O0[i] = 0.f; O1[i] = 0.f; }
    float mrun = -1e30f, lrun = 0.f;
    const int nkt = 2 * m + 2;
    for (int kt = 0; kt < nkt; ++kt) {
      __syncthreads();
      const int tk0 = b * SEQ + 64 * kt;
#pragma unroll
      for (int i = 0; i < 3; ++i) {
        const int c = tid + 256 * i, row = c / 12, cc = c % 12;
        const uint4 v = *(const uint4*)(Kd + (size_t)(tk0 + row) * 768 + h * 96 + cc * 8);
        *(uint4*)(smem + ATT_KOFF + row * KLD + cc * 16) = v;
      }
#pragma unroll
      for (int i = 0; i < 2; ++i) {
        const int c = tid + 256 * i, row = c >> 3, cc = c & 7;
        const uint4 v = *(const uint4*)(KVRAW + (size_t)(tk0 + row) * 1024 + 512 + h * 64 + cc * 8);
        *(uint4*)(smem + ATT_VOFF + row * VLD + cc * 16) = v;
      }
      __syncthreads();
      if (kt <= cw) {
        f32x16 X[2];
#pragma unroll
        for (int sub = 0; sub < 2; ++sub) {
#pragma unroll
          for (int i = 0; i < 16; ++i) X[sub][i] = 0.f;
#pragma unroll
          for (int ks = 0; ks < 6; ++ks) {
            const bf16x8 a = *reinterpret_cast<const bf16x8*>(smem + ATT_KOFF + (32 * sub + r) * KLD + (16 * ks + 8 * hh) * 2);
            X[sub] = MFMA32(a, qf[ks], X[sub]);
          }
        }
        float mx = X[0][0];
#pragma unroll
        for (int i = 0; i < 16; ++i) { mx = fmaxf(mx, X[0][i]); mx = fmaxf(mx, X[1][i]); }
        mx = fmaxf(mx, __shfl_xor(mx, 32));
        const float mnew = fmaxf(mrun, mx);
        const float alpha = exp2f(mrun - mnew);
        mrun = mnew;
        float rsum = 0.f;
#pragma unroll
        for (int sub = 0; sub < 2; ++sub)
#pragma unroll
          for (int i = 0; i < 16; ++i) { const float e = exp2f(X[sub][i] - mnew); X[sub][i] = e; rsum += e; }
        lrun = lrun * alpha + rsum;
#pragma unroll
        for (int i = 0; i < 16; ++i) { O0[i] *= alpha; O1[i] *= alpha; }
        const int i16 = lane & 15, q4 = i16 >> 2, p4 = i16 & 3, blk = (lane >> 4) & 1;
#pragma unroll
        for (int sub = 0; sub < 2; ++sub) {
#pragma unroll
          for (int s = 0; s < 2; ++s) {
            bf16x8 pb;
#pragma unroll
            for (int j = 0; j < 8; ++j) pb[j] = (short)f2bf(X[sub][8 * s + j]);
            const unsigned rowlo = 32 * sub + 16 * s + 4 * hh + q4;
#pragma unroll
            for (int dt = 0; dt < 2; ++dt) {
              const unsigned colb = (32 * dt + 16 * blk) * 2 + 8 * p4;
              const s16x4 lo = tr_read(lds_base + ATT_VOFF + rowlo * VLD + colb);
              const s16x4 hi = tr_read(lds_base + ATT_VOFF + (rowlo + 8) * VLD + colb);
              const bf16x8 a = __builtin_shufflevector(lo, hi, 0, 1, 2, 3, 4, 5, 6, 7);
              if (dt == 0) O0 = MFMA32(a, pb, O0); else O1 = MFMA32(a, pb, O1);
            }
          }
        }
      }
    }
    const float ltot = lrun + __shfl_xor(lrun, 32);
    const float inv = 1.f / ltot;
    float ss = 0.f;
#pragma unroll
    for (int i = 0; i < 16; ++i) { O0[i] *= inv; O1[i] *= inv; ss += O0[i] * O0[i] + O1[i] * O1[i]; }
    ss += __shfl_xor(ss, 32);
    const float rs = rsqrtf(ss * (1.f / 64.f) + EPS);
#pragma unroll
    for (int dt = 0; dt < 2; ++dt)
#pragma unroll
      for (int gq = 0; gq < 4; ++gq) {
        const int d = 32 * dt + 8 * gq + 4 * hh;
        const float* gp = p.g_attn_out + h * 64 + d;
        float o[4];
#pragma unroll
        for (int j = 0; j < 4; ++j) o[j] = (dt == 0 ? O0[4 * gq + j] : O1[4 * gq + j]) * rs * gp[j];
        *(uint2*)(Y + (size_t)tq * 1024 + h * 64 + d) = make_uint2(pack2(o[0], o[1]), pack2(o[2], o[3]));
      }
  }
}

DI float row16_allsum(float v) {
  v += __shfl_xor(v, 8); v += __shfl_xor(v, 4); v += __shfl_xor(v, 2); v += __shfl_xor(v, 1);
  return v;
}
struct ScanIn { uint2 kk, u, b, k, r; u16 v; };
DI void scan_load(ScanIn& s, const u16* KK, const u16* U, const u16* BB, const u16* KS, const u16* RS, const u16* VS,
                  size_t tok, int cj, int ci) {
  const size_t o = tok * 512;
  s.kk = *(const uint2*)(KK + o + cj); s.u = *(const uint2*)(U + o + cj); s.b = *(const uint2*)(BB + o + cj);
  s.k = *(const uint2*)(KS + o + cj); s.r = *(const uint2*)(RS + o + cj); s.v = VS[o + ci];
}
DI void phase_scan(const Params& p, int bid, int nblk, char* smem) {
  char* ws = p.ws;
  const u16* KK = (const u16*)(ws + OFF_KK); const u16* U = (const u16*)(ws + OFF_U); const u16* BB = (const u16*)(ws + OFF_BB);
  const u16* KS = (const u16*)(ws + OFF_KS); const u16* RS = (const u16*)(ws + OFF_RS); const u16* VS = (const u16*)(ws + OFF_VS);
  float* YRAW = (float*)(ws + OFF_YRAW);
  const int tid = threadIdx.x, w = tid >> 6, lane = tid & 63, jq = lane & 15;
  for (int unit = bid; unit < 512; unit += nblk) {
    const int bh = unit >> 2, rg = unit & 3, b = bh >> 3, h = bh & 7;
    const int i = 16 * rg + 4 * w + (lane >> 4);
    const int cj = h * 64 + 4 * jq, ci = h * 64 + i;
    const size_t tb = (size_t)b * SEQ;
    float S0 = 0.f, S1 = 0.f, S2 = 0.f, S3 = 0.f;
    constexpr int PF = 8;
    ScanIn cur[PF], nxt[PF];
#pragma unroll
    for (int q = 0; q < PF; ++q) scan_load(cur[q], KK, U, BB, KS, RS, VS, tb + q, cj, ci);
    for (int s0 = 0; s0 < SEQ; s0 += PF) {
      if (s0 + PF < SEQ) {
#pragma unroll
        for (int q = 0; q < PF; ++q) scan_load(nxt[q], KK, U, BB, KS, RS, VS, tb + s0 + PF + q, cj, ci);
      }
#pragma unroll
      for (int q = 0; q < PF; ++q) {
        const ScanIn& c = cur[q];
        const float kk0 = bflo(c.kk.x), kk1 = bfhi(c.kk.x), kk2 = bflo(c.kk.y), kk3 = bfhi(c.kk.y);
        float sk = S0 * kk0 + S1 * kk1 + S2 * kk2 + S3 * kk3;
        sk = row16_allsum(sk);
        const float v = bf2f(c.v);
        S0 = S0 * (1.f - bflo(c.u.x)) - sk * bflo(c.b.x) + v * bflo(c.k.x);
        S1 = S1 * (1.f - bfhi(c.u.x)) - sk * bfhi(c.b.x) + v * bfhi(c.k.x);
        S2 = S2 * (1.f - bflo(c.u.y)) - sk * bflo(c.b.y) + v * bflo(c.k.y);
        S3 = S3 * (1.f - bfhi(c.u.y)) - sk * bfhi(c.b.y) + v * bfhi(c.k.y);
        float y = S0 * bflo(c.r.x) + S1 * bfhi(c.r.x) + S2 * bflo(c.r.y) + S3 * bfhi(c.r.y);
        y = row16_allsum(y);
        if (jq == 0) YRAW[(tb + s0 + q) * 512 + ci] = y;
      }
#pragma unroll
      for (int q = 0; q < PF; ++q) cur[q] = nxt[q];
    }
  }
}

DI void phase_3c(const Params& p, int bid, int nblk, char* smem) {
  char* ws = p.ws;
  const float* YRAW = (const float*)(ws + OFF_YRAW);
  const u16* KS = (const u16*)(ws + OFF_KS); const u16* RS = (const u16*)(ws + OFF_RS); const u16* VS = (const u16*)(ws + OFF_VS);
  const u16* G = (const u16*)(ws + OFF_G);
  u16* Y = (u16*)(ws + OFF_Y);
  const int tid = threadIdx.x, wid = tid >> 6, lane = tid & 63;
  for (int t = bid * 4 + wid; t < T; t += nblk * 4) {
    const int c0 = 8 * lane;
    const float4 y0 = *(const float4*)(YRAW + (size_t)t * 512 + c0);
    const float4 y1 = *(const float4*)(YRAW + (size_t)t * 512 + c0 + 4);
    float y[8] = {y0.x, y0.y, y0.z, y0.w, y1.x, y1.y, y1.z, y1.w};
    const uint4 rr = *(const uint4*)(RS + (size_t)t * 512 + c0);
    const uint4 kr = *(const uint4*)(KS + (size_t)t * 512 + c0);
    const uint4 vr = *(const uint4*)(VS + (size_t)t * 512 + c0);
    const uint4 gr = *(const uint4*)(G + (size_t)t * 512 + c0);
    float rv[8] = {bflo(rr.x), bfhi(rr.x), bflo(rr.y), bfhi(rr.y), bflo(rr.z), bfhi(rr.z), bflo(rr.w), bfhi(rr.w)};
    float kv[8] = {bflo(kr.x), bfhi(kr.x), bflo(kr.y), bfhi(kr.y), bflo(kr.z), bfhi(kr.z), bflo(kr.w), bfhi(kr.w)};
    float vv[8] = {bflo(vr.x), bfhi(vr.x), bflo(vr.y), bfhi(vr.y), bflo(vr.z), bfhi(vr.z), bflo(vr.w), bfhi(vr.w)};
    float gv[8] = {bflo(gr.x), bfhi(gr.x), bflo(gr.y), bfhi(gr.y), bflo(gr.z), bfhi(gr.z), bflo(gr.w), bfhi(gr.w)};
    float sm = 0.f, bsum = 0.f;
#pragma unroll
    for (int i = 0; i < 8; ++i) { sm += y[i]; bsum += rv[i] * kv[i] * p.r_k[c0 + i]; }
    sm += __shfl_xor(sm, 1); sm += __shfl_xor(sm, 2); sm += __shfl_xor(sm, 4);
    bsum += __shfl_xor(bsum, 1); bsum += __shfl_xor(bsum, 2); bsum += __shfl_xor(bsum, 4);
    const float mu = sm * (1.f / 64.f);
    float var = 0.f;
#pragma unroll
    for (int i = 0; i < 8; ++i) { const float d = y[i] - mu; var += d * d; }
    var += __shfl_xor(var, 1); var += __shfl_xor(var, 2); var += __shfl_xor(var, 4);
    const float rs = rsqrtf(var * (1.f / 64.f) + 64e-5f);
    float o[8];
#pragma unroll
    for (int i = 0; i < 8; ++i) o[i] = ((y[i] - mu) * rs * p.ln_x_w[c0 + i] + p.ln_x_b[c0 + i] + bsum * vv[i]) * gv[i];
    *(uint4*)(Y + (size_t)t * 1024 + 512 + c0) = make_uint4(pack2(o[0], o[1]), pack2(o[2], o[3]), pack2(o[4], o[5]), pack2(o[6], o[7]));
  }
}

DI void phase_wo(const Params& p, int bid, int nblk, char* smem) {
  char* ws = p.ws;
  const int tid = threadIdx.x;
  {
    uint2* EU = (uint2*)(ws + OFF_EU); uint2* EV = (uint2*)(ws + OFF_EV);
    const float4* su = (const float4*)p.expert_u; const float4* sv = (const float4*)p.expert_v;
    const float4* gf = (const float4*)p.g_ffn;
    for (size_t i = (size_t)bid * NTHR + tid; i < (size_t)16384 * 256; i += (size_t)nblk * NTHR) {
      const float4 g = gf[i & 255];
      const float4 a = su[i], b = sv[i];
      EU[i] = make_uint2(pack2(a.x * g.x, a.y * g.y), pack2(a.z * g.z, a.w * g.w));
      EV[i] = make_uint2(pack2(b.x, b.y), pack2(b.z, b.w));
    }
  }
  const u16* Y = (const u16*)(ws + OFF_Y);
  const int NT = 8;
  for (int tl = bid; tl < 256 * NT; tl += nblk) {
    const int mt = tl / NT, nt = tl % NT;
    gemm_tile(Y, 1024, (const u16*)(ws + OFF_WOT), 1024, 1024, mt * 128, nt * 128,
              [&](int r, int c, float v) { p.out[(size_t)r * DM + c] = p.x[(size_t)r * DM + c] + v; }, smem);
  }
}

DI void phase_5(const Params& p, int bid, int nblk, char* smem) {
  char* ws = p.ws;
  const int tid = threadIdx.x, wid = tid >> 6, lane = tid & 63;
  for (int row = bid * 4 + wid; row < T; row += nblk * 4) {
    const float4* xr = (const float4*)(p.out + (size_t)row * DM);
    uint2* xb = (uint2*)(ws + OFF_X2B + (size_t)row * DM * 2);
    float ss = 0.f;
#pragma unroll
    for (int i = 0; i < 4; ++i) {
      const float4 v = xr[lane + 64 * i];
      ss += v.x * v.x + v.y * v.y + v.z * v.z + v.w * v.w;
      xb[lane + 64 * i] = make_uint2(pack2(v.x, v.y), pack2(v.z, v.w));
    }
    ss = wave_allsum(ss);
    if (lane == 0) ((float*)(ws + OFF_RSTD2))[row] = rsqrtf(ss * (1.f / DM) + EPS);
  }
}

DI void phase_6(const Params& p, int bid, int nblk, char* smem) {
  char* ws = p.ws;
  const float* rstd = (const float*)(ws + OFF_RSTD2);
  u16* QP = (u16*)(ws + OFF_QP);
  const int NT = 16;
  for (int tl = bid; tl < 256 * NT; tl += nblk) {
    const int mt = tl / NT, nt = tl % NT;
    gemm_tile((const u16*)(ws + OFF_X2B), 1024, (const u16*)(ws + OFF_WPQT), 1024, 1024, mt * 128, nt * 128,
              [&](int r, int c, float v) { QP[(size_t)r * 2048 + c] = f2bf(v * rstd[r]); }, smem);
  }
}

DI void ins16(float (&top)[16], float x) {
#pragma unroll
  for (int i = 0; i < 16; ++i) { const float hi = fmaxf(top[i], x); x = fminf(top[i], x); top[i] = hi; }
}
DI void phase_7(const Params& p, int bid, int nblk, char* smem) {
  char* ws = p.ws;
  const u16* QP = (const u16*)(ws + OFF_QP);
  const u16* SUBK = (const u16*)(ws + OFF_SUBK);
  int* IDX = (int*)(ws + OFF_IDX); float* GATE = (float*)(ws + OFF_GATE);
  float* lists = (float*)smem;
  const int tid = threadIdx.x, w = tid >> 6, lane = tid & 63, r = lane & 31, hh = lane >> 5;
  const int th = w & 1, pp = w >> 1;
  for (int it = bid; it < 512 * 8; it += nblk) {
    const int tt = it >> 3, h = it & 7;
    const int t = tt * 64 + 32 * th + r;
    bf16x8 qf[8];
#pragma unroll
    for (int ks = 0; ks < 8; ++ks) qf[ks] = *reinterpret_cast<const bf16x8*>(QP + (size_t)t * 2048 + h * 256 + pp * 128 + 16 * ks + 8 * hh);
    const u16* sk = SUBK + (size_t)(h * 2 + pp) * 128 * 128;
    float top[16];
#pragma unroll
    for (int i = 0; i < 16; ++i) top[i] = -INFINITY;
#pragma unroll
    for (int kt = 0; kt < 4; ++kt) {
      f32x16 acc;
#pragma unroll
      for (int i = 0; i < 16; ++i) acc[i] = 0.f;
#pragma unroll
      for (int ks = 0; ks < 8; ++ks) {
        const bf16x8 a = *reinterpret_cast<const bf16x8*>(sk + (size_t)(32 * kt + r) * 128 + 16 * ks + 8 * hh);
        acc = MFMA32(a, qf[ks], acc);
      }
#pragma unroll
      for (int i = 0; i < 16; ++i) {
        const unsigned key = 32 * kt + (i & 3) + 8 * (i >> 2) + 4 * hh;
        const float v = __uint_as_float((__float_as_uint(acc[i]) & ~127u) | key);
        ins16(top, v);
      }
    }
    float oth[16];
#pragma unroll
    for (int i = 0; i < 16; ++i) oth[i] = __shfl_xor(top[i], 32);
#pragma unroll
    for (int i = 0; i < 16; ++i) ins16(top, oth[i]);
    __syncthreads();
    if (hh == 0) {
      float* dst = lists + ((32 * th + r) * 2 + pp) * 16;
#pragma unroll
      for (int i = 0; i < 16; i += 4) *(float4*)(dst + i) = make_float4(top[i], top[i + 1], top[i + 2], top[i + 3]);
    }
    __syncthreads();
    if (tid < 64) {
      const float* l1 = lists + (tid * 2 + 0) * 16;
      const float* l2 = lists + (tid * 2 + 1) * 16;
      float s1[16], s2[16];
#pragma unroll
      for (int i = 0; i < 16; ++i) {
        s1[i] = __uint_as_float(__float_as_uint(l1[i]) & ~127u);
        s2[i] = __uint_as_float(__float_as_uint(l2[i]) & ~127u);
      }
      float ts[16];
#pragma unroll
      for (int i = 0; i < 16; ++i) ts[i] = -INFINITY;
#pragma unroll
      for (int a = 0; a < 16; ++a)
#pragma unroll
        for (int b = 0; b < 16; ++b)
          if ((a + 1) * (b + 1) <= 16) {
            const float sm = s1[a] + s2[b];
            ins16(ts, __uint_as_float((__float_as_uint(sm) & ~255u) | (unsigned)(a * 16 + b)));
          }
      const size_t ob = ((size_t)(tt * 64 + tid) * 8 + h) * 16;
      float e[16], esum = 0.f;
      const float mx = __uint_as_float(__float_as_uint(ts[0]) & ~255u);
#pragma unroll
      for (int i = 0; i < 16; ++i) {
        const unsigned bits = __float_as_uint(ts[i]);
        const unsigned cid = bits & 255u;
        const float val = __uint_as_float(bits & ~255u);
        e[i] = __expf(val - mx); esum += e[i];
        const unsigned i1 = __float_as_uint(l1[cid >> 4]) & 127u, i2 = __float_as_uint(l2[cid & 15]) & 127u;
        IDX[ob + i] = (int)(i1 * 128 + i2);
      }
      const float inv = 1.f / esum;
#pragma unroll
      for (int i = 0; i < 16; ++i) GATE[ob + i] = e[i] * inv;
    }
  }
}

DI void phase_8(const Params& p, int bid, int nblk, char* smem) {
  char* ws = p.ws;
  const u16* X2B = (const u16*)(ws + OFF_X2B);
  const u16* EU = (const u16*)(ws + OFF_EU); const u16* EV = (const u16*)(ws + OFF_EV);
  const int* IDX = (const int*)(ws + OFF_IDX); const float* GATE = (const float*)(ws + OFF_GATE);
  const float* rstd2 = (const float*)(ws + OFF_RSTD2);
  const int tid = threadIdx.x, wid = tid >> 6, lane = tid & 63;
  for (int t = bid * 4 + wid; t < T; t += nblk * 4) {
    float xh[16];
    {
      const uint4 a = *(const uint4*)(X2B + (size_t)t * DM + 16 * lane);
      const uint4 b = *(const uint4*)(X2B + (size_t)t * DM + 16 * lane + 8);
      xh[0] = bflo(a.x); xh[1] = bfhi(a.x); xh[2] = bflo(a.y); xh[3] = bfhi(a.y); xh[4] = bflo(a.z); xh[5] = bfhi(a.z); xh[6] = bflo(a.w); xh[7] = bfhi(a.w);
      xh[8] = bflo(b.x); xh[9] = bfhi(b.x); xh[10] = bflo(b.y); xh[11] = bfhi(b.y); xh[12] = bflo(b.z); xh[13] = bfhi(b.z); xh[14] = bflo(b.w); xh[15] = bfhi(b.w);
    }
    const float rs = rstd2[t];
    const int id0 = IDX[(size_t)t * 128 + lane], id1 = IDX[(size_t)t * 128 + 64 + lane];
    const float g0 = GATE[(size_t)t * 128 + lane], g1 = GATE[(size_t)t * 128 + 64 + lane];
    float acc[16];
#pragma unroll
    for (int i = 0; i < 16; ++i) acc[i] = 0.f;
    for (int k0 = 0; k0 < 128; k0 += 4) {
      uint4 ua[4], ub[4], va[4], vb[4];
      float gt[4];
#pragma unroll
      for (int q = 0; q < 4; ++q) {
        const int k = k0 + q;
        const int e = __shfl(k < 64 ? id0 : id1, k & 63);
        gt[q] = __shfl(k < 64 ? g0 : g1, k & 63);
        const u16* up = EU + (size_t)e * DM + 16 * lane;
        const u16* vp = EV + (size_t)e * DM + 16 * lane;
        ua[q] = *(const uint4*)up; ub[q] = *(const uint4*)(up + 8);
        va[q] = *(const uint4*)vp; vb[q] = *(const uint4*)(vp + 8);
      }
#pragma unroll
      for (int q = 0; q < 4; ++q) {
        float d = xh[0] * bflo(ua[q].x) + xh[1] * bfhi(ua[q].x) + xh[2] * bflo(ua[q].y) + xh[3] * bfhi(ua[q].y)
                + xh[4] * bflo(ua[q].z) + xh[5] * bfhi(ua[q].z) + xh[6] * bflo(ua[q].w) + xh[7] * bfhi(ua[q].w)
                + xh[8] * bflo(ub[q].x) + xh[9] * bfhi(ub[q].x) + xh[10] * bflo(ub[q].y) + xh[11] * bfhi(ub[q].y)
                + xh[12] * bflo(ub[q].z) + xh[13] * bfhi(ub[q].z) + xh[14] * bflo(ub[q].w) + xh[15] * bfhi(ub[q].w);
        d = wave_allsum(d) * rs;
        const float wg = gt[q] * 0.5f * d * (1.f + erff(d * 0.70710678118654752f));
        acc[0] += wg * bflo(va[q].x); acc[1] += wg * bfhi(va[q].x); acc[2] += wg * bflo(va[q].y); acc[3] += wg * bfhi(va[q].y);
        acc[4] += wg * bflo(va[q].z); acc[5] += wg * bfhi(va[q].z); acc[6] += wg * bflo(va[q].w); acc[7] += wg * bfhi(va[q].w);
        acc[8] += wg * bflo(vb[q].x); acc[9] += wg * bfhi(vb[q].x); acc[10] += wg * bflo(vb[q].y); acc[11] += wg * bfhi(vb[q].y);
        acc[12] += wg * bflo(vb[q].z); acc[13] += wg * bfhi(vb[q].z); acc[14] += wg * bflo(vb[q].w); acc[15] += wg * bfhi(vb[q].w);
      }
    }
    float4* op = (float4*)(p.out + (size_t)t * DM + 16 * lane);
#pragma unroll
    for (int i = 0; i < 4; ++i) {
      float4 v = op[i];
      v.x += acc[4 * i]; v.y += acc[4 * i + 1]; v.z += acc[4 * i + 2]; v.w += acc[4 * i + 3];
      op[i] = v;
    }
  }
}


#define XB_TMO      128
#define XB_XCNT(j)  (256  + 64 * (j))
#define XB_XSUB(j)  (1280 + 64 * (j))
#define XB_XGEN(j)  (2304 + 64 * (j))
#define XB_TOP      3328
#define XB_TOPGEN   3392
#define XCD_BAR_WORDS 3456
#define XB_SPIN_CAP (1u << 20)
#define LAS __attribute__((address_space(3)))
DI unsigned xb_ld(unsigned* p) { return __hip_atomic_load(p, __ATOMIC_RELAXED, __HIP_MEMORY_SCOPE_AGENT); }
DI unsigned xb_add(unsigned* p, unsigned v) { return __hip_atomic_fetch_add(p, v, __ATOMIC_RELAXED, __HIP_MEMORY_SCOPE_AGENT); }
DI unsigned xb_xcc_id() { return (unsigned)__builtin_amdgcn_s_getreg((3 << 11) | 20) & 0xFu; }
#define XB_SPIN(cond, bar) do { unsigned _sp = 0; while (cond) { __builtin_amdgcn_s_sleep(1); \
    if ((++_sp & 255u) == 0u) { if (xb_ld(&(bar)[XB_TMO])) break; if (_sp > XB_SPIN_CAP) { atomicAdd(&(bar)[XB_TMO], 1u); break; } } } } while (0)
struct XcdBarrier { unsigned* bar; unsigned x; volatile LAS unsigned* st; };
DI XcdBarrier xcd_barrier_post(unsigned* bar, volatile LAS unsigned* st) {
  XcdBarrier b; b.bar = bar; b.x = xb_xcc_id(); b.st = st;
  if (threadIdx.x == 0) (void)xb_add(&bar[XB_XCNT(b.x)], 1u);
  return b;
}
DI void xcd_barrier_complete(unsigned* bar, unsigned x, unsigned& nloc, unsigned& nx) {
  const unsigned G = gridDim.x * gridDim.y * gridDim.z;
  unsigned sum, cnt, mine, sp = 0u;
  for (;;) {
    sum = 0u; cnt = 0u; mine = 0u;
#pragma unroll
    for (unsigned j = 0; j < 16; ++j) { const unsigned c = xb_ld(&bar[XB_XCNT(j)]); sum += c; cnt += (c > 0u) ? 1u : 0u; mine = (j == x) ? c : mine; }
    if (sum == G) break;
    __builtin_amdgcn_s_sleep(1);
    if ((++sp & 255u) == 0u) { if (xb_ld(&bar[XB_TMO])) break; if (sp > XB_SPIN_CAP) { atomicAdd(&bar[XB_TMO], 1u); break; } }
  }
  nloc = mine > 0u ? mine : 1u; nx = cnt > 0u ? cnt : 1u;
}
DI void xcd_barrier(const XcdBarrier& b) {
  asm volatile("s_waitcnt vmcnt(0)" ::: "memory");
  __syncthreads();
  if (threadIdx.x == 0) {
    unsigned* bar = b.bar;
    __builtin_amdgcn_s_waitcnt(0);
    unsigned nloc = b.st[0], nx = b.st[1];
    if (nloc == 0u) { xcd_barrier_complete(bar, b.x, nloc, nx); b.st[0] = nloc; b.st[1] = nx; }
    const unsigned old = xb_add(&bar[XB_XSUB(b.x)], 1u);
    const unsigned gen = old / nloc;
    if (old + 1u == (gen + 1u) * nloc) {
      __builtin_amdgcn_fence(__ATOMIC_RELEASE, "agent");
      asm volatile("s_waitcnt vmcnt(0)" ::: "memory");
      const unsigned og = xb_add(&bar[XB_TOP], 1u);
      const unsigned tg = og / nx;
      if (og + 1u == (tg + 1u) * nx) xb_add(&bar[XB_TOPGEN], 1u);
      else XB_SPIN(xb_ld(&bar[XB_TOPGEN]) == tg, bar);
      __builtin_amdgcn_fence(__ATOMIC_ACQUIRE, "agent");
      xb_add(&bar[XB_XGEN(b.x)], 1u);
      asm volatile("s_waitcnt vmcnt(0)" ::: "memory");
    } else {
      XB_SPIN(xb_ld(&bar[XB_XGEN(b.x)]) == gen, bar);
      __builtin_amdgcn_fence(__ATOMIC_ACQUIRE, "agent");
      asm volatile("s_waitcnt vmcnt(0)" ::: "memory");
    }
  }
  __syncthreads();
}

constexpr int NPHASE = 12;
template <int PH>
DI void run_phase(const Params& p, int bid, int nblk, char* smem) {
  if constexpr (PH == 0) phase_prep(p, bid, nblk, smem);
  else if constexpr (PH == 1) phase_gemm1(p, bid, nblk, smem);
  else if constexpr (PH == 2) phase_2a(p, bid, nblk, smem);
  else if constexpr (PH == 3) phase_2b(p, bid, nblk, smem);
  else if constexpr (PH == 4) phase_2c(p, bid, nblk, smem);
  else if constexpr (PH == 5) phase_attn(p, bid, nblk, smem);
  else if constexpr (PH == 6) phase_scan(p, bid, nblk, smem);
  else if constexpr (PH == 7) phase_3c(p, bid, nblk, smem);
  else if constexpr (PH == 8) phase_wo(p, bid, nblk, smem);
  else if constexpr (PH == 9) phase_5(p, bid, nblk, smem);
  else if constexpr (PH == 10) phase_6(p, bid, nblk, smem);
  else if constexpr (PH == 11) { phase_7(p, bid, nblk, smem); }
  else phase_8(p, bid, nblk, smem);
}

constexpr int SMEM_BYTES = 32768;

#if MEGA
__global__ void __launch_bounds__(NTHR, 2) mega_kernel(Params p) {
  __shared__ __attribute__((aligned(16))) char smem[SMEM_BYTES];
  __shared__ uint4 xb_words;
  cg::grid_group grid = cg::this_grid();
  const int bid = blockIdx.x, nblk = gridDim.x;
  if (threadIdx.x == 0) xb_words = make_uint4(0u, 0u, 0u, 0u);
  __syncthreads();
  XcdBarrier xb = xcd_barrier_post((unsigned*)(p.ws + OFF_BAR), (volatile LAS unsigned*)&xb_words);
  run_phase<0>(p, bid, nblk, smem); grid.sync();
  run_phase<1>(p, bid, nblk, smem); xcd_barrier(xb);
  run_phase<2>(p, bid, nblk, smem); xcd_barrier(xb);
  run_phase<3>(p, bid, nblk, smem); xcd_barrier(xb);
  run_phase<4>(p, bid, nblk, smem); xcd_barrier(xb);
  run_phase<5>(p, bid, nblk, smem); xcd_barrier(xb);
  run_phase<6>(p, bid, nblk, smem); xcd_barrier(xb);
  run_phase<7>(p, bid, nblk, smem); xcd_barrier(xb);
  run_phase<8>(p, bid, nblk, smem); xcd_barrier(xb);
  run_phase<9>(p, bid, nblk, smem); xcd_barrier(xb);
  run_phase<10>(p, bid, nblk, smem); xcd_barrier(xb);
  run_phase<11>(p, bid, nblk, smem); xcd_barrier(xb);
  run_phase<12>(p, bid, nblk, smem);
}
#else
template <int PH>
__global__ void __launch_bounds__(NTHR, 2) phase_kernel(Params p) {
  __shared__ __attribute__((aligned(16))) char smem[SMEM_BYTES];
  run_phase<PH>(p, blockIdx.x, gridDim.x, smem);
}
#endif

extern "C" void kernel_launch(void* const* d_in, const int* in_sizes, int n_in, void* d_out, int out_size, void* d_ws,
                              size_t ws_size, hipStream_t stream) {
  Params p{};
  p.x = (const float*)d_in[0]; p.pos = (const int*)d_in[1];
  p.g_mix = (const float*)d_in[2]; p.w_in = (const float*)d_in[3]; p.rwkv_mu = (const float*)d_in[4];
  p.g_cq = (const float*)d_in[5]; p.g_ckv = (const float*)d_in[6]; p.w_uq = (const float*)d_in[7];
  p.w_uk = (const float*)d_in[8]; p.w_uv = (const float*)d_in[9]; p.g_qnorm = (const float*)d_in[10];
  p.g_knorm = (const float*)d_in[11]; p.g_attn_out = (const float*)d_in[12]; p.w0 = (const float*)d_in[13];
  p.w2 = (const float*)d_in[14]; p.a0 = (const float*)d_in[15]; p.a2 = (const float*)d_in[16];
  p.g2 = (const float*)d_in[17]; p.k_k = (const float*)d_in[18]; p.k_a = (const float*)d_in[19];
  p.r_k = (const float*)d_in[20]; p.ln_x_w = (const float*)d_in[21]; p.ln_x_b = (const float*)d_in[22];
  p.w_o = (const float*)d_in[23]; p.g_ffn = (const float*)d_in[24]; p.w_pq = (const float*)d_in[25];
  p.sub_keys = (const float*)d_in[26]; p.expert_u = (const float*)d_in[27]; p.expert_v = (const float*)d_in[28];
  p.out = (float*)d_out; p.ws = (char*)d_ws;
#if MEGA
  static int grid_blocks = 0;
  if (!grid_blocks) {
    int dev = 0, cus = 0, per_cu = 0;
    hipGetDevice(&dev);
    hipDeviceGetAttribute(&cus, hipDeviceAttributeMultiprocessorCount, dev);
    (void)hipOccupancyMaxActiveBlocksPerMultiprocessor(&per_cu, mega_kernel, NTHR, 0);
    if (per_cu > 2) per_cu = 2;
    grid_blocks = cus * per_cu;
  }
  hipMemsetAsync((char*)d_ws + OFF_BAR, 0, 16384, stream);
  void* args[] = {&p};
  hipError_t e = hipLaunchCooperativeKernel((void*)mega_kernel, dim3(grid_blocks), dim3(NTHR), args, 0, stream);
  if (e != hipSuccess) fprintf(stderr, "cooperative launch failed: %s (grid %d)\n", hipGetErrorString(e), grid_blocks);
#else
  const int NB = 512;
  phase_kernel<0><<<NB, NTHR, 0, stream>>>(p);
  phase_kernel<1><<<NB, NTHR, 0, stream>>>(p);
  phase_kernel<2><<<NB, NTHR, 0, stream>>>(p);
  phase_kernel<3><<<NB, NTHR, 0, stream>>>(p);
  phase_kernel<4><<<NB, NTHR, 0, stream>>>(p);
  phase_kernel<5><<<NB, NTHR, 0, stream>>>(p);
  phase_kernel<6><<<NB, NTHR, 0, stream>>>(p);
  phase_kernel<7><<<NB, NTHR, 0, stream>>>(p);
  phase_kernel<8><<<NB, NTHR, 0, stream>>>(p);
  phase_kernel<9><<<NB, NTHR, 0, stream>>>(p);
  phase_kernel<10><<<NB, NTHR, 0, stream>>>(p);
  phase_kernel<11><<<NB, NTHR, 0, stream>>>(p);
  phase_kernel<12><<<NB, NTHR, 0, stream>>>(p);
#endif
}
```

```cpp
#include <hip/hip_runtime.h>
#include <hip/hip_cooperative_groups.h>
#include <cstdio>
#include <cstdint>
namespace cg = cooperative_groups;

#ifndef MEGA
#define MEGA 1
#endif

typedef unsigned short u16;
using bf16x8 = __attribute__((ext_vector_type(8))) short;
using s16x4  = __attribute__((ext_vector_type(4))) short;
using f32x4  = __attribute__((ext_vector_type(4))) float;
using f32x16 = __attribute__((ext_vector_type(16))) float;
#define DI __device__ __forceinline__

constexpr int T = 32768, SEQ = 2048, DM = 1024;
constexpr int INC = 2464, MLAC = 672, RWC = 1792;
constexpr int NTHR = 256;
constexpr float EPS = 1e-6f;

constexpr size_t MiB = 1048576;
constexpr size_t OFF_WINT  = 0;
constexpr size_t OFF_WUQT  = OFF_WINT  + 2560 * 1024 * 2;
constexpr size_t OFF_WUKVT = OFF_WUQT  + 768 * 384 * 2;
constexpr size_t OFF_W2T   = OFF_WUKVT + 1024 * 256 * 2;
constexpr size_t OFF_A2T   = OFF_W2T   + 512 * 64 * 2;
constexpr size_t OFF_G2T   = OFF_A2T   + 512 * 64 * 2;
constexpr size_t OFF_WOT   = OFF_G2T   + 512 * 128 * 2;
constexpr size_t OFF_WPQT  = OFF_WOT   + 1024 * 1024 * 2;
constexpr size_t OFF_SUBK  = OFF_WPQT  + 2048 * 1024 * 2;
constexpr size_t OFF_ROPE  = OFF_SUBK  + 16 * 128 * 128 * 2;
constexpr size_t OFF_RSTD1 = OFF_ROPE  + (size_t)T * 32 * 4;
constexpr size_t OFF_RSTDQ = OFF_RSTD1 + (size_t)T * 4;
constexpr size_t OFF_RSTDKV= OFF_RSTDQ + (size_t)T * 4;
constexpr size_t OFF_RSTD2 = OFF_RSTDKV+ (size_t)T * 4;
constexpr size_t OFF_A_END = OFF_RSTD2 + (size_t)T * 4;
static_assert(OFF_A_END <= 19 * MiB, "region A");
constexpr size_t OFF_BAR   = 19 * MiB;
constexpr size_t OFF_QCTR  = OFF_BAR + 16384;
constexpr size_t OFF_XB    = 20 * MiB;
constexpr size_t OFF_Y     = OFF_XB;
constexpr size_t OFF_PM    = 84 * MiB;
constexpr size_t OFF_PR    = 126 * MiB;
constexpr size_t OFF_U     = OFF_PR;
constexpr size_t OFF_G     = OFF_PR + 32 * MiB;
constexpr size_t OFF_KK    = OFF_PR + 64 * MiB;
constexpr size_t OFF_KVRAW = 238 * MiB;
constexpr size_t OFF_QRAW  = 302 * MiB;
constexpr size_t OFF_LORAIN= 350 * MiB;
constexpr size_t OFF_YRAW  = 302 * MiB;
constexpr size_t OFF_RS    = 366 * MiB;
constexpr size_t OFF_KS    = 398 * MiB;
constexpr size_t OFF_VS    = 430 * MiB;
constexpr size_t OFF_BB    = 462 * MiB;
constexpr size_t OFF_EU    = 84 * MiB;
constexpr size_t OFF_EV    = 116 * MiB;
constexpr size_t OFF_X2B   = 148 * MiB;
constexpr size_t OFF_QP    = 238 * MiB;
constexpr size_t OFF_IDX   = 20 * MiB;
constexpr size_t OFF_GATE  = 28 * MiB;
constexpr size_t OFF_WGT   = 44 * MiB;
constexpr size_t OFF_PART  = 238 * MiB;
constexpr int NSL = 16;
constexpr size_t DO_Q = 0, DO_K = (size_t)T * 768 * 2, DO_AA = (size_t)T * 768 * 4;

struct Params {
  const float* x; const int* pos;
  const float *g_mix, *w_in, *rwkv_mu, *g_cq, *g_ckv, *w_uq, *w_uk, *w_uv, *g_qnorm, *g_knorm, *g_attn_out;
  const float *w0, *w2, *a0, *a2, *g2, *k_k, *k_a, *r_k, *ln_x_w, *ln_x_b, *w_o, *g_ffn, *w_pq, *sub_keys, *expert_u, *expert_v;
  float* out; char* ws;
};

DI u16 f2bf(float x) { unsigned u = __float_as_uint(x); u += 0x7fffu + ((u >> 16) & 1u); return (u16)(u >> 16); }
DI float bf2f(u16 h) { return __uint_as_float(((unsigned)h) << 16); }
DI unsigned pack2(float a, float b) { return (unsigned)f2bf(a) | ((unsigned)f2bf(b) << 16); }
DI float bflo(unsigned u) { return __uint_as_float(u << 16); }
DI float bfhi(unsigned u) { return __uint_as_float(u & 0xffff0000u); }
DI float wave_allsum(float v) {
#pragma unroll
  for (int o = 32; o > 0; o >>= 1) v += __shfl_xor(v, o);
  return v;
}
DI float sigmoidf_(float x) { return 1.f / (1.f + __expf(-x)); }

DI void tconv(const float* __restrict__ src, int K, int N, const float* __restrict__ scale, u16* __restrict__ dst,
              int ldd, int noff, int bid, int nblk, float* tile) {
  const int tid = threadIdx.x, tx = tid & 31, ty = tid >> 5;
  const int nbn = N / 32, ntl = (K / 32) * nbn;
  for (int tl = bid; tl < ntl; tl += nblk) {
    const int kb = tl / nbn, nb = tl % nbn;
#pragma unroll
    for (int i = 0; i < 4; ++i) {
      const int k = kb * 32 + ty + 8 * i;
      float v = src[(size_t)k * N + nb * 32 + tx];
      if (scale) v *= scale[k];
      tile[(ty + 8 * i) * 33 + tx] = v;
    }
    __syncthreads();
#pragma unroll
    for (int i = 0; i < 4; ++i) {
      const int n = nb * 32 + ty + 8 * i;
      dst[(size_t)(noff + n) * ldd + kb * 32 + tx] = f2bf(tile[tx * 33 + ty + 8 * i]);
    }
    __syncthreads();
  }
}

DI void phase_prep(const Params& p, int bid, int nblk, char* smem) {
  float* tile = (float*)smem;
  char* ws = p.ws;
  const int tid = threadIdx.x;
  tconv(p.w_in, 1024, INC, p.g_mix, (u16*)(ws + OFF_WINT), 1024, 0, bid, nblk, tile);
  for (int i = bid * NTHR + tid; i < 96 * 1024; i += nblk * NTHR) ((u16*)(ws + OFF_WINT))[2464 * 1024 + i] = 0;
  tconv(p.w_uq, 384, 768, p.g_cq, (u16*)(ws + OFF_WUQT), 384, 0, bid, nblk, tile);
  tconv(p.w_uk, 256, 512, p.g_ckv, (u16*)(ws + OFF_WUKVT), 256, 0, bid, nblk, tile);
  tconv(p.w_uv, 256, 512, p.g_ckv, (u16*)(ws + OFF_WUKVT), 256, 512, bid, nblk, tile);
  tconv(p.w2, 64, 512, nullptr, (u16*)(ws + OFF_W2T), 64, 0, bid, nblk, tile);
  tconv(p.a2, 64, 512, nullptr, (u16*)(ws + OFF_A2T), 64, 0, bid, nblk, tile);
  tconv(p.g2, 128, 512, nullptr, (u16*)(ws + OFF_G2T), 128, 0, bid, nblk, tile);
  tconv(p.w_o, 1024, 1024, nullptr, (u16*)(ws + OFF_WOT), 1024, 0, bid, nblk, tile);
  tconv(p.w_pq, 1024, 2048, p.g_ffn, (u16*)(ws + OFF_WPQT), 1024, 0, bid, nblk, tile);
  for (int i = bid * NTHR + tid; i < 16 * 128 * 128; i += nblk * NTHR) ((u16*)(ws + OFF_SUBK))[i] = f2bf(p.sub_keys[i]);
  for (int i = bid * NTHR + tid; i < T * 16; i += nblk * NTHR) {
    const int t = i >> 4, j = i & 15;
    const float inv = powf(10000.0f, -(float)j / 16.0f);
    const float ang = (float)p.pos[t] * inv;
    float s, c; sincosf(ang, &s, &c);
    float* rp = (float*)(ws + OFF_ROPE) + (size_t)t * 32;
    rp[j] = c; rp[16 + j] = s;
  }
  const int wid = tid >> 6, lane = tid & 63;
  for (int row = bid * 4 + wid; row < T; row += nblk * 4) {
    const float4* xr = (const float4*)(p.x + (size_t)row * DM);
    uint2* xb = (uint2*)(ws + OFF_XB + (size_t)row * DM * 2);
    float ss = 0.f;
#pragma unroll
    for (int i = 0; i < 4; ++i) {
      const float4 v = xr[lane + 64 * i];
      ss += v.x * v.x + v.y * v.y + v.z * v.z + v.w * v.w;
      xb[lane + 64 * i] = make_uint2(pack2(v.x, v.y), pack2(v.z, v.w));
    }
    ss = wave_allsum(ss);
    if (lane == 0) ((float*)(ws + OFF_RSTD1))[row] = rsqrtf(ss * (1.f / DM) + EPS);
  }
}

template <class Epi>
DI void gemm_tile(const u16* __restrict__ A, int lda, const u16* __restrict__ Bt, int ldb, int K, int m0, int n0,
                  Epi epi, char* smem) {
  u16* SA = (u16*)smem;
  u16* SB = SA + 128 * 32;
  const int tid = threadIdx.x, wid = tid >> 6, lane = tid & 63, wr = wid >> 1, wc = wid & 1, fr = lane & 15, fq = lane >> 4;
  f32x4 acc[4][4];
#pragma unroll
  for (int m = 0; m < 4; ++m)
#pragma unroll
    for (int n = 0; n < 4; ++n) acc[m][n] = f32x4{0.f, 0.f, 0.f, 0.f};
  const int nk = K / 32;
  for (int kt = 0; kt < nk; ++kt) {
#pragma unroll
    for (int i = 0; i < 2; ++i) {
      const int b = tid * 16 + i * 4096, r = b / 64, c = (b % 64) / 2;
      __builtin_amdgcn_global_load_lds((const unsigned*)(A + (size_t)(m0 + r) * lda + kt * 32 + c),
                                       (__attribute__((address_space(3))) unsigned*)((char*)SA + b), 16, 0, 0);
      __builtin_amdgcn_global_load_lds((const unsigned*)(Bt + (size_t)(n0 + r) * ldb + kt * 32 + c),
                                       (__attribute__((address_space(3))) unsigned*)((char*)SB + b), 16, 0, 0);
    }
    asm volatile("s_waitcnt vmcnt(0)" ::: "memory");
    __syncthreads();
    bf16x8 af[4], bfr[4];
#pragma unroll
    for (int m = 0; m < 4; ++m) af[m] = *reinterpret_cast<const bf16x8*>((char*)SA + (wr * 64 + m * 16 + fr) * 64 + fq * 16);
#pragma unroll
    for (int n = 0; n < 4; ++n) bfr[n] = *reinterpret_cast<const bf16x8*>((char*)SB + (wc * 64 + n * 16 + fr) * 64 + fq * 16);
#pragma unroll
    for (int m = 0; m < 4; ++m)
#pragma unroll
      for (int n = 0; n < 4; ++n) acc[m][n] = __builtin_amdgcn_mfma_f32_16x16x32_bf16(af[m], bfr[n], acc[m][n], 0, 0, 0);
    __syncthreads();
  }
#pragma unroll
  for (int m = 0; m < 4; ++m)
#pragma unroll
    for (int n = 0; n < 4; ++n)
#pragma unroll
      for (int j = 0; j < 4; ++j) epi(m0 + wr * 64 + m * 16 + fq * 4 + j, n0 + wc * 64 + n * 16 + fr, acc[m][n][j]);
}

DI void phase_gemm1(const Params& p, int bid, int nblk, char* smem) {
  char* ws = p.ws;
  const u16* A = (const u16*)(ws + OFF_XB);
  const u16* Bt = (const u16*)(ws + OFF_WINT);
  const float* rstd = (const float*)(ws + OFF_RSTD1);
  u16* PM = (u16*)(ws + OFF_PM);
  u16* PR = (u16*)(ws + OFF_PR);
  const int NT = 20;
  for (int tl = bid; tl < 256 * NT; tl += nblk) {
    const int mt = tl / NT, nt = tl % NT;
    gemm_tile(A, 1024, Bt, 1024, 1024, mt * 128, nt * 128,
              [&](int r, int c, float v) {
                if (c < INC) {
                  const u16 o = f2bf(v * rstd[r]);
                  if (c < MLAC) PM[(size_t)r * MLAC + c] = o; else PR[(size_t)r * RWC + (c - MLAC)] = o;
                }
              }, smem);
  }
}

DI void phase_2a(const Params& p, int bid, int nblk, char* smem) {
  char* ws = p.ws;
  const u16* PM = (const u16*)(ws + OFF_PM);
  const u16* PR = (const u16*)(ws + OFF_PR);
  u16* RS = (u16*)(ws + OFF_RS); u16* KS = (u16*)(ws + OFF_KS); u16* VS = (u16*)(ws + OFF_VS);
  u16* LI = (u16*)(ws + OFF_LORAIN);
  float* red = (float*)smem;
  const int tid = threadIdx.x, wid = tid >> 6, lane = tid & 63;
  for (int t = bid; t < T; t += nblk) {
    const u16* pm = PM + (size_t)t * MLAC;
    float q0 = bf2f(pm[tid]); float sq = q0 * q0;
    if (tid < 128) { const float q1 = bf2f(pm[256 + tid]); sq += q1 * q1; }
    const float kv = bf2f(pm[384 + tid]); float skv = kv * kv;
    sq = wave_allsum(sq); skv = wave_allsum(skv);
    if (lane == 0) { red[wid] = sq; red[4 + wid] = skv; }
    __syncthreads();
    if (tid == 0) {
      ((float*)(ws + OFF_RSTDQ))[t] = rsqrtf((red[0] + red[1] + red[2] + red[3]) * (1.f / 384.f) + EPS);
      ((float*)(ws + OFF_RSTDKV))[t] = rsqrtf((red[4] + red[5] + red[6] + red[7]) * (1.f / 256.f) + EPS);
    }
    __syncthreads();
    const bool first = (t % SEQ) == 0;
    const u16* cur = PR + (size_t)t * RWC;
    const u16* prv = cur - RWC;
#pragma unroll
    for (int i = 0; i < 7; ++i) {
      const int c = tid + 256 * i;
      const float cv = bf2f(cur[c]);
      const float pv = first ? 0.f : bf2f(prv[c]);
      const float v = cv + (pv - cv) * p.rwkv_mu[c];
      if (c < 512) RS[(size_t)t * 512 + c] = f2bf(v);
      else if (c < 1024) KS[(size_t)t * 512 + c - 512] = f2bf(v);
      else if (c < 1536) VS[(size_t)t * 512 + c - 1024] = f2bf(v);
      else if (c < 1600) LI[(size_t)t * 256 + c - 1536] = f2bf(tanhf(v));
      else if (c < 1664) LI[(size_t)t * 256 + c - 1536] = f2bf(v);
      else LI[(size_t)t * 256 + c - 1536] = f2bf(sigmoidf_(v));
    }
  }
}

DI void phase_2b(const Params& p, int bid, int nblk, char* smem) {
  char* ws = p.ws;
  const u16* PM = (const u16*)(ws + OFF_PM);
  const u16* LI = (const u16*)(ws + OFF_LORAIN);
  const float* rq = (const float*)(ws + OFF_RSTDQ);
  const float* rkv = (const float*)(ws + OFF_RSTDKV);
  u16* QRAW = (u16*)(ws + OFF_QRAW); u16* KVRAW = (u16*)(ws + OFF_KVRAW);
  u16* U = (u16*)(ws + OFF_U); u16* G = (u16*)(ws + OFF_G);
  u16* AA = (u16*)((char*)p.out + DO_AA);
  const int NT = 26;
  for (int tl = bid; tl < 256 * NT; tl += nblk) {
    const int mt = tl / NT, j = tl % NT, m0 = mt * 128;
    if (j < 6) {
      gemm_tile(PM, MLAC, (const u16*)(ws + OFF_WUQT), 384, 384, m0, j * 128,
                [&](int r, int c, float v) { QRAW[(size_t)r * 768 + c] = f2bf(v * rq[r]); }, smem);
    } else if (j < 14) {
      gemm_tile(PM + 384, MLAC, (const u16*)(ws + OFF_WUKVT), 256, 256, m0, (j - 6) * 128,
                [&](int r, int c, float v) { KVRAW[(size_t)r * 1024 + c] = f2bf(v * rkv[r]); }, smem);
    } else if (j < 18) {
      gemm_tile(LI, 256, (const u16*)(ws + OFF_W2T), 64, 64, m0, (j - 14) * 128,
                [&](int r, int c, float v) {
                  const float sg = sigmoidf_(p.w0[c] + v);
                  U[(size_t)r * 512 + c] = f2bf(-expm1f(-0.6065306597126334f * sg));
                }, smem);
    } else if (j < 22) {
      gemm_tile(LI + 64, 256, (const u16*)(ws + OFF_A2T), 64, 64, m0, (j - 18) * 128,
                [&](int r, int c, float v) { AA[(size_t)r * 512 + c] = f2bf(sigmoidf_(p.a0[c] + v)); }, smem);
    } else {
      gemm_tile(LI + 128, 256, (const u16*)(ws + OFF_G2T), 128, 128, m0, (j - 22) * 128,
                [&](int r, int c, float v) { G[(size_t)r * 512 + c] = f2bf(v); }, smem);
    }
  }
}

DI void phase_2c(const Params& p, int bid, int nblk, char* smem) {
  char* ws = p.ws;
  const u16* PM = (const u16*)(ws + OFF_PM);
  const u16* QRAW = (const u16*)(ws + OFF_QRAW);
  const u16* KVRAW = (const u16*)(ws + OFF_KVRAW);
  u16* Q = (u16*)((char*)p.out + DO_Q); u16* Kd = (u16*)((char*)p.out + DO_K);
  const u16* AA = (const u16*)((char*)p.out + DO_AA);
  u16* KS = (u16*)(ws + OFF_KS); u16* KK = (u16*)(ws + OFF_KK); u16* BB = (u16*)(ws + OFF_BB);
  const float* rope = (const float*)(ws + OFF_ROPE);
  const int tid = threadIdx.x, wid = tid >> 6, lane = tid & 63;
  const float QSCALE = 0.10206207261596575f * 1.4426950408889634f;
  for (int t = bid * 4 + wid; t < T; t += nblk * 4) {
    const int e0 = 2 * lane;
    const bool act = lane < 48;
    const bool isrope = lane >= 32 && lane < 48;
    const bool second = lane >= 40;
    float cs0 = 0.f, cs1 = 0.f, sn0 = 0.f, sn1 = 0.f;
    if (isrope) {
      const int i0 = e0 - (second ? 80 : 64);
      cs0 = rope[(size_t)t * 32 + i0]; cs1 = rope[(size_t)t * 32 + i0 + 1];
      sn0 = rope[(size_t)t * 32 + 16 + i0]; sn1 = rope[(size_t)t * 32 + 16 + i0 + 1];
    }
    float gq0 = 0.f, gq1 = 0.f, gk0 = 0.f, gk1 = 0.f;
    if (act) { gq0 = p.g_qnorm[e0]; gq1 = p.g_qnorm[e0 + 1]; gk0 = p.g_knorm[e0]; gk1 = p.g_knorm[e0 + 1]; }
    for (int h = 0; h < 8; ++h) {
#pragma unroll
      for (int which = 0; which < 2; ++which) {
        float v0 = 0.f, v1 = 0.f;
        if (act) {
          unsigned raw;
          if (which == 0) raw = *(const unsigned*)(QRAW + (size_t)t * 768 + h * 96 + e0);
          else if (e0 < 64) raw = *(const unsigned*)(KVRAW + (size_t)t * 1024 + h * 64 + e0);
          else raw = *(const unsigned*)(PM + (size_t)t * MLAC + 640 + (e0 - 64));
          v0 = bflo(raw); v1 = bfhi(raw);
        }
        const float ss = wave_allsum(v0 * v0 + v1 * v1);
        const float rs = rsqrtf(ss * (1.f / 96.f) + EPS);
        v0 *= rs * (which == 0 ? gq0 : gk0);
        v1 *= rs * (which == 0 ? gq1 : gk1);
        const float o0 = __shfl_xor(v0, 8), o1 = __shfl_xor(v1, 8);
        if (isrope) {
          if (!second) { v0 = v0 * cs0 - o0 * sn0; v1 = v1 * cs1 - o1 * sn1; }
          else { v0 = o0 * sn0 + v0 * cs0; v1 = o1 * sn1 + v1 * cs1; }
        }
        if (act) {
          if (which == 0) *(unsigned*)(Q + (size_t)t * 768 + h * 96 + e0) = pack2(v0 * QSCALE, v1 * QSCALE);
          else *(unsigned*)(Kd + (size_t)t * 768 + h * 96 + e0) = pack2(v0, v1);
        }
      }
    }
    {
      const int c0 = 8 * lane;
      const uint4 kraw = *(const uint4*)(KS + (size_t)t * 512 + c0);
      const uint4 araw = *(const uint4*)(AA + (size_t)t * 512 + c0);
      float kv[8], av[8], kkv[8];
      kv[0] = bflo(kraw.x); kv[1] = bfhi(kraw.x); kv[2] = bflo(kraw.y); kv[3] = bfhi(kraw.y);
      kv[4] = bflo(kraw.z); kv[5] = bfhi(kraw.z); kv[6] = bflo(kraw.w); kv[7] = bfhi(kraw.w);
      av[0] = bflo(araw.x); av[1] = bfhi(araw.x); av[2] = bflo(araw.y); av[3] = bfhi(araw.y);
      av[4] = bflo(araw.z); av[5] = bfhi(araw.z); av[6] = bflo(araw.w); av[7] = bfhi(araw.w);
      float ss = 0.f;
#pragma unroll
      for (int i = 0; i < 8; ++i) { kkv[i] = kv[i] * p.k_k[c0 + i]; ss += kkv[i] * kkv[i]; }
      ss += __shfl_xor(ss, 1); ss += __shfl_xor(ss, 2); ss += __shfl_xor(ss, 4);
      const float inv = 1.f / fmaxf(sqrtf(ss), 1e-12f);
      float kn[8], bb[8], k2[8];
#pragma unroll
      for (int i = 0; i < 8; ++i) {
        kn[i] = kkv[i] * inv;
        bb[i] = kn[i] * av[i];
        k2[i] = kv[i] * (1.f + (av[i] - 1.f) * p.k_a[c0 + i]);
      }
      *(uint4*)(KK + (size_t)t * 512 + c0) = make_uint4(pack2(kn[0], kn[1]), pack2(kn[2], kn[3]), pack2(kn[4], kn[5]), pack2(kn[6], kn[7]));
      *(uint4*)(BB + (size_t)t * 512 + c0) = make_uint4(pack2(bb[0], bb[1]), pack2(bb[2], bb[3]), pack2(bb[4], bb[5]), pack2(bb[6], bb[7]));
      *(uint4*)(KS + (size_t)t * 512 + c0) = make_uint4(pack2(k2[0], k2[1]), pack2(k2[2], k2[3]), pack2(k2[4], k2[5]), pack2(k2[6], k2[7]));
    }
  }
}

DI s16x4 tr_read(unsigned lds_addr) {
  s16x4 r;
  asm volatile("ds_read_b64_tr_b16 %0, %1\n\ts_waitcnt lgkmcnt(0)" : "=&v"(r) : "v"(lds_addr) : "memory");
  return r;
}
#define MFMA32(a, b, c) __builtin_amdgcn_mfma_f32_32x32x16_bf16((a), (b), (c), 0, 0, 0)

constexpr int KLD = 208, VLD = 192;
constexpr int ATT_KOFF = 0, ATT_VOFF = 64 * KLD;
DI void phase_attn(const Params& p, int bid, int nblk, char* smem) {
  char* ws = p.ws;
  const u16* Q = (const u16*)((char*)p.out + DO_Q);
  const u16* Kd = (const u16*)((char*)p.out + DO_K);
  const u16* KVRAW = (const u16*)(ws + OFF_KVRAW);
  u16* Y = (u16*)(ws + OFF_Y);
  const int tid = threadIdx.x, w = tid >> 6, lane = tid & 63, r = lane & 31, hh = lane >> 5;
  const unsigned lds_base = (unsigned)(size_t)smem;
  for (int it = bid; it < 2048; it += nblk) {
    const int rd = it >> 9, pos = it & 511, g = pos >> 7, bh = pos & 127;
    const int m = rd == 0 ? 15 - g : rd == 1 ? 8 + g : rd == 2 ? 7 - g : g;
    const int b = bh >> 3, h = bh & 7;
    const int t0 = b * SEQ + 128 * m;
    const int cw = 2 * m + (w >> 1);
    const int tq = t0 + 32 * w + r;
    bf16x8 qf[6];
#pragma unroll
    for (int ks = 0; ks < 6; ++ks) qf[ks] = *reinterpret_cast<const bf16x8*>(Q + (size_t)tq * 768 + h * 96 + 16 * ks + 8 * hh);
    f32x16 O0, O1;
#pragma unroll
    for (int i = 0; i < 16; ++i) { O0[i] = 0.f; O1[i] = 0.f; }
    float mrun = -1e30f, lrun = 0.f;
    const int nkt = 2 * m + 2;
    for (int kt = 0; kt < nkt; ++kt) {
      __syncthreads();
      const int tk0 = b * SEQ + 64 * kt;
#pragma unroll
      for (int i = 0; i < 3; ++i) {
        const int c = tid + 256 * i, row = c / 12, cc = c % 12;
        const uint4 v = *(const uint4*)(Kd + (size_t)(tk0 + row) * 768 + h * 96 + cc * 8);
        *(uint4*)(smem + ATT_KOFF + row * KLD + cc * 16) = v;
      }
#pragma unroll
      for (int i = 0; i < 2; ++i) {
        const int c = tid + 256 * i, row = c >> 3, cc = c & 7;
        const uint4 v = *(const uint4*)(KVRAW + (size_t)(tk0 + row) * 1024 + 512 + h * 64 + cc * 8);
        *(uint4*)(smem + ATT_VOFF + row * VLD + cc * 16) = v;
      }
      __syncthreads();
      if (kt <= cw) {
        f32x16 X[2];
#pragma unroll
        for (int sub = 0; sub < 2; ++sub) {
#pragma unroll
          for (int i = 0; i < 16; ++i) X[sub][i] = 0.f;
#pragma unroll
          for (int ks = 0; ks < 6; ++ks) {
            const bf16x8 a = *reinterpret_cast<const bf16x8*>(smem + ATT_KOFF + (32 * sub + r) * KLD + (16 * ks + 8 * hh) * 2);
            X[sub] = MFMA32(a, qf[ks], X[sub]);
          }
        }
        float mx = X[0][0];
#pragma unroll
        for (int i = 0; i < 16; ++i) { mx = fmaxf(mx, X[0][i]); mx = fmaxf(mx, X[1][i]); }
        mx = fmaxf(mx, __shfl_xor(mx, 32));
        const float mnew = fmaxf(mrun, mx);
        const float alpha = exp2f(mrun - mnew);
        mrun = mnew;
        float rsum = 0.f;
#pragma unroll
        for (int sub = 0; sub < 2; ++sub)
#pragma unroll
          for (int i = 0; i < 16; ++i) { const float e = exp2f(X[sub][i] - mnew); X[sub][i] = e; rsum += e; }
        lrun = lrun * alpha + rsum;
#pragma unroll
        for (int i = 0; i < 16; ++i) { O0[i] *= alpha; O1[i] *= alpha; }
        const int i16 = lane & 15, q4 = i16 >> 2, p4 = i16 & 3, blk = (lane >> 4) & 1;
#pragma unroll
        for (int sub = 0; sub < 2; ++sub) {
#pragma unroll
          for (int s = 0; s < 2; ++s) {
            bf16x8 pb;
#pragma unroll
            for (int j = 0; j < 8; ++j) pb[j] = (short)f2bf(X[sub][8 * s + j]);
            const unsigned rowlo = 32 * sub + 16 * s + 4 * hh + q4;
#pragma unroll
            for (int dt = 0; dt < 2; ++dt) {
              const unsigned colb = (32 * dt + 16 * blk) * 2 + 8 * p4;
              const s16x4 lo = tr_read(lds_base + ATT_VOFF + rowlo * VLD + colb);
              const s16x4 hi = tr_read(lds_base + ATT_VOFF + (rowlo + 8) * VLD + colb);
              const bf16x8 a = __builtin_shufflevector(lo, hi, 0, 1, 2, 3, 4, 5, 6, 7);
              if (dt == 0) O0 = MFMA32(a, pb, O0); else O1 = MFMA32(a, pb, O1);
            }
          }
        }
      }
    }
    const float ltot = lrun + __shfl_xor(lrun, 32);
    const float inv = 1.f / ltot;
    float ss = 0.f;
#pragma unroll
    for (int i = 0; i < 16; ++i) { O0[i] *= inv; O1[i] *= inv; ss += O0[i] * O0[i] + O1[i] * O1[i]; }
    ss += __shfl_xor(ss, 32);
    const float rs = rsqrtf(ss * (1.f / 64.f) + EPS);
#pragma unroll
    for (int dt = 0; dt < 2; ++dt)
#pragma unroll
      for (int gq = 0; gq < 4; ++gq) {
        const int d = 32 * dt + 8 * gq + 4 * hh;
        const float* gp = p.g_attn_out + h * 64 + d;
        float o[4];
#pragma unroll
        for (int j = 0; j < 4; ++j) o[j] = (dt == 0 ? O0[4 * gq + j] : O1[4 * gq + j]) * rs * gp[j];
        *(uint2*)(Y + (size_t)tq * 1024 + h * 64 + d) = make_uint2(pack2(o[0], o[1]), pack2(o[2], o[3]));
      }
  }
}

DI float row16_allsum(float v) {
  v += __shfl_xor(v, 8); v += __shfl_xor(v, 4); v += __shfl_xor(v, 2); v += __shfl_xor(v, 1);
  return v;
}
struct ScanIn { uint2 kk, u, b, k, r; u16 v; };
DI void scan_load(ScanIn& s, const u16* KK, const u16* U, const u16* BB, const u16* KS, const u16* RS, const u16* VS,
                  size_t tok, int cj, int ci) {
  const size_t o = tok * 512;
  s.kk = *(const uint2*)(KK + o + cj); s.u = *(const uint2*)(U + o + cj); s.b = *(const uint2*)(BB + o + cj);
  s.k = *(const uint2*)(KS + o + cj); s.r = *(const uint2*)(RS + o + cj); s.v = VS[o + ci];
}
DI void phase_scan(const Params& p, int bid, int nblk, char* smem) {
  char* ws = p.ws;
  const u16* KK = (const u16*)(ws + OFF_KK); const u16* U = (const u16*)(ws + OFF_U); const u16* BB = (const u16*)(ws + OFF_BB);
  const u16* KS = (const u16*)(ws + OFF_KS); const u16* RS = (const u16*)(ws + OFF_RS); const u16* VS = (const u16*)(ws + OFF_VS);
  float* YRAW = (float*)(ws + OFF_YRAW);
  const int tid = threadIdx.x, w = tid >> 6, lane = tid & 63, jq = lane & 15;
  for (int unit = bid; unit < 512; unit += nblk) {
    const int bh = unit >> 2, rg = unit & 3, b = bh >> 3, h = bh & 7;
    const int i = 16 * rg + 4 * w + (lane >> 4);
    const int cj = h * 64 + 4 * jq, ci = h * 64 + i;
    const size_t tb = (size_t)b * SEQ;
    float S0 = 0.f, S1 = 0.f, S2 = 0.f, S3 = 0.f;
    constexpr int PF = 8;
    ScanIn cur[PF], nxt[PF];
#pragma unroll
    for (int q = 0; q < PF; ++q) scan_load(cur[q], KK, U, BB, KS, RS, VS, tb + q, cj, ci);
    for (int s0 = 0; s0 < SEQ; s0 += PF) {
      if (s0 + PF < SEQ) {
#pragma unroll
        for (int q = 0; q < PF; ++q) scan_load(nxt[q], KK, U, BB, KS, RS, VS, tb + s0 + PF + q, cj, ci);
      }
#pragma unroll
      for (int q = 0; q < PF; ++q) {
        const ScanIn& c = cur[q];
        const float kk0 = bflo(c.kk.x), kk1 = bfhi(c.kk.x), kk2 = bflo(c.kk.y), kk3 = bfhi(c.kk.y);
        float sk = S0 * kk0 + S1 * kk1 + S2 * kk2 + S3 * kk3;
        sk = row16_allsum(sk);
        const float v = bf2f(c.v);
        S0 = S0 * (1.f - bflo(c.u.x)) - sk * bflo(c.b.x) + v * bflo(c.k.x);
        S1 = S1 * (1.f - bfhi(c.u.x)) - sk * bfhi(c.b.x) + v * bfhi(c.k.x);
        S2 = S2 * (1.f - bflo(c.u.y)) - sk * bflo(c.b.y) + v * bflo(c.k.y);
        S3 = S3 * (1.f - bfhi(c.u.y)) - sk * bfhi(c.b.y) + v * bfhi(c.k.y);
        float y = S0 * bflo(c.r.x) + S1 * bfhi(c.r.x) + S2 * bflo(c.r.y) + S3 * bfhi(c.r.y);
        y = row16_allsum(y);
        if (jq == 0) YRAW[(tb + s0 + q) * 512 + ci] = y;
      }
#pragma unroll
      for (int q = 0; q < PF; ++q) cur[q] = nxt[q];
    }
  }
}

DI void phase_3c(const Params& p, int bid, int nblk, char* smem) {
  char* ws = p.ws;
  const float* YRAW = (const float*)(ws + OFF_YRAW);
  const u16* KS = (const u16*)(ws + OFF_KS); const u16* RS = (const u16*)(ws + OFF_RS); const u16* VS = (const u16*)(ws + OFF_VS);
  const u16* G = (const u16*)(ws + OFF_G);
  u16* Y = (u16*)(ws + OFF_Y);
  const int tid = threadIdx.x, wid = tid >> 6, lane = tid & 63;
  for (int t = bid * 4 + wid; t < T; t += nblk * 4) {
    const int c0 = 8 * lane;
    const float4 y0 = *(const float4*)(YRAW + (size_t)t * 512 + c0);
    const float4 y1 = *(const float4*)(YRAW + (size_t)t * 512 + c0 + 4);
    float y[8] = {y0.x, y0.y, y0.z, y0.w, y1.x, y1.y, y1.z, y1.w};
    const uint4 rr = *(const uint4*)(RS + (size_t)t * 512 + c0);
    const uint4 kr = *(const uint4*)(KS + (size_t)t * 512 + c0);
    const uint4 vr = *(const uint4*)(VS + (size_t)t * 512 + c0);
    const uint4 gr = *(const uint4*)(G + (size_t)t * 512 + c0);
    float rv[8] = {bflo(rr.x), bfhi(rr.x), bflo(rr.y), bfhi(rr.y), bflo(rr.z), bfhi(rr.z), bflo(rr.w), bfhi(rr.w)};
    float kv[8] = {bflo(kr.x), bfhi(kr.x), bflo(kr.y), bfhi(kr.y), bflo(kr.z), bfhi(kr.z), bflo(kr.w), bfhi(kr.w)};
    float vv[8] = {bflo(vr.x), bfhi(vr.x), bflo(vr.y), bfhi(vr.y), bflo(vr.z), bfhi(vr.z), bflo(vr.w), bfhi(vr.w)};
    float gv[8] = {bflo(gr.x), bfhi(gr.x), bflo(gr.y), bfhi(gr.y), bflo(gr.z), bfhi(gr.z), bflo(gr.w), bfhi(gr.w)};
    float sm = 0.f, bsum = 0.f;
#pragma unroll
    for (int i = 0; i < 8; ++i) { sm += y[i]; bsum += rv[i] * kv[i] * p.r_k[c0 + i]; }
    sm += __shfl_xor(sm, 1); sm += __shfl_xor(sm, 2); sm += __shfl_xor(sm, 4);
    bsum += __shfl_xor(bsum, 1); bsum += __shfl_xor(bsum, 2); bsum += __shfl_xor(bsum, 4);
    const float mu = sm * (1.f / 64.f);
    float var = 0.f;
#pragma unroll
    for (int i = 0; i < 8; ++i) { const float d = y[i] - mu; var += d * d; }
    var += __shfl_xor(var, 1); var += __shfl_xor(var, 2); var += __shfl_xor(var, 4);
    const float rs = rsqrtf(var * (1.f / 64.f) + 64e-5f);
    float o[8];
#pragma unroll
    for (int i = 0; i < 8; ++i) o[i] = ((y[i] - mu) * rs * p.ln_x_w[c0 + i] + p.ln_x_b[c0 + i] + bsum * vv[i]) * gv[i];
    *(uint4*)(Y + (size_t)t * 1024 + 512 + c0) = make_uint4(pack2(o[0], o[1]), pack2(o[2], o[3]), pack2(o[4], o[5]), pack2(o[6], o[7]));
  }
}

DI void phase_wo(const Params& p, int bid, int nblk, char* smem) {
  char* ws = p.ws;
  const int tid = threadIdx.x;
  {
    uint2* EU = (uint2*)(ws + OFF_EU); uint2* EV = (uint2*)(ws + OFF_EV);
    const float4* su = (const float4*)p.expert_u; const float4* sv = (const float4*)p.expert_v;
    const float4* gf = (const float4*)p.g_ffn;
    for (size_t i = (size_t)bid * NTHR + tid; i < (size_t)16384 * 256; i += (size_t)nblk * NTHR) {
      const float4 g = gf[i & 255];
      const float4 a = su[i], b = sv[i];
      EU[i] = make_uint2(pack2(a.x * g.x, a.y * g.y), pack2(a.z * g.z, a.w * g.w));
      EV[i] = make_uint2(pack2(b.x, b.y), pack2(b.z, b.w));
    }
  }
  const u16* Y = (const u16*)(ws + OFF_Y);
  const int NT = 8;
  for (int tl = bid; tl < 256 * NT; tl += nblk) {
    const int mt = tl / NT, nt = tl % NT;
    gemm_tile(Y, 1024, (const u16*)(ws + OFF_WOT), 1024, 1024, mt * 128, nt * 128,
              [&](int r, int c, float v) { p.out[(size_t)r * DM + c] = p.x[(size_t)r * DM + c] + v; }, smem);
  }
}

DI void phase_5(const Params& p, int bid, int nblk, char* smem) {
  char* ws = p.ws;
  const int tid = threadIdx.x, wid = tid >> 6, lane = tid & 63;
  for (int row = bid * 4 + wid; row < T; row += nblk * 4) {
    const float4* xr = (const float4*)(p.out + (size_t)row * DM);
    uint2* xb = (uint2*)(ws + OFF_X2B + (size_t)row * DM * 2);
    float ss = 0.f;
#pragma unroll
    for (int i = 0; i < 4; ++i) {
      const float4 v = xr[lane + 64 * i];
      ss += v.x * v.x + v.y * v.y + v.z * v.z + v.w * v.w;
      xb[lane + 64 * i] = make_uint2(pack2(v.x, v.y), pack2(v.z, v.w));
    }
    ss = wave_allsum(ss);
    if (lane == 0) ((float*)(ws + OFF_RSTD2))[row] = rsqrtf(ss * (1.f / DM) + EPS);
  }
}

DI void phase_6(const Params& p, int bid, int nblk, char* smem) {
  char* ws = p.ws;
  const float* rstd = (const float*)(ws + OFF_RSTD2);
  u16* QP = (u16*)(ws + OFF_QP);
  const int NT = 16;
  for (int tl = bid; tl < 256 * NT; tl += nblk) {
    const int mt = tl / NT, nt = tl % NT;
    gemm_tile((const u16*)(ws + OFF_X2B), 1024, (const u16*)(ws + OFF_WPQT), 1024, 1024, mt * 128, nt * 128,
              [&](int r, int c, float v) { QP[(size_t)r * 2048 + c] = f2bf(v * rstd[r]); }, smem);
  }
}

DI void ins16(float (&top)[16], float x) {
#pragma unroll
  for (int i = 0; i < 16; ++i) { const float hi = fmaxf(top[i], x); x = fminf(top[i], x); top[i] = hi; }
}
DI void phase_7(const Params& p, int bid, int nblk, char* smem) {
  char* ws = p.ws;
  const u16* QP = (const u16*)(ws + OFF_QP);
  const u16* SUBK = (const u16*)(ws + OFF_SUBK);
  u16* IDX = (u16*)(ws + OFF_IDX); float* GATE = (float*)(ws + OFF_GATE);
  float* lists = (float*)smem;
  const int tid = threadIdx.x, w = tid >> 6, lane = tid & 63, r = lane & 31, hh = lane >> 5;
  const int th = w & 1, pp = w >> 1;
  for (int it = bid; it < 512 * 8; it += nblk) {
    const int tt = it >> 3, h = it & 7;
    const int t = tt * 64 + 32 * th + r;
    bf16x8 qf[8];
#pragma unroll
    for (int ks = 0; ks < 8; ++ks) qf[ks] = *reinterpret_cast<const bf16x8*>(QP + (size_t)t * 2048 + h * 256 + pp * 128 + 16 * ks + 8 * hh);
    const u16* sk = SUBK + (size_t)(h * 2 + pp) * 128 * 128;
    float top[16];
#pragma unroll
    for (int i = 0; i < 16; ++i) top[i] = -INFINITY;
#pragma unroll
    for (int kt = 0; kt < 4; ++kt) {
      f32x16 acc;
#pragma unroll
      for (int i = 0; i < 16; ++i) acc[i] = 0.f;
#pragma unroll
      for (int ks = 0; ks < 8; ++ks) {
        const bf16x8 a = *reinterpret_cast<const bf16x8*>(sk + (size_t)(32 * kt + r) * 128 + 16 * ks + 8 * hh);
        acc = MFMA32(a, qf[ks], acc);
      }
#pragma unroll
      for (int i = 0; i < 16; ++i) {
        const unsigned key = 32 * kt + (i & 3) + 8 * (i >> 2) + 4 * hh;
        const float v = __uint_as_float((__float_as_uint(acc[i]) & ~127u) | key);
        ins16(top, v);
      }
    }
    float oth[16];
#pragma unroll
    for (int i = 0; i < 16; ++i) oth[i] = __shfl_xor(top[i], 32);
#pragma unroll
    for (int i = 0; i < 16; ++i) ins16(top, oth[i]);
    __syncthreads();
    if (hh == 0) {
      float* dst = lists + ((32 * th + r) * 2 + pp) * 16;
#pragma unroll
      for (int i = 0; i < 16; i += 4) *(float4*)(dst + i) = make_float4(top[i], top[i + 1], top[i + 2], top[i + 3]);
    }
    __syncthreads();
    if (tid < 64) {
      const float* l1 = lists + (tid * 2 + 0) * 16;
      const float* l2 = lists + (tid * 2 + 1) * 16;
      float s1[16], s2[16];
#pragma unroll
      for (int i = 0; i < 16; ++i) {
        s1[i] = __uint_as_float(__float_as_uint(l1[i]) & ~127u);
        s2[i] = __uint_as_float(__float_as_uint(l2[i]) & ~127u);
      }
      float ts[16];
#pragma unroll
      for (int i = 0; i < 16; ++i) ts[i] = -INFINITY;
#pragma unroll
      for (int a = 0; a < 16; ++a)
#pragma unroll
        for (int b = 0; b < 16; ++b)
          if ((a + 1) * (b + 1) <= 16) {
            const float sm = s1[a] + s2[b];
            ins16(ts, __uint_as_float((__float_as_uint(sm) & ~255u) | (unsigned)(a * 16 + b)));
          }
      const size_t ob = ((size_t)(tt * 64 + tid) * 8 + h) * 16;
      float e[16], esum = 0.f;
      const float mx = __uint_as_float(__float_as_uint(ts[0]) & ~255u);
#pragma unroll
      for (int i = 0; i < 16; ++i) {
        const unsigned bits = __float_as_uint(ts[i]);
        const unsigned cid = bits & 255u;
        const float val = __uint_as_float(bits & ~255u);
        e[i] = __expf(val - mx); esum += e[i];
        const unsigned i1 = __float_as_uint(l1[cid >> 4]) & 127u, i2 = __float_as_uint(l2[cid & 15]) & 127u;
        IDX[ob + i] = (u16)(i1 * 128 + i2);
      }
      const float inv = 1.f / esum;
#pragma unroll
      for (int i = 0; i < 16; ++i) GATE[ob + i] = e[i] * inv;
    }
  }
}

typedef __bf16 bf2_t __attribute__((ext_vector_type(2)));
DI float dot2bf(unsigned a, unsigned b, float c) {
  return __builtin_amdgcn_fdot2_f32_bf16(__builtin_bit_cast(bf2_t, a), __builtin_bit_cast(bf2_t, b), c, false);
}
DI unsigned xcc_id_() { return (unsigned)__builtin_amdgcn_s_getreg((3 << 11) | 20) & 0xFu; }
DI unsigned idx_get(const uint4& a, const uint4& b, int j) {
  const unsigned w = j < 8 ? (j < 2 ? a.x : j < 4 ? a.y : j < 6 ? a.z : a.w) : (j < 10 ? b.x : j < 12 ? b.y : j < 14 ? b.z : b.w);
  return (j & 1) ? (w >> 16) : (w & 0xffffu);
}

DI void peer_u_item(const Params& p, int s, int item) {
  char* ws = p.ws;
  const u16* X2B = (const u16*)(ws + OFF_X2B);
  const u16* EU = (const u16*)(ws + OFF_EU);
  const u16* IDX = (const u16*)(ws + OFF_IDX);
  float* PART = (float*)(ws + OFF_PART) + (size_t)s * T * 128;
  const int tid = threadIdx.x, w = tid >> 6, lane = tid & 63, g8 = lane >> 3, c = lane & 7;
  const int tw = item * 64 + 16 * w;
  const size_t coff = 64 * s + 8 * c;
  uint4 i0 = *(const uint4*)(IDX + (size_t)tw * 128 + 16 * g8);
  uint4 i1 = *(const uint4*)(IDX + (size_t)tw * 128 + 16 * g8 + 8);
  for (int tt = 0; tt < 16; ++tt) {
    const int t = tw + tt;
    const uint4 xa = *(const uint4*)(X2B + (size_t)t * DM + coff);
    uint4 rows[16];
#pragma unroll
    for (int j = 0; j < 16; ++j) rows[j] = *(const uint4*)(EU + (size_t)idx_get(i0, i1, j) * DM + coff);
    if (tt < 15) {
      i0 = *(const uint4*)(IDX + (size_t)(t + 1) * 128 + 16 * g8);
      i1 = *(const uint4*)(IDX + (size_t)(t + 1) * 128 + 16 * g8 + 8);
    }
    float r[16];
#pragma unroll
    for (int j = 0; j < 16; ++j) {
      float d = dot2bf(xa.x, rows[j].x, 0.f);
      d = dot2bf(xa.y, rows[j].y, d); d = dot2bf(xa.z, rows[j].z, d); d = dot2bf(xa.w, rows[j].w, d);
      r[j] = d;
    }
#pragma unroll
    for (int j = 0; j < 8; ++j) { const bool hi = c & 4; const float keep = hi ? r[j + 8] : r[j], send = hi ? r[j] : r[j + 8]; r[j] = keep + __shfl_xor(send, 4); }
#pragma unroll
    for (int j = 0; j < 4; ++j) { const bool hi = c & 2; const float keep = hi ? r[j + 4] : r[j], send = hi ? r[j] : r[j + 4]; r[j] = keep + __shfl_xor(send, 2); }
#pragma unroll
    for (int j = 0; j < 2; ++j) { const bool hi = c & 1; const float keep = hi ? r[j + 2] : r[j], send = hi ? r[j] : r[j + 2]; r[j] = keep + __shfl_xor(send, 1); }
    *(float2*)(PART + (size_t)t * 128 + 2 * lane) = make_float2(r[0], r[1]);
  }
}

DI void peer_v_item(const Params& p, int s, int item) {
  char* ws = p.ws;
  const u16* EV = (const u16*)(ws + OFF_EV);
  const u16* IDX = (const u16*)(ws + OFF_IDX);
  const float* WGT = (const float*)(ws + OFF_WGT);
  const int tid = threadIdx.x, w = tid >> 6, lane = tid & 63, g8 = lane >> 3, c = lane & 7;
  const int tw = item * 64 + 16 * w;
  const size_t coff = 64 * s + 8 * c;
  uint4 i0 = *(const uint4*)(IDX + (size_t)tw * 128 + 16 * g8);
  uint4 i1 = *(const uint4*)(IDX + (size_t)tw * 128 + 16 * g8 + 8);
  for (int tt = 0; tt < 16; ++tt) {
    const int t = tw + tt;
    float wg[16];
    {
      const float4* wp = (const float4*)(WGT + (size_t)t * 128 + 16 * g8);
#pragma unroll
      for (int q = 0; q < 4; ++q) { const float4 v = wp[q]; wg[4 * q] = v.x; wg[4 * q + 1] = v.y; wg[4 * q + 2] = v.z; wg[4 * q + 3] = v.w; }
    }
    uint4 rows[16];
#pragma unroll
    for (int j = 0; j < 16; ++j) rows[j] = *(const uint4*)(EV + (size_t)idx_get(i0, i1, j) * DM + coff);
    if (tt < 15) {
      i0 = *(const uint4*)(IDX + (size_t)(t + 1) * 128 + 16 * g8);
      i1 = *(const uint4*)(IDX + (size_t)(t + 1) * 128 + 16 * g8 + 8);
    }
    float a[8];
#pragma unroll
    for (int i = 0; i < 8; ++i) a[i] = 0.f;
#pragma unroll
    for (int j = 0; j < 16; ++j) {
      a[0] += wg[j] * bflo(rows[j].x); a[1] += wg[j] * bfhi(rows[j].x); a[2] += wg[j] * bflo(rows[j].y); a[3] += wg[j] * bfhi(rows[j].y);
      a[4] += wg[j] * bflo(rows[j].z); a[5] += wg[j] * bfhi(rows[j].z); a[6] += wg[j] * bflo(rows[j].w); a[7] += wg[j] * bfhi(rows[j].w);
    }
#pragma unroll
    for (int i = 0; i < 4; ++i) { const bool hi = g8 & 4; const float keep = hi ? a[i + 4] : a[i], send = hi ? a[i] : a[i + 4]; a[i] = keep + __shfl_xor(send, 32); }
#pragma unroll
    for (int i = 0; i < 2; ++i) { const bool hi = g8 & 2; const float keep = hi ? a[i + 2] : a[i], send = hi ? a[i] : a[i + 2]; a[i] = keep + __shfl_xor(send, 16); }
    { const bool hi = g8 & 1; const float keep = hi ? a[1] : a[0], send = hi ? a[0] : a[1]; a[0] = keep + __shfl_xor(send, 8); }
    float* op = p.out + (size_t)t * DM + coff + g8;
    *op = *op + a[0];
  }
}

template <int WHICH>
DI void phase_peer_queue(const Params& p, int bid, int nblk, char* smem) {
  unsigned* ctr = (unsigned*)(p.ws + OFF_QCTR) + WHICH * NSL * 64;
  int* s_item = (int*)smem;
  const unsigned x = xcc_id_() & 7u;
  for (int rr = 0; rr < NSL; ++rr) {
    const int s = (int)((x + (unsigned)(rr >> 1)) & 7u) + 8 * (rr & 1);
    for (;;) {
      __syncthreads();
      if (threadIdx.x == 0) *s_item = (int)atomicAdd(&ctr[s * 64], 1u);
      __syncthreads();
      const int item = *s_item;
      if (item >= T / 64) break;
      if (WHICH == 0) peer_u_item(p, s, item); else peer_v_item(p, s, item);
    }
  }
}

DI void phase_peer_w(const Params& p, int bid, int nblk, char* smem) {
  char* ws = p.ws;
  const float* PART = (const float*)(ws + OFF_PART);
  const float* GATE = (const float*)(ws + OFF_GATE);
  const float* rstd2 = (const float*)(ws + OFF_RSTD2);
  float* WGT = (float*)(ws + OFF_WGT);
  for (size_t i = (size_t)bid * NTHR + threadIdx.x; i < (size_t)T * 128; i += (size_t)nblk * NTHR) {
    float sum = 0.f;
#pragma unroll
    for (int s = 0; s < NSL; ++s) sum += PART[(size_t)s * T * 128 + i];
    const float d = sum * rstd2[i >> 7];
    WGT[i] = GATE[i] * 0.5f * d * (1.f + erff(d * 0.70710678118654752f));
  }
}

#define XB_TMO      128
#define XB_XCNT(j)  (256  + 64 * (j))
#define XB_XSUB(j)  (1280 + 64 * (j))
#define XB_XGEN(j)  (2304 + 64 * (j))
#define XB_TOP      3328
#define XB_TOPGEN   3392
#define XCD_BAR_WORDS 3456
#define XB_SPIN_CAP (1u << 20)
#define LAS __attribute__((address_space(3)))
DI unsigned xb_ld(unsigned* p) { return __hip_atomic_load(p, __ATOMIC_RELAXED, __HIP_MEMORY_SCOPE_AGENT); }
DI unsigned xb_add(unsigned* p, unsigned v) { return __hip_atomic_fetch_add(p, v, __ATOMIC_RELAXED, __HIP_MEMORY_SCOPE_AGENT); }
DI unsigned xb_xcc_id() { return (unsigned)__builtin_amdgcn_s_getreg((3 << 11) | 20) & 0xFu; }
#define XB_SPIN(cond, bar) do { unsigned _sp = 0; while (cond) { __builtin_amdgcn_s_sleep(1); \
    if ((++_sp & 255u) == 0u) { if (xb_ld(&(bar)[XB_TMO])) break; if (_sp > XB_SPIN_CAP) { atomicAdd(&(bar)[XB_TMO], 1u); break; } } } } while (0)
struct XcdBarrier { unsigned* bar; unsigned x; volatile LAS unsigned* st; };
DI XcdBarrier xcd_barrier_post(unsigned* bar, volatile LAS unsigned* st) {
  XcdBarrier b; b.bar = bar; b.x = xb_xcc_id(); b.st = st;
  if (threadIdx.x == 0) (void)xb_add(&bar[XB_XCNT(b.x)], 1u);
  return b;
}
DI void xcd_barrier_complete(unsigned* bar, unsigned x, unsigned& nloc, unsigned& nx) {
  const unsigned G = gridDim.x * gridDim.y * gridDim.z;
  unsigned sum, cnt, mine, sp = 0u;
  for (;;) {
    sum = 0u; cnt = 0u; mine = 0u;
#pragma unroll
    for (unsigned j = 0; j < 16; ++j) { const unsigned c = xb_ld(&bar[XB_XCNT(j)]); sum += c; cnt += (c > 0u) ? 1u : 0u; mine = (j == x) ? c : mine; }
    if (sum == G) break;
    __builtin_amdgcn_s_sleep(1);
    if ((++sp & 255u) == 0u) { if (xb_ld(&bar[XB_TMO])) break; if (sp > XB_SPIN_CAP) { atomicAdd(&bar[XB_TMO], 1u); break; } }
  }
  nloc = mine > 0u ? mine : 1u; nx = cnt > 0u ? cnt : 1u;
}
DI void xcd_barrier(const XcdBarrier& b) {
  asm volatile("s_waitcnt vmcnt(0)" ::: "memory");
  __syncthreads();
  if (threadIdx.x == 0) {
    unsigned* bar = b.bar;
    __builtin_amdgcn_s_waitcnt(0);
    unsigned nloc = b.st[0], nx = b.st[1];
    if (nloc == 0u) { xcd_barrier_complete(bar, b.x, nloc, nx); b.st[0] = nloc; b.st[1] = nx; }
    const unsigned old = xb_add(&bar[XB_XSUB(b.x)], 1u);
    const unsigned gen = old / nloc;
    if (old + 1u == (gen + 1u) * nloc) {
      __builtin_amdgcn_fence(__ATOMIC_RELEASE, "agent");
      asm volatile("s_waitcnt vmcnt(0)" ::: "memory");
      const unsigned og = xb_add(&bar[XB_TOP], 1u);
      const unsigned tg = og / nx;
      if (og + 1u == (tg + 1u) * nx) xb_add(&bar[XB_TOPGEN], 1u);
      else XB_SPIN(xb_ld(&bar[XB_TOPGEN]) == tg, bar);
      __builtin_amdgcn_fence(__ATOMIC_ACQUIRE, "agent");
      xb_add(&bar[XB_XGEN(b.x)], 1u);
      asm volatile("s_waitcnt vmcnt(0)" ::: "memory");
    } else {
      XB_SPIN(xb_ld(&bar[XB_XGEN(b.x)]) == gen, bar);
      __builtin_amdgcn_fence(__ATOMIC_ACQUIRE, "agent");
      asm volatile("s_waitcnt vmcnt(0)" ::: "memory");
    }
  }
  __syncthreads();
}

constexpr int NPHASE = 12;
template <int PH>
DI void run_phase(const Params& p, int bid, int nblk, char* smem) {
  if constexpr (PH == 0) phase_prep(p, bid, nblk, smem);
  else if constexpr (PH == 1) phase_gemm1(p, bid, nblk, smem);
  else if constexpr (PH == 2) phase_2a(p, bid, nblk, smem);
  else if constexpr (PH == 3) phase_2b(p, bid, nblk, smem);
  else if constexpr (PH == 4) phase_2c(p, bid, nblk, smem);
  else if constexpr (PH == 5) phase_attn(p, bid, nblk, smem);
  else if constexpr (PH == 6) phase_scan(p, bid, nblk, smem);
  else if constexpr (PH == 7) phase_3c(p, bid, nblk, smem);
  else if constexpr (PH == 8) phase_wo(p, bid, nblk, smem);
  else if constexpr (PH == 9) phase_5(p, bid, nblk, smem);
  else if constexpr (PH == 10) phase_6(p, bid, nblk, smem);
  else if constexpr (PH == 11) { phase_7(p, bid, nblk, smem); }
  else if constexpr (PH == 12) phase_peer_queue<0>(p, bid, nblk, smem);
  else if constexpr (PH == 13) phase_peer_w(p, bid, nblk, smem);
  else phase_peer_queue<1>(p, bid, nblk, smem);
}

constexpr int SMEM_BYTES = 32768;

#if MEGA
__global__ void __launch_bounds__(NTHR, 2) mega_kernel(Params p) {
  __shared__ __attribute__((aligned(16))) char smem[SMEM_BYTES];
  __shared__ uint4 xb_words;
  cg::grid_group grid = cg::this_grid();
  const int bid = blockIdx.x, nblk = gridDim.x;
  if (threadIdx.x == 0) xb_words = make_uint4(0u, 0u, 0u, 0u);
  __syncthreads();
  XcdBarrier xb = xcd_barrier_post((unsigned*)(p.ws + OFF_BAR), (volatile LAS unsigned*)&xb_words);
  run_phase<0>(p, bid, nblk, smem); grid.sync();
  run_phase<1>(p, bid, nblk, smem); xcd_barrier(xb);
  run_phase<2>(p, bid, nblk, smem); xcd_barrier(xb);
  run_phase<3>(p, bid, nblk, smem); xcd_barrier(xb);
  run_phase<4>(p, bid, nblk, smem); xcd_barrier(xb);
  run_phase<5>(p, bid, nblk, smem); xcd_barrier(xb);
  run_phase<6>(p, bid, nblk, smem); xcd_barrier(xb);
  run_phase<7>(p, bid, nblk, smem); xcd_barrier(xb);
  run_phase<8>(p, bid, nblk, smem); xcd_barrier(xb);
  run_phase<9>(p, bid, nblk, smem); xcd_barrier(xb);
  run_phase<10>(p, bid, nblk, smem); xcd_barrier(xb);
  run_phase<11>(p, bid, nblk, smem); xcd_barrier(xb);
  run_phase<12>(p, bid, nblk, smem); xcd_barrier(xb);
  run_phase<13>(p, bid, nblk, smem); xcd_barrier(xb);
  run_phase<14>(p, bid, nblk, smem);
}
#else
template <int PH>
__global__ void __launch_bounds__(NTHR, 2) phase_kernel(Params p) {
  __shared__ __attribute__((aligned(16))) char smem[SMEM_BYTES];
  run_phase<PH>(p, blockIdx.x, gridDim.x, smem);
}
#endif

extern "C" void kernel_launch(void* const* d_in, const int* in_sizes, int n_in, void* d_out, int out_size, void* d_ws,
                              size_t ws_size, hipStream_t stream) {
  Params p{};
  p.x = (const float*)d_in[0]; p.pos = (const int*)d_in[1];
  p.g_mix = (const float*)d_in[2]; p.w_in = (const float*)d_in[3]; p.rwkv_mu = (const float*)d_in[4];
  p.g_cq = (const float*)d_in[5]; p.g_ckv = (const float*)d_in[6]; p.w_uq = (const float*)d_in[7];
  p.w_uk = (const float*)d_in[8]; p.w_uv = (const float*)d_in[9]; p.g_qnorm = (const float*)d_in[10];
  p.g_knorm = (const float*)d_in[11]; p.g_attn_out = (const float*)d_in[12]; p.w0 = (const float*)d_in[13];
  p.w2 = (const float*)d_in[14]; p.a0 = (const float*)d_in[15]; p.a2 = (const float*)d_in[16];
  p.g2 = (const float*)d_in[17]; p.k_k = (const float*)d_in[18]; p.k_a = (const float*)d_in[19];
  p.r_k = (const float*)d_in[20]; p.ln_x_w = (const float*)d_in[21]; p.ln_x_b = (const float*)d_in[22];
  p.w_o = (const float*)d_in[23]; p.g_ffn = (const float*)d_in[24]; p.w_pq = (const float*)d_in[25];
  p.sub_keys = (const float*)d_in[26]; p.expert_u = (const float*)d_in[27]; p.expert_v = (const float*)d_in[28];
  p.out = (float*)d_out; p.ws = (char*)d_ws;
#if MEGA
  static int grid_blocks = 0;
  if (!grid_blocks) {
    int dev = 0, cus = 0, per_cu = 0;
    hipGetDevice(&dev);
    hipDeviceGetAttribute(&cus, hipDeviceAttributeMultiprocessorCount, dev);
    (void)hipOccupancyMaxActiveBlocksPerMultiprocessor(&per_cu, mega_kernel, NTHR, 0);
    if (per_cu > 2) per_cu = 2;
    grid_blocks = cus * per_cu;
  }
  (void)hipMemsetAsync((char*)d_ws + OFF_BAR, 0, 32768, stream);
  void* args[] = {&p};
  hipError_t e = hipLaunchCooperativeKernel((void*)mega_kernel, dim3(grid_blocks), dim3(NTHR), args, 0, stream);
  if (e != hipSuccess) fprintf(stderr, "cooperative launch failed: %s (grid %d)\n", hipGetErrorString(e), grid_blocks);
#else
  const int NB = 512;
  phase_kernel<0><<<NB, NTHR, 0, stream>>>(p);
  phase_kernel<1><<<NB, NTHR, 0, stream>>>(p);
  phase_kernel<2><<<NB, NTHR, 0, stream>>>(p);
  phase_kernel<3><<<NB, NTHR, 0, stream>>>(p);
  phase_kernel<4><<<NB, NTHR, 0, stream>>>(p);
  phase_kernel<5><<<NB, NTHR, 0, stream>>>(p);
  phase_kernel<6><<<NB, NTHR, 0, stream>>>(p);
  phase_kernel<7><<<NB, NTHR, 0, stream>>>(p);
  phase_kernel<8><<<NB, NTHR, 0, stream>>>(p);
  phase_kernel<9><<<NB, NTHR, 0, stream>>>(p);
  phase_kernel<10><<<NB, NTHR, 0, stream>>>(p);
  phase_kernel<11><<<NB, NTHR, 0, stream>>>(p);
  phase_kernel<12><<<NB, NTHR, 0, stream>>>(p);
  phase_kernel<13><<<NB, NTHR, 0, stream>>>(p);
  phase_kernel<14><<<NB, NTHR, 0, stream>>>(p);
#endif
}
```

```cpp
#include <hip/hip_runtime.h>
#include <hip/hip_cooperative_groups.h>
#include <cstdio>
#include <cstdint>
namespace cg = cooperative_groups;

#ifndef MEGA
#define MEGA 1
#endif

typedef unsigned short u16;
using bf16x8 = __attribute__((ext_vector_type(8))) short;
using s16x4  = __attribute__((ext_vector_type(4))) short;
using f32x4  = __attribute__((ext_vector_type(4))) float;
using f32x16 = __attribute__((ext_vector_type(16))) float;
#define DI __device__ __forceinline__

constexpr int T = 32768, SEQ = 2048, DM = 1024;
constexpr int INC = 2464, MLAC = 672, RWC = 1792;
constexpr int NTHR = 256;
constexpr float EPS = 1e-6f;

constexpr size_t MiB = 1048576;
constexpr size_t OFF_WINT  = 0;
constexpr size_t OFF_WUQT  = OFF_WINT  + 2560 * 1024 * 2;
constexpr size_t OFF_WUKVT = OFF_WUQT  + 768 * 384 * 2;
constexpr size_t OFF_W2T   = OFF_WUKVT + 1024 * 256 * 2;
constexpr size_t OFF_A2T   = OFF_W2T   + 512 * 64 * 2;
constexpr size_t OFF_G2T   = OFF_A2T   + 512 * 64 * 2;
constexpr size_t OFF_WOT   = OFF_G2T   + 512 * 128 * 2;
constexpr size_t OFF_WPQT  = OFF_WOT   + 1024 * 1024 * 2;
constexpr size_t OFF_SUBK  = OFF_WPQT  + 2048 * 1024 * 2;
constexpr size_t OFF_ROPE  = OFF_SUBK  + 16 * 128 * 128 * 2;
constexpr size_t OFF_RSTD1 = OFF_ROPE  + (size_t)T * 32 * 4;
constexpr size_t OFF_RSTDQ = OFF_RSTD1 + (size_t)T * 4;
constexpr size_t OFF_RSTDKV= OFF_RSTDQ + (size_t)T * 4;
constexpr size_t OFF_RSTD2 = OFF_RSTDKV+ (size_t)T * 4;
constexpr size_t OFF_A_END = OFF_RSTD2 + (size_t)T * 4;
static_assert(OFF_A_END <= 19 * MiB, "region A");
constexpr size_t OFF_BAR   = 19 * MiB;
constexpr size_t OFF_QCTR  = OFF_BAR + 16384;
constexpr size_t OFF_XB    = 20 * MiB;
constexpr size_t OFF_Y     = OFF_XB;
constexpr size_t OFF_PM    = 84 * MiB;
constexpr size_t OFF_PR    = 126 * MiB;
constexpr size_t OFF_U     = OFF_PR;
constexpr size_t OFF_G     = OFF_PR + 32 * MiB;
constexpr size_t OFF_KK    = OFF_PR + 64 * MiB;
constexpr size_t OFF_KVRAW = 238 * MiB;
constexpr size_t OFF_QRAW  = 302 * MiB;
constexpr size_t OFF_LORAIN= 350 * MiB;
constexpr size_t OFF_YRAW  = 302 * MiB;
constexpr size_t OFF_RS    = 366 * MiB;
constexpr size_t OFF_KS    = 398 * MiB;
constexpr size_t OFF_VS    = 430 * MiB;
constexpr size_t OFF_BB    = 462 * MiB;
constexpr size_t OFF_EU    = 84 * MiB;
constexpr size_t OFF_EV    = 116 * MiB;
constexpr size_t OFF_X2B   = 148 * MiB;
constexpr size_t OFF_QP    = 238 * MiB;
constexpr size_t OFF_IDX   = 20 * MiB;
constexpr size_t OFF_GATE  = 28 * MiB;
constexpr size_t OFF_WGT   = 44 * MiB;
constexpr size_t OFF_PART  = 238 * MiB;
constexpr int NSL = 16;
constexpr size_t DO_Q = 0, DO_K = (size_t)T * 768 * 2, DO_AA = (size_t)T * 768 * 4;

struct Params {
  const float* x; const int* pos;
  const float *g_mix, *w_in, *rwkv_mu, *g_cq, *g_ckv, *w_uq, *w_uk, *w_uv, *g_qnorm, *g_knorm, *g_attn_out;
  const float *w0, *w2, *a0, *a2, *g2, *k_k, *k_a, *r_k, *ln_x_w, *ln_x_b, *w_o, *g_ffn, *w_pq, *sub_keys, *expert_u, *expert_v;
  float* out; char* ws;
};

DI u16 f2bf(float x) { unsigned u = __float_as_uint(x); u += 0x7fffu + ((u >> 16) & 1u); return (u16)(u >> 16); }
DI float bf2f(u16 h) { return __uint_as_float(((unsigned)h) << 16); }
DI unsigned pack2(float a, float b) { return (unsigned)f2bf(a) | ((unsigned)f2bf(b) << 16); }
DI float bflo(unsigned u) { return __uint_as_float(u << 16); }
DI float bfhi(unsigned u) { return __uint_as_float(u & 0xffff0000u); }
DI float wave_allsum(float v) {
#pragma unroll
  for (int o = 32; o > 0; o >>= 1) v += __shfl_xor(v, o);
  return v;
}
DI float sigmoidf_(float x) { return 1.f / (1.f + __expf(-x)); }

DI void tconv(const float* __restrict__ src, int K, int N, const float* __restrict__ scale, u16* __restrict__ dst,
              int ldd, int noff, int bid, int nblk, float* tile) {
  const int tid = threadIdx.x, tx = tid & 31, ty = tid >> 5;
  const int nbn = N / 32, ntl = (K / 32) * nbn;
  for (int tl = bid; tl < ntl; tl += nblk) {
    const int kb = tl / nbn, nb = tl % nbn;
#pragma unroll
    for (int i = 0; i < 4; ++i) {
      const int k = kb * 32 + ty + 8 * i;
      float v = src[(size_t)k * N + nb * 32 + tx];
      if (scale) v *= scale[k];
      tile[(ty + 8 * i) * 33 + tx] = v;
    }
    __syncthreads();
#pragma unroll
    for (int i = 0; i < 4; ++i) {
      const int n = nb * 32 + ty + 8 * i;
      dst[(size_t)(noff + n) * ldd + kb * 32 + tx] = f2bf(tile[tx * 33 + ty + 8 * i]);
    }
    __syncthreads();
  }
}

DI void phase_prep(const Params& p, int bid, int nblk, char* smem) {
  float* tile = (float*)smem;
  char* ws = p.ws;
  const int tid = threadIdx.x;
  tconv(p.w_in, 1024, INC, p.g_mix, (u16*)(ws + OFF_WINT), 1024, 0, bid, nblk, tile);
  for (int i = bid * NTHR + tid; i < 96 * 1024; i += nblk * NTHR) ((u16*)(ws + OFF_WINT))[2464 * 1024 + i] = 0;
  tconv(p.w_uq, 384, 768, p.g_cq, (u16*)(ws + OFF_WUQT), 384, 0, bid, nblk, tile);
  tconv(p.w_uk, 256, 512, p.g_ckv, (u16*)(ws + OFF_WUKVT), 256, 0, bid, nblk, tile);
  tconv(p.w_uv, 256, 512, p.g_ckv, (u16*)(ws + OFF_WUKVT), 256, 512, bid, nblk, tile);
  tconv(p.w2, 64, 512, nullptr, (u16*)(ws + OFF_W2T), 64, 0, bid, nblk, tile);
  tconv(p.a2, 64, 512, nullptr, (u16*)(ws + OFF_A2T), 64, 0, bid, nblk, tile);
  tconv(p.g2, 128, 512, nullptr, (u16*)(ws + OFF_G2T), 128, 0, bid, nblk, tile);
  tconv(p.w_o, 1024, 1024, nullptr, (u16*)(ws + OFF_WOT), 1024, 0, bid, nblk, tile);
  tconv(p.w_pq, 1024, 2048, p.g_ffn, (u16*)(ws + OFF_WPQT), 1024, 0, bid, nblk, tile);
  for (int i = bid * NTHR + tid; i < 16 * 128 * 128; i += nblk * NTHR) ((u16*)(ws + OFF_SUBK))[i] = f2bf(p.sub_keys[i]);
  for (int i = bid * NTHR + tid; i < T * 16; i += nblk * NTHR) {
    const int t = i >> 4, j = i & 15;
    const float inv = powf(10000.0f, -(float)j / 16.0f);
    const float ang = (float)p.pos[t] * inv;
    float s, c; sincosf(ang, &s, &c);
    float* rp = (float*)(ws + OFF_ROPE) + (size_t)t * 32;
    rp[j] = c; rp[16 + j] = s;
  }
  const int wid = tid >> 6, lane = tid & 63;
  for (int row = bid * 4 + wid; row < T; row += nblk * 4) {
    const float4* xr = (const float4*)(p.x + (size_t)row * DM);
    uint2* xb = (uint2*)(ws + OFF_XB + (size_t)row * DM * 2);
    float ss = 0.f;
#pragma unroll
    for (int i = 0; i < 4; ++i) {
      const float4 v = xr[lane + 64 * i];
      ss += v.x * v.x + v.y * v.y + v.z * v.z + v.w * v.w;
      xb[lane + 64 * i] = make_uint2(pack2(v.x, v.y), pack2(v.z, v.w));
    }
    ss = wave_allsum(ss);
    if (lane == 0) ((float*)(ws + OFF_RSTD1))[row] = rsqrtf(ss * (1.f / DM) + EPS);
  }
}

template <class Epi>
DI void gemm_tile(const u16* __restrict__ A, int lda, const u16* __restrict__ Bt, int ldb, int K, int m0, int n0,
                  Epi epi, char* smem) {
  u16* SA = (u16*)smem;
  u16* SB = SA + 128 * 32;
  const int tid = threadIdx.x, wid = tid >> 6, lane = tid & 63, wr = wid >> 1, wc = wid & 1, fr = lane & 15, fq = lane >> 4;
  f32x4 acc[4][4];
#pragma unroll
  for (int m = 0; m < 4; ++m)
#pragma unroll
    for (int n = 0; n < 4; ++n) acc[m][n] = f32x4{0.f, 0.f, 0.f, 0.f};
  const int nk = K / 32;
  for (int kt = 0; kt < nk; ++kt) {
#pragma unroll
    for (int i = 0; i < 2; ++i) {
      const int b = tid * 16 + i * 4096, r = b / 64, c = (b % 64) / 2;
      __builtin_amdgcn_global_load_lds((const unsigned*)(A + (size_t)(m0 + r) * lda + kt * 32 + c),
                                       (__attribute__((address_space(3))) unsigned*)((char*)SA + b), 16, 0, 0);
      __builtin_amdgcn_global_load_lds((const unsigned*)(Bt + (size_t)(n0 + r) * ldb + kt * 32 + c),
                                       (__attribute__((address_space(3))) unsigned*)((char*)SB + b), 16, 0, 0);
    }
    asm volatile("s_waitcnt vmcnt(0)" ::: "memory");
    __syncthreads();
    bf16x8 af[4], bfr[4];
#pragma unroll
    for (int m = 0; m < 4; ++m) af[m] = *reinterpret_cast<const bf16x8*>((char*)SA + (wr * 64 + m * 16 + fr) * 64 + fq * 16);
#pragma unroll
    for (int n = 0; n < 4; ++n) bfr[n] = *reinterpret_cast<const bf16x8*>((char*)SB + (wc * 64 + n * 16 + fr) * 64 + fq * 16);
#pragma unroll
    for (int m = 0; m < 4; ++m)
#pragma unroll
      for (int n = 0; n < 4; ++n) acc[m][n] = __builtin_amdgcn_mfma_f32_16x16x32_bf16(af[m], bfr[n], acc[m][n], 0, 0, 0);
    __syncthreads();
  }
#pragma unroll
  for (int m = 0; m < 4; ++m)
#pragma unroll
    for (int n = 0; n < 4; ++n)
#pragma unroll
      for (int j = 0; j < 4; ++j) epi(m0 + wr * 64 + m * 16 + fq * 4 + j, n0 + wc * 64 + n * 16 + fr, acc[m][n][j]);
}

DI void phase_gemm1(const Params& p, int bid, int nblk, char* smem) {
  char* ws = p.ws;
  const u16* A = (const u16*)(ws + OFF_XB);
  const u16* Bt = (const u16*)(ws + OFF_WINT);
  const float* rstd = (const float*)(ws + OFF_RSTD1);
  u16* PM = (u16*)(ws + OFF_PM);
  u16* PR = (u16*)(ws + OFF_PR);
  const int NT = 20;
  for (int tl = bid; tl < 256 * NT; tl += nblk) {
    const int mt = tl / NT, nt = tl % NT;
    gemm_tile(A, 1024, Bt, 1024, 1024, mt * 128, nt * 128,
              [&](int r, int c, float v) {
                if (c < INC) {
                  const u16 o = f2bf(v * rstd[r]);
                  if (c < MLAC) PM[(size_t)r * MLAC + c] = o; else PR[(size_t)r * RWC + (c - MLAC)] = o;
                }
              }, smem);
  }
}

DI void phase_2a(const Params& p, int bid, int nblk, char* smem) {
  char* ws = p.ws;
  const u16* PM = (const u16*)(ws + OFF_PM);
  const u16* PR = (const u16*)(ws + OFF_PR);
  u16* RS = (u16*)(ws + OFF_RS); u16* KS = (u16*)(ws + OFF_KS); u16* VS = (u16*)(ws + OFF_VS);
  u16* LI = (u16*)(ws + OFF_LORAIN);
  float* red = (float*)smem;
  const int tid = threadIdx.x, wid = tid >> 6, lane = tid & 63;
  for (int t = bid; t < T; t += nblk) {
    const u16* pm = PM + (size_t)t * MLAC;
    float q0 = bf2f(pm[tid]); float sq = q0 * q0;
    if (tid < 128) { const float q1 = bf2f(pm[256 + tid]); sq += q1 * q1; }
    const float kv = bf2f(pm[384 + tid]); float skv = kv * kv;
    sq = wave_allsum(sq); skv = wave_allsum(skv);
    if (lane == 0) { red[wid] = sq; red[4 + wid] = skv; }
    __syncthreads();
    if (tid == 0) {
      ((float*)(ws + OFF_RSTDQ))[t] = rsqrtf((red[0] + red[1] + red[2] + red[3]) * (1.f / 384.f) + EPS);
      ((float*)(ws + OFF_RSTDKV))[t] = rsqrtf((red[4] + red[5] + red[6] + red[7]) * (1.f / 256.f) + EPS);
    }
    __syncthreads();
    const bool first = (t % SEQ) == 0;
    const u16* cur = PR + (size_t)t * RWC;
    const u16* prv = cur - RWC;
#pragma unroll
    for (int i = 0; i < 7; ++i) {
      const int c = tid + 256 * i;
      const float cv = bf2f(cur[c]);
      const float pv = first ? 0.f : bf2f(prv[c]);
      const float v = cv + (pv - cv) * p.rwkv_mu[c];
      if (c < 512) RS[(size_t)t * 512 + c] = f2bf(v);
      else if (c < 1024) KS[(size_t)t * 512 + c - 512] = f2bf(v);
      else if (c < 1536) VS[(size_t)t * 512 + c - 1024] = f2bf(v);
      else if (c < 1600) LI[(size_t)t * 256 + c - 1536] = f2bf(tanhf(v));
      else if (c < 1664) LI[(size_t)t * 256 + c - 1536] = f2bf(v);
      else LI[(size_t)t * 256 + c - 1536] = f2bf(sigmoidf_(v));
    }
  }
}

DI void phase_2b(const Params& p, int bid, int nblk, char* smem) {
  char* ws = p.ws;
  const u16* PM = (const u16*)(ws + OFF_PM);
  const u16* LI = (const u16*)(ws + OFF_LORAIN);
  const float* rq = (const float*)(ws + OFF_RSTDQ);
  const float* rkv = (const float*)(ws + OFF_RSTDKV);
  u16* QRAW = (u16*)(ws + OFF_QRAW); u16* KVRAW = (u16*)(ws + OFF_KVRAW);
  u16* U = (u16*)(ws + OFF_U); u16* G = (u16*)(ws + OFF_G);
  u16* AA = (u16*)((char*)p.out + DO_AA);
  const int NT = 26;
  for (int tl = bid; tl < 256 * NT; tl += nblk) {
    const int mt = tl / NT, j = tl % NT, m0 = mt * 128;
    if (j < 6) {
      gemm_tile(PM, MLAC, (const u16*)(ws + OFF_WUQT), 384, 384, m0, j * 128,
                [&](int r, int c, float v) { QRAW[(size_t)r * 768 + c] = f2bf(v * rq[r]); }, smem);
    } else if (j < 14) {
      gemm_tile(PM + 384, MLAC, (const u16*)(ws + OFF_WUKVT), 256, 256, m0, (j - 6) * 128,
                [&](int r, int c, float v) { KVRAW[(size_t)r * 1024 + c] = f2bf(v * rkv[r]); }, smem);
    } else if (j < 18) {
      gemm_tile(LI, 256, (const u16*)(ws + OFF_W2T), 64, 64, m0, (j - 14) * 128,
                [&](int r, int c, float v) {
                  const float sg = sigmoidf_(p.w0[c] + v);
                  U[(size_t)r * 512 + c] = f2bf(-expm1f(-0.6065306597126334f * sg));
                }, smem);
    } else if (j < 22) {
      gemm_tile(LI + 64, 256, (const u16*)(ws + OFF_A2T), 64, 64, m0, (j - 18) * 128,
                [&](int r, int c, float v) { AA[(size_t)r * 512 + c] = f2bf(sigmoidf_(p.a0[c] + v)); }, smem);
    } else {
      gemm_tile(LI + 128, 256, (const u16*)(ws + OFF_G2T), 128, 128, m0, (j - 22) * 128,
                [&](int r, int c, float v) { G[(size_t)r * 512 + c] = f2bf(v); }, smem);
    }
  }
}

DI void phase_2c(const Params& p, int bid, int nblk, char* smem) {
  char* ws = p.ws;
  const u16* PM = (const u16*)(ws + OFF_PM);
  const u16* QRAW = (const u16*)(ws + OFF_QRAW);
  const u16* KVRAW = (const u16*)(ws + OFF_KVRAW);
  u16* Q = (u16*)((char*)p.out + DO_Q); u16* Kd = (u16*)((char*)p.out + DO_K);
  const u16* AA = (const u16*)((char*)p.out + DO_AA);
  u16* KS = (u16*)(ws + OFF_KS); u16* KK = (u16*)(ws + OFF_KK); u16* BB = (u16*)(ws + OFF_BB);
  const float* rope = (const float*)(ws + OFF_ROPE);
  const int tid = threadIdx.x, wid = tid >> 6, lane = tid & 63;
  const float QSCALE = 0.10206207261596575f * 1.4426950408889634f;
  for (int t = bid * 4 + wid; t < T; t += nblk * 4) {
    const int e0 = 2 * lane;
    const bool act = lane < 48;
    const bool isrope = lane >= 32 && lane < 48;
    const bool second = lane >= 40;
    float cs0 = 0.f, cs1 = 0.f, sn0 = 0.f, sn1 = 0.f;
    if (isrope) {
      const int i0 = e0 - (second ? 80 : 64);
      cs0 = rope[(size_t)t * 32 + i0]; cs1 = rope[(size_t)t * 32 + i0 + 1];
      sn0 = rope[(size_t)t * 32 + 16 + i0]; sn1 = rope[(size_t)t * 32 + 16 + i0 + 1];
    }
    float gq0 = 0.f, gq1 = 0.f, gk0 = 0.f, gk1 = 0.f;
    if (act) { gq0 = p.g_qnorm[e0]; gq1 = p.g_qnorm[e0 + 1]; gk0 = p.g_knorm[e0]; gk1 = p.g_knorm[e0 + 1]; }
    for (int h = 0; h < 8; ++h) {
#pragma unroll
      for (int which = 0; which < 2; ++which) {
        float v0 = 0.f, v1 = 0.f;
        if (act) {
          unsigned raw;
          if (which == 0) raw = *(const unsigned*)(QRAW + (size_t)t * 768 + h * 96 + e0);
          else if (e0 < 64) raw = *(const unsigned*)(KVRAW + (size_t)t * 1024 + h * 64 + e0);
          else raw = *(const unsigned*)(PM + (size_t)t * MLAC + 640 + (e0 - 64));
          v0 = bflo(raw); v1 = bfhi(raw);
        }
        const float ss = wave_allsum(v0 * v0 + v1 * v1);
        const float rs = rsqrtf(ss * (1.f / 96.f) + EPS);
        v0 *= rs * (which == 0 ? gq0 : gk0);
        v1 *= rs * (which == 0 ? gq1 : gk1);
        const float o0 = __shfl_xor(v0, 8), o1 = __shfl_xor(v1, 8);
        if (isrope) {
          if (!second) { v0 = v0 * cs0 - o0 * sn0; v1 = v1 * cs1 - o1 * sn1; }
          else { v0 = o0 * sn0 + v0 * cs0; v1 = o1 * sn1 + v1 * cs1; }
        }
        if (act) {
          if (which == 0) *(unsigned*)(Q + (size_t)t * 768 + h * 96 + e0) = pack2(v0 * QSCALE, v1 * QSCALE);
          else *(unsigned*)(Kd + (size_t)t * 768 + h * 96 + e0) = pack2(v0, v1);
        }
      }
    }
    {
      const int c0 = 8 * lane;
      const uint4 kraw = *(const uint4*)(KS + (size_t)t * 512 + c0);
      const uint4 araw = *(const uint4*)(AA + (size_t)t * 512 + c0);
      float kv[8], av[8], kkv[8];
      kv[0] = bflo(kraw.x); kv[1] = bfhi(kraw.x); kv[2] = bflo(kraw.y); kv[3] = bfhi(kraw.y);
      kv[4] = bflo(kraw.z); kv[5] = bfhi(kraw.z); kv[6] = bflo(kraw.w); kv[7] = bfhi(kraw.w);
      av[0] = bflo(araw.x); av[1] = bfhi(araw.x); av[2] = bflo(araw.y); av[3] = bfhi(araw.y);
      av[4] = bflo(araw.z); av[5] = bfhi(araw.z); av[6] = bflo(araw.w); av[7] = bfhi(araw.w);
      float ss = 0.f;
#pragma unroll
      for (int i = 0; i < 8; ++i) { kkv[i] = kv[i] * p.k_k[c0 + i]; ss += kkv[i] * kkv[i]; }
      ss += __shfl_xor(ss, 1); ss += __shfl_xor(ss, 2); ss += __shfl_xor(ss, 4);
      const float inv = 1.f / fmaxf(sqrtf(ss), 1e-12f);
      float kn[8], bb[8], k2[8];
#pragma unroll
      for (int i = 0; i < 8; ++i) {
        kn[i] = kkv[i] * inv;
        bb[i] = kn[i] * av[i];
        k2[i] = kv[i] * (1.f + (av[i] - 1.f) * p.k_a[c0 + i]);
      }
      *(uint4*)(KK + (size_t)t * 512 + c0) = make_uint4(pack2(kn[0], kn[1]), pack2(kn[2], kn[3]), pack2(kn[4], kn[5]), pack2(kn[6], kn[7]));
      *(uint4*)(BB + (size_t)t * 512 + c0) = make_uint4(pack2(bb[0], bb[1]), pack2(bb[2], bb[3]), pack2(bb[4], bb[5]), pack2(bb[6], bb[7]));
      *(uint4*)(KS + (size_t)t * 512 + c0) = make_uint4(pack2(k2[0], k2[1]), pack2(k2[2], k2[3]), pack2(k2[4], k2[5]), pack2(k2[6], k2[7]));
    }
  }
}

DI s16x4 tr_read(unsigned lds_addr) {
  s16x4 r;
  asm volatile("ds_read_b64_tr_b16 %0, %1\n\ts_waitcnt lgkmcnt(0)" : "=&v"(r) : "v"(lds_addr) : "memory");
  return r;
}
#define MFMA32(a, b, c) __builtin_amdgcn_mfma_f32_32x32x16_bf16((a), (b), (c), 0, 0, 0)

constexpr int KLD = 208, VLD = 192;
constexpr int ATT_KOFF = 0, ATT_VOFF = 64 * KLD;
DI void phase_attn(const Params& p, int bid, int nblk, char* smem) {
  char* ws = p.ws;
  const u16* Q = (const u16*)((char*)p.out + DO_Q);
  const u16* Kd = (const u16*)((char*)p.out + DO_K);
  const u16* KVRAW = (const u16*)(ws + OFF_KVRAW);
  u16* Y = (u16*)(ws + OFF_Y);
  const int tid = threadIdx.x, w = tid >> 6, lane = tid & 63, r = lane & 31, hh = lane >> 5;
  const unsigned lds_base = (unsigned)(size_t)smem;
  for (int it = bid; it < 2048; it += nblk) {
    const int rd = it >> 9, pos = it & 511, g = pos >> 7, bh = pos & 127;
    const int m = rd == 0 ? 15 - g : rd == 1 ? 8 + g : rd == 2 ? 7 - g : g;
    const int b = bh >> 3, h = bh & 7;
    const int t0 = b * SEQ + 128 * m;
    const int cw = 2 * m + (w >> 1);
    const int tq = t0 + 32 * w + r;
    bf16x8 qf[6];
#pragma unroll
    for (int ks = 0; ks < 6; ++ks) qf[ks] = *reinterpret_cast<const bf16x8*>(Q + (size_t)tq * 768 + h * 96 + 16 * ks + 8 * hh);
    f32x16 O0, O1;
#pragma unroll
    for (int i = 0; i < 16; ++i) { O0[i] = 0.f; O1[i] = 0.f; }
    float mrun = -1e30f, lrun = 0.f;
    const int nkt = 2 * m + 2;
    for (int kt = 0; kt < nkt; ++kt) {
      __syncthreads();
      const int tk0 = b * SEQ + 64 * kt;
#pragma unroll
      for (int i = 0; i < 3; ++i) {
        const int c = tid + 256 * i, row = c / 12, cc = c % 12;
        const uint4 v = *(const uint4*)(Kd + (size_t)(tk0 + row) * 768 + h * 96 + cc * 8);
        *(uint4*)(smem + ATT_KOFF + row * KLD + cc * 16) = v;
      }
#pragma unroll
      for (int i = 0; i < 2; ++i) {
        const int c = tid + 256 * i, row = c >> 3, cc = c & 7;
        const uint4 v = *(const uint4*)(KVRAW + (size_t)(tk0 + row) * 1024 + 512 + h * 64 + cc * 8);
        *(uint4*)(smem + ATT_VOFF + row * VLD + cc * 16) = v;
      }
      __syncthreads();
      if (kt <= cw) {
        f32x16 X[2];
#pragma unroll
        for (int sub = 0; sub < 2; ++sub) {
#pragma unroll
          for (int i = 0; i < 16; ++i) X[sub][i] = 0.f;
#pragma unroll
          for (int ks = 0; ks < 6; ++ks) {
            const bf16x8 a = *reinterpret_cast<const bf16x8*>(smem + ATT_KOFF + (32 * sub + r) * KLD + (16 * ks + 8 * hh) * 2);
            X[sub] = MFMA32(a, qf[ks], X[sub]);
          }
        }
        float mx = X[0][0];
#pragma unroll
        for (int i = 0; i < 16; ++i) { mx = fmaxf(mx, X[0][i]); mx = fmaxf(mx, X[1][i]); }
        mx = fmaxf(mx, __shfl_xor(mx, 32));
        const float mnew = fmaxf(mrun, mx);
        const float alpha = exp2f(mrun - mnew);
        mrun = mnew;
        float rsum = 0.f;
#pragma unroll
        for (int sub = 0; sub < 2; ++sub)
#pragma unroll
          for (int i = 0; i < 16; ++i) { const float e = exp2f(X[sub][i] - mnew); X[sub][i] = e; rsum += e; }
        lrun = lrun * alpha + rsum;
#pragma unroll
        for (int i = 0; i < 16; ++i) { O0[i] *= alpha; O1[i] *= alpha; }
        const int i16 = lane & 15, q4 = i16 >> 2, p4 = i16 & 3, blk = (lane >> 4) & 1;
#pragma unroll
        for (int sub = 0; sub < 2; ++sub) {
#pragma unroll
          for (int s = 0; s < 2; ++s) {
            bf16x8 pb;
#pragma unroll
            for (int j = 0; j < 8; ++j) pb[j] = (short)f2bf(X[sub][8 * s + j]);
            const unsigned rowlo = 32 * sub + 16 * s + 4 * hh + q4;
#pragma unroll
            for (int dt = 0; dt < 2; ++dt) {
              const unsigned colb = (32 * dt + 16 * blk) * 2 + 8 * p4;
              const s16x4 lo = tr_read(lds_base + ATT_VOFF + rowlo * VLD + colb);
              const s16x4 hi = tr_read(lds_base + ATT_VOFF + (rowlo + 8) * VLD + colb);
              const bf16x8 a = __builtin_shufflevector(lo, hi, 0, 1, 2, 3, 4, 5, 6, 7);
              if (dt == 0) O0 = MFMA32(a, pb, O0); else O1 = MFMA32(a, pb, O1);
            }
          }
        }
      }
    }
    const float ltot = lrun + __shfl_xor(lrun, 32);
    const float inv = 1.f / ltot;
    float ss = 0.f;
#pragma unroll
    for (int i = 0; i < 16; ++i) { O0[i] *= inv; O1[i] *= inv; ss += O0[i] * O0[i] + O1[i] * O1[i]; }
    ss += __shfl_xor(ss, 32);
    const float rs = rsqrtf(ss * (1.f / 64.f) + EPS);
#pragma unroll
    for (int dt = 0; dt < 2; ++dt)
#pragma unroll
      for (int gq = 0; gq < 4; ++gq) {
        const int d = 32 * dt + 8 * gq + 4 * hh;
        const float* gp = p.g_attn_out + h * 64 + d;
        float o[4];
#pragma unroll
        for (int j = 0; j < 4; ++j) o[j] = (dt == 0 ? O0[4 * gq + j] : O1[4 * gq + j]) * rs * gp[j];
        *(uint2*)(Y + (size_t)tq * 1024 + h * 64 + d) = make_uint2(pack2(o[0], o[1]), pack2(o[2], o[3]));
      }
  }
}

template <int N> DI float dpp_ror(float v) {
  return __builtin_bit_cast(float, __builtin_amdgcn_update_dpp(0, __builtin_bit_cast(int, v), 0x120 + N, 0xF, 0xF, false));
}
DI float row16_allsum(float v) {
  v += dpp_ror<8>(v); v += dpp_ror<4>(v); v += dpp_ror<2>(v); v += dpp_ror<1>(v);
  return v;
}
constexpr int SC_CH = 16, SC_BUFB = 21504;
DI void phase_scan(const Params& p, int bid, int nblk, char* smem) {
  char* ws = p.ws;
  const u16* KK = (const u16*)(ws + OFF_KK); const u16* U = (const u16*)(ws + OFF_U); const u16* BB = (const u16*)(ws + OFF_BB);
  const u16* KS = (const u16*)(ws + OFF_KS); const u16* RS = (const u16*)(ws + OFF_RS); const u16* VS = (const u16*)(ws + OFF_VS);
  float* YRAW = (float*)(ws + OFF_YRAW);
  const int tid = threadIdx.x, w = tid >> 6, lane = tid & 63, jq = lane & 15, r4 = lane >> 4;
  const int st = tid >> 4, q16 = tid & 15;
  float* Yl = (float*)(smem + 2 * SC_BUFB);
  for (int unit = bid; unit < 512; unit += nblk) {
    const int bh = unit >> 2, rg = unit & 3, b = bh >> 3, h = bh & 7;
    const size_t tb = (size_t)b * SEQ;
    const int cj = h * 64 + 4 * q16, ci = h * 64 + 16 * rg + q16;
    uint2 lkk, lu, lb, lk, lr; u16 lv;
    auto gload = [&](int s0) {
      const size_t o = (tb + s0 + st) * 512;
      lkk = *(const uint2*)(KK + o + cj); lu = *(const uint2*)(U + o + cj); lb = *(const uint2*)(BB + o + cj);
      lk = *(const uint2*)(KS + o + cj); lr = *(const uint2*)(RS + o + cj); lv = VS[o + ci];
    };
    auto lstore = [&](int buf) {
      float* base = (float*)(smem + buf * SC_BUFB);
      const int o = st * 64 + 4 * q16;
      *(float4*)(base + o) = make_float4(bflo(lkk.x), bfhi(lkk.x), bflo(lkk.y), bfhi(lkk.y));
      *(float4*)(base + 1024 + o) = make_float4(1.f - bflo(lu.x), 1.f - bfhi(lu.x), 1.f - bflo(lu.y), 1.f - bfhi(lu.y));
      *(float4*)(base + 2048 + o) = make_float4(bflo(lb.x), bfhi(lb.x), bflo(lb.y), bfhi(lb.y));
      *(float4*)(base + 3072 + o) = make_float4(bflo(lk.x), bfhi(lk.x), bflo(lk.y), bfhi(lk.y));
      *(float4*)(base + 4096 + o) = make_float4(bflo(lr.x), bfhi(lr.x), bflo(lr.y), bfhi(lr.y));
      base[5120 + st * 16 + q16] = bf2f(lv);
    };
    __syncthreads();
    gload(0); lstore(0);
    __syncthreads();
    float S0 = 0.f, S1 = 0.f, S2 = 0.f, S3 = 0.f;
    for (int c = 0; c < SEQ / SC_CH; ++c) {
      const bool more = c + 1 < SEQ / SC_CH;
      if (more) gload((c + 1) * SC_CH);
      const float* base = (const float*)(smem + (c & 1) * SC_BUFB);
#pragma unroll
      for (int s = 0; s < SC_CH; ++s) {
        const float4 kk = *(const float4*)(base + s * 64 + 4 * jq);
        const float4 wv = *(const float4*)(base + 1024 + s * 64 + 4 * jq);
        const float4 bv = *(const float4*)(base + 2048 + s * 64 + 4 * jq);
        const float4 kv = *(const float4*)(base + 3072 + s * 64 + 4 * jq);
        const float4 rv = *(const float4*)(base + 4096 + s * 64 + 4 * jq);
        const float v = base[5120 + s * 16 + 4 * w + r4];
        float sk = S0 * kk.x + S1 * kk.y + S2 * kk.z + S3 * kk.w;
        sk = row16_allsum(sk);
        S0 = S0 * wv.x - sk * bv.x + v * kv.x;
        S1 = S1 * wv.y - sk * bv.y + v * kv.y;
        S2 = S2 * wv.z - sk * bv.z + v * kv.z;
        S3 = S3 * wv.w - sk * bv.w + v * kv.w;
        float y = S0 * rv.x + S1 * rv.y + S2 * rv.z + S3 * rv.w;
        y = row16_allsum(y);
        Yl[s * 16 + 4 * w + r4] = y;
      }
      __syncthreads();
      YRAW[(tb + c * SC_CH + st) * 512 + ci] = Yl[st * 16 + q16];
      if (more) lstore((c + 1) & 1);
      __syncthreads();
    }
  }
}

DI void phase_3c(const Params& p, int bid, int nblk, char* smem) {
  char* ws = p.ws;
  const float* YRAW = (const float*)(ws + OFF_YRAW);
  const u16* KS = (const u16*)(ws + OFF_KS); const u16* RS = (const u16*)(ws + OFF_RS); const u16* VS = (const u16*)(ws + OFF_VS);
  const u16* G = (const u16*)(ws + OFF_G);
  u16* Y = (u16*)(ws + OFF_Y);
  const int tid = threadIdx.x, wid = tid >> 6, lane = tid & 63;
  for (int t = bid * 4 + wid; t < T; t += nblk * 4) {
    const int c0 = 8 * lane;
    const float4 y0 = *(const float4*)(YRAW + (size_t)t * 512 + c0);
    const float4 y1 = *(const float4*)(YRAW + (size_t)t * 512 + c0 + 4);
    float y[8] = {y0.x, y0.y, y0.z, y0.w, y1.x, y1.y, y1.z, y1.w};
    const uint4 rr = *(const uint4*)(RS + (size_t)t * 512 + c0);
    const uint4 kr = *(const uint4*)(KS + (size_t)t * 512 + c0);
    const uint4 vr = *(const uint4*)(VS + (size_t)t * 512 + c0);
    const uint4 gr = *(const uint4*)(G + (size_t)t * 512 + c0);
    float rv[8] = {bflo(rr.x), bfhi(rr.x), bflo(rr.y), bfhi(rr.y), bflo(rr.z), bfhi(rr.z), bflo(rr.w), bfhi(rr.w)};
    float kv[8] = {bflo(kr.x), bfhi(kr.x), bflo(kr.y), bfhi(kr.y), bflo(kr.z), bfhi(kr.z), bflo(kr.w), bfhi(kr.w)};
    float vv[8] = {bflo(vr.x), bfhi(vr.x), bflo(vr.y), bfhi(vr.y), bflo(vr.z), bfhi(vr.z), bflo(vr.w), bfhi(vr.w)};
    float gv[8] = {bflo(gr.x), bfhi(gr.x), bflo(gr.y), bfhi(gr.y), bflo(gr.z), bfhi(gr.z), bflo(gr.w), bfhi(gr.w)};
    float sm = 0.f, bsum = 0.f;
#pragma unroll
    for (int i = 0; i < 8; ++i) { sm += y[i]; bsum += rv[i] * kv[i] * p.r_k[c0 + i]; }
    sm += __shfl_xor(sm, 1); sm += __shfl_xor(sm, 2); sm += __shfl_xor(sm, 4);
    bsum += __shfl_xor(bsum, 1); bsum += __shfl_xor(bsum, 2); bsum += __shfl_xor(bsum, 4);
    const float mu = sm * (1.f / 64.f);
    float var = 0.f;
#pragma unroll
    for (int i = 0; i < 8; ++i) { const float d = y[i] - mu; var += d * d; }
    var += __shfl_xor(var, 1); var += __shfl_xor(var, 2); var += __shfl_xor(var, 4);
    const float rs = rsqrtf(var * (1.f / 64.f) + 64e-5f);
    float o[8];
#pragma unroll
    for (int i = 0; i < 8; ++i) o[i] = ((y[i] - mu) * rs * p.ln_x_w[c0 + i] + p.ln_x_b[c0 + i] + bsum * vv[i]) * gv[i];
    *(uint4*)(Y + (size_t)t * 1024 + 512 + c0) = make_uint4(pack2(o[0], o[1]), pack2(o[2], o[3]), pack2(o[4], o[5]), pack2(o[6], o[7]));
  }
}

DI void phase_wo(const Params& p, int bid, int nblk, char* smem) {
  char* ws = p.ws;
  const int tid = threadIdx.x;
  {
    uint2* EU = (uint2*)(ws + OFF_EU); uint2* EV = (uint2*)(ws + OFF_EV);
    const float4* su = (const float4*)p.expert_u; const float4* sv = (const float4*)p.expert_v;
    const float4* gf = (const float4*)p.g_ffn;
    for (size_t i = (size_t)bid * NTHR + tid; i < (size_t)16384 * 256; i += (size_t)nblk * NTHR) {
      const float4 g = gf[i & 255];
      const float4 a = su[i], b = sv[i];
      EU[i] = make_uint2(pack2(a.x * g.x, a.y * g.y), pack2(a.z * g.z, a.w * g.w));
      EV[i] = make_uint2(pack2(b.x, b.y), pack2(b.z, b.w));
    }
  }
  const u16* Y = (const u16*)(ws + OFF_Y);
  const int NT = 8;
  for (int tl = bid; tl < 256 * NT; tl += nblk) {
    const int mt = tl / NT, nt = tl % NT;
    gemm_tile(Y, 1024, (const u16*)(ws + OFF_WOT), 1024, 1024, mt * 128, nt * 128,
              [&](int r, int c, float v) { p.out[(size_t)r * DM + c] = p.x[(size_t)r * DM + c] + v; }, smem);
  }
}

DI void phase_5(const Params& p, int bid, int nblk, char* smem) {
  char* ws = p.ws;
  const int tid = threadIdx.x, wid = tid >> 6, lane = tid & 63;
  for (int row = bid * 4 + wid; row < T; row += nblk * 4) {
    const float4* xr = (const float4*)(p.out + (size_t)row * DM);
    uint2* xb = (uint2*)(ws + OFF_X2B + (size_t)row * DM * 2);
    float ss = 0.f;
#pragma unroll
    for (int i = 0; i < 4; ++i) {
      const float4 v = xr[lane + 64 * i];
      ss += v.x * v.x + v.y * v.y + v.z * v.z + v.w * v.w;
      xb[lane + 64 * i] = make_uint2(pack2(v.x, v.y), pack2(v.z, v.w));
    }
    ss = wave_allsum(ss);
    if (lane == 0) ((float*)(ws + OFF_RSTD2))[row] = rsqrtf(ss * (1.f / DM) + EPS);
  }
}

DI void phase_6(const Params& p, int bid, int nblk, char* smem) {
  char* ws = p.ws;
  const float* rstd = (const float*)(ws + OFF_RSTD2);
  u16* QP = (u16*)(ws + OFF_QP);
  const int NT = 16;
  for (int tl = bid; tl < 256 * NT; tl += nblk) {
    const int mt = tl / NT, nt = tl % NT;
    gemm_tile((const u16*)(ws + OFF_X2B), 1024, (const u16*)(ws + OFF_WPQT), 1024, 1024, mt * 128, nt * 128,
              [&](int r, int c, float v) { QP[(size_t)r * 2048 + c] = f2bf(v * rstd[r]); }, smem);
  }
}

DI void ins16(float (&top)[16], float x) {
#pragma unroll
  for (int i = 0; i < 16; ++i) { const float hi = fmaxf(top[i], x); x = fminf(top[i], x); top[i] = hi; }
}
DI void phase_7(const Params& p, int bid, int nblk, char* smem) {
  char* ws = p.ws;
  const u16* QP = (const u16*)(ws + OFF_QP);
  const u16* SUBK = (const u16*)(ws + OFF_SUBK);
  u16* IDX = (u16*)(ws + OFF_IDX); float* GATE = (float*)(ws + OFF_GATE);
  float* lists = (float*)smem;
  const int tid = threadIdx.x, w = tid >> 6, lane = tid & 63, r = lane & 31, hh = lane >> 5;
  const int th = w & 1, pp = w >> 1;
  for (int it = bid; it < 512 * 8; it += nblk) {
    const int tt = it >> 3, h = it & 7;
    const int t = tt * 64 + 32 * th + r;
    bf16x8 qf[8];
#pragma unroll
    for (int ks = 0; ks < 8; ++ks) qf[ks] = *reinterpret_cast<const bf16x8*>(QP + (size_t)t * 2048 + h * 256 + pp * 128 + 16 * ks + 8 * hh);
    const u16* sk = SUBK + (size_t)(h * 2 + pp) * 128 * 128;
    float top[16];
#pragma unroll
    for (int i = 0; i < 16; ++i) top[i] = -INFINITY;
#pragma unroll
    for (int kt = 0; kt < 4; ++kt) {
      f32x16 acc;
#pragma unroll
      for (int i = 0; i < 16; ++i) acc[i] = 0.f;
#pragma unroll
      for (int ks = 0; ks < 8; ++ks) {
        const bf16x8 a = *reinterpret_cast<const bf16x8*>(sk + (size_t)(32 * kt + r) * 128 + 16 * ks + 8 * hh);
        acc = MFMA32(a, qf[ks], acc);
      }
#pragma unroll
      for (int i = 0; i < 16; ++i) {
        const unsigned key = 32 * kt + (i & 3) + 8 * (i >> 2) + 4 * hh;
        const float v = __uint_as_float((__float_as_uint(acc[i]) & ~127u) | key);
        ins16(top, v);
      }
    }
    float oth[16];
#pragma unroll
    for (int i = 0; i < 16; ++i) oth[i] = __shfl_xor(top[i], 32);
#pragma unroll
    for (int i = 0; i < 16; ++i) ins16(top, oth[i]);
    __syncthreads();
    if (hh == 0) {
      float* dst = lists + ((32 * th + r) * 2 + pp) * 16;
#pragma unroll
      for (int i = 0; i < 16; i += 4) *(float4*)(dst + i) = make_float4(top[i], top[i + 1], top[i + 2], top[i + 3]);
    }
    __syncthreads();
    if (tid < 64) {
      const float* l1 = lists + (tid * 2 + 0) * 16;
      const float* l2 = lists + (tid * 2 + 1) * 16;
      float s1[16], s2[16];
#pragma unroll
      for (int i = 0; i < 16; ++i) {
        s1[i] = __uint_as_float(__float_as_uint(l1[i]) & ~127u);
        s2[i] = __uint_as_float(__float_as_uint(l2[i]) & ~127u);
      }
      float ts[16];
#pragma unroll
      for (int i = 0; i < 16; ++i) ts[i] = -INFINITY;
#pragma unroll
      for (int a = 0; a < 16; ++a)
#pragma unroll
        for (int b = 0; b < 16; ++b)
          if ((a + 1) * (b + 1) <= 16) {
            const float sm = s1[a] + s2[b];
            ins16(ts, __uint_as_float((__float_as_uint(sm) & ~255u) | (unsigned)(a * 16 + b)));
          }
      const size_t ob = ((size_t)(tt * 64 + tid) * 8 + h) * 16;
      float e[16], esum = 0.f;
      const float mx = __uint_as_float(__float_as_uint(ts[0]) & ~255u);
#pragma unroll
      for (int i = 0; i < 16; ++i) {
        const unsigned bits = __float_as_uint(ts[i]);
        const unsigned cid = bits & 255u;
        const float val = __uint_as_float(bits & ~255u);
        e[i] = __expf(val - mx); esum += e[i];
        const unsigned i1 = __float_as_uint(l1[cid >> 4]) & 127u, i2 = __float_as_uint(l2[cid & 15]) & 127u;
        IDX[ob + i] = (u16)(i1 * 128 + i2);
      }
      const float inv = 1.f / esum;
#pragma unroll
      for (int i = 0; i < 16; ++i) GATE[ob + i] = e[i] * inv;
    }
  }
}

typedef __bf16 bf2_t __attribute__((ext_vector_type(2)));
DI float dot2bf(unsigned a, unsigned b, float c) {
  return __builtin_amdgcn_fdot2_f32_bf16(__builtin_bit_cast(bf2_t, a), __builtin_bit_cast(bf2_t, b), c, false);
}
DI unsigned xcc_id_() { return (unsigned)__builtin_amdgcn_s_getreg((3 << 11) | 20) & 0xFu; }
DI unsigned idx_get(const uint4& a, const uint4& b, int j) {
  const unsigned w = j < 8 ? (j < 2 ? a.x : j < 4 ? a.y : j < 6 ? a.z : a.w) : (j < 10 ? b.x : j < 12 ? b.y : j < 14 ? b.z : b.w);
  return (j & 1) ? (w >> 16) : (w & 0xffffu);
}

DI void peer_u_item(const Params& p, int s, int item) {
  char* ws = p.ws;
  const u16* X2B = (const u16*)(ws + OFF_X2B);
  const u16* EU = (const u16*)(ws + OFF_EU);
  const u16* IDX = (const u16*)(ws + OFF_IDX);
  float* PART = (float*)(ws + OFF_PART) + (size_t)s * T * 128;
  const int tid = threadIdx.x, w = tid >> 6, lane = tid & 63, g8 = lane >> 3, c = lane & 7;
  const int tw = item * 64 + 16 * w;
  const size_t coff = 64 * s + 8 * c;
  uint4 i0 = *(const uint4*)(IDX + (size_t)tw * 128 + 16 * g8);
  uint4 i1 = *(const uint4*)(IDX + (size_t)tw * 128 + 16 * g8 + 8);
  for (int tt = 0; tt < 16; ++tt) {
    const int t = tw + tt;
    const uint4 xa = *(const uint4*)(X2B + (size_t)t * DM + coff);
    uint4 rows[16];
#pragma unroll
    for (int j = 0; j < 16; ++j) rows[j] = *(const uint4*)(EU + (size_t)idx_get(i0, i1, j) * DM + coff);
    if (tt < 15) {
      i0 = *(const uint4*)(IDX + (size_t)(t + 1) * 128 + 16 * g8);
      i1 = *(const uint4*)(IDX + (size_t)(t + 1) * 128 + 16 * g8 + 8);
    }
    float r[16];
#pragma unroll
    for (int j = 0; j < 16; ++j) {
      float d = dot2bf(xa.x, rows[j].x, 0.f);
      d = dot2bf(xa.y, rows[j].y, d); d = dot2bf(xa.z, rows[j].z, d); d = dot2bf(xa.w, rows[j].w, d);
      r[j] = d;
    }
#pragma unroll
    for (int j = 0; j < 8; ++j) { const bool hi = c & 4; const float keep = hi ? r[j + 8] : r[j], send = hi ? r[j] : r[j + 8]; r[j] = keep + __shfl_xor(send, 4); }
#pragma unroll
    for (int j = 0; j < 4; ++j) { const bool hi = c & 2; const float keep = hi ? r[j + 4] : r[j], send = hi ? r[j] : r[j + 4]; r[j] = keep + __shfl_xor(send, 2); }
#pragma unroll
    for (int j = 0; j < 2; ++j) { const bool hi = c & 1; const float keep = hi ? r[j + 2] : r[j], send = hi ? r[j] : r[j + 2]; r[j] = keep + __shfl_xor(send, 1); }
    *(float2*)(PART + (size_t)t * 128 + 2 * lane) = make_float2(r[0], r[1]);
  }
}

DI void peer_v_item(const Params& p, int s, int item) {
  char* ws = p.ws;
  const u16* EV = (const u16*)(ws + OFF_EV);
  const u16* IDX = (const u16*)(ws + OFF_IDX);
  const float* WGT = (const float*)(ws + OFF_WGT);
  const int tid = threadIdx.x, w = tid >> 6, lane = tid & 63, g8 = lane >> 3, c = lane & 7;
  const int tw = item * 64 + 16 * w;
  const size_t coff = 64 * s + 8 * c;
  uint4 i0 = *(const uint4*)(IDX + (size_t)tw * 128 + 16 * g8);
  uint4 i1 = *(const uint4*)(IDX + (size_t)tw * 128 + 16 * g8 + 8);
  for (int tt = 0; tt < 16; ++tt) {
    const int t = tw + tt;
    float wg[16];
    {
      const float4* wp = (const float4*)(WGT + (size_t)t * 128 + 16 * g8);
#pragma unroll
      for (int q = 0; q < 4; ++q) { const float4 v = wp[q]; wg[4 * q] = v.x; wg[4 * q + 1] = v.y; wg[4 * q + 2] = v.z; wg[4 * q + 3] = v.w; }
    }
    uint4 rows[16];
#pragma unroll
    for (int j = 0; j < 16; ++j) rows[j] = *(const uint4*)(EV + (size_t)idx_get(i0, i1, j) * DM + coff);
    if (tt < 15) {
      i0 = *(const uint4*)(IDX + (size_t)(t + 1) * 128 + 16 * g8);
      i1 = *(const uint4*)(IDX + (size_t)(t + 1) * 128 + 16 * g8 + 8);
    }
    float a[8];
#pragma unroll
    for (int i = 0; i < 8; ++i) a[i] = 0.f;
#pragma unroll
    for (int j = 0; j < 16; ++j) {
      a[0] += wg[j] * bflo(rows[j].x); a[1] += wg[j] * bfhi(rows[j].x); a[2] += wg[j] * bflo(rows[j].y); a[3] += wg[j] * bfhi(rows[j].y);
      a[4] += wg[j] * bflo(rows[j].z); a[5] += wg[j] * bfhi(rows[j].z); a[6] += wg[j] * bflo(rows[j].w); a[7] += wg[j] * bfhi(rows[j].w);
    }
#pragma unroll
    for (int i = 0; i < 4; ++i) { const bool hi = g8 & 4; const float keep = hi ? a[i + 4] : a[i], send = hi ? a[i] : a[i + 4]; a[i] = keep + __shfl_xor(send, 32); }
#pragma unroll
    for (int i = 0; i < 2; ++i) { const bool hi = g8 & 2; const float keep = hi ? a[i + 2] : a[i], send = hi ? a[i] : a[i + 2]; a[i] = keep + __shfl_xor(send, 16); }
    { const bool hi = g8 & 1; const float keep = hi ? a[1] : a[0], send = hi ? a[0] : a[1]; a[0] = keep + __shfl_xor(send, 8); }
    float* op = p.out + (size_t)t * DM + coff + g8;
    *op = *op + a[0];
  }
}

template <int WHICH>
DI void phase_peer_queue(const Params& p, int bid, int nblk, char* smem) {
  unsigned* ctr = (unsigned*)(p.ws + OFF_QCTR) + WHICH * NSL * 64;
  int* s_item = (int*)smem;
  const unsigned x = xcc_id_() & 7u;
  for (int rr = 0; rr < NSL; ++rr) {
    const int s = (int)((x + (unsigned)(rr >> 1)) & 7u) + 8 * (rr & 1);
    for (;;) {
      __syncthreads();
      if (threadIdx.x == 0) *s_item = (int)atomicAdd(&ctr[s * 64], 1u);
      __syncthreads();
      const int item = *s_item;
      if (item >= T / 64) break;
      if (WHICH == 0) peer_u_item(p, s, item); else peer_v_item(p, s, item);
    }
  }
}

DI void phase_peer_w(const Params& p, int bid, int nblk, char* smem) {
  char* ws = p.ws;
  const float* PART = (const float*)(ws + OFF_PART);
  const float* GATE = (const float*)(ws + OFF_GATE);
  const float* rstd2 = (const float*)(ws + OFF_RSTD2);
  float* WGT = (float*)(ws + OFF_WGT);
  for (size_t i = (size_t)bid * NTHR + threadIdx.x; i < (size_t)T * 128; i += (size_t)nblk * NTHR) {
    float sum = 0.f;
#pragma unroll
    for (int s = 0; s < NSL; ++s) sum += PART[(size_t)s * T * 128 + i];
    const float d = sum * rstd2[i >> 7];
    WGT[i] = GATE[i] * 0.5f * d * (1.f + erff(d * 0.70710678118654752f));
  }
}

#define XB_TMO      128
#define XB_XCNT(j)  (256  + 64 * (j))
#define XB_XSUB(j)  (1280 + 64 * (j))
#define XB_XGEN(j)  (2304 + 64 * (j))
#define XB_TOP      3328
#define XB_TOPGEN   3392
#define XCD_BAR_WORDS 3456
#define XB_SPIN_CAP (1u << 20)
#define LAS __attribute__((address_space(3)))
DI unsigned xb_ld(unsigned* p) { return __hip_atomic_load(p, __ATOMIC_RELAXED, __HIP_MEMORY_SCOPE_AGENT); }
DI unsigned xb_add(unsigned* p, unsigned v) { return __hip_atomic_fetch_add(p, v, __ATOMIC_RELAXED, __HIP_MEMORY_SCOPE_AGENT); }
DI unsigned xb_xcc_id() { return (unsigned)__builtin_amdgcn_s_getreg((3 << 11) | 20) & 0xFu; }
#define XB_SPIN(cond, bar) do { unsigned _sp = 0; while (cond) { __builtin_amdgcn_s_sleep(1); \
    if ((++_sp & 255u) == 0u) { if (xb_ld(&(bar)[XB_TMO])) break; if (_sp > XB_SPIN_CAP) { atomicAdd(&(bar)[XB_TMO], 1u); break; } } } } while (0)
struct XcdBarrier { unsigned* bar; unsigned x; volatile LAS unsigned* st; };
DI XcdBarrier xcd_barrier_post(unsigned* bar, volatile LAS unsigned* st) {
  XcdBarrier b; b.bar = bar; b.x = xb_xcc_id(); b.st = st;
  if (threadIdx.x == 0) (void)xb_add(&bar[XB_XCNT(b.x)], 1u);
  return b;
}
DI void xcd_barrier_complete(unsigned* bar, unsigned x, unsigned& nloc, unsigned& nx) {
  const unsigned G = gridDim.x * gridDim.y * gridDim.z;
  unsigned sum, cnt, mine, sp = 0u;
  for (;;) {
    sum = 0u; cnt = 0u; mine = 0u;
#pragma unroll
    for (unsigned j = 0; j < 16; ++j) { const unsigned c = xb_ld(&bar[XB_XCNT(j)]); sum += c; cnt += (c > 0u) ? 1u : 0u; mine = (j == x) ? c : mine; }
    if (sum == G) break;
    __builtin_amdgcn_s_sleep(1);
    if ((++sp & 255u) == 0u) { if (xb_ld(&bar[XB_TMO])) break; if (sp > XB_SPIN_CAP) { atomicAdd(&bar[XB_TMO], 1u); break; } }
  }
  nloc = mine > 0u ? mine : 1u; nx = cnt > 0u ? cnt : 1u;
}
DI void xcd_barrier(const XcdBarrier& b) {
  asm volatile("s_waitcnt vmcnt(0)" ::: "memory");
  __syncthreads();
  if (threadIdx.x == 0) {
    unsigned* bar = b.bar;
    __builtin_amdgcn_s_waitcnt(0);
    unsigned nloc = b.st[0], nx = b.st[1];
    if (nloc == 0u) { xcd_barrier_complete(bar, b.x, nloc, nx); b.st[0] = nloc; b.st[1] = nx; }
    const unsigned old = xb_add(&bar[XB_XSUB(b.x)], 1u);
    const unsigned gen = old / nloc;
    if (old + 1u == (gen + 1u) * nloc) {
      __builtin_amdgcn_fence(__ATOMIC_RELEASE, "agent");
      asm volatile("s_waitcnt vmcnt(0)" ::: "memory");
      const unsigned og = xb_add(&bar[XB_TOP], 1u);
      const unsigned tg = og / nx;
      if (og + 1u == (tg + 1u) * nx) xb_add(&bar[XB_TOPGEN], 1u);
      else XB_SPIN(xb_ld(&bar[XB_TOPGEN]) == tg, bar);
      __builtin_amdgcn_fence(__ATOMIC_ACQUIRE, "agent");
      xb_add(&bar[XB_XGEN(b.x)], 1u);
      asm volatile("s_waitcnt vmcnt(0)" ::: "memory");
    } else {
      XB_SPIN(xb_ld(&bar[XB_XGEN(b.x)]) == gen, bar);
      __builtin_amdgcn_fence(__ATOMIC_ACQUIRE, "agent");
      asm volatile("s_waitcnt vmcnt(0)" ::: "memory");
    }
  }
  __syncthreads();
}

constexpr int NPHASE = 12;
template <int PH>
DI void run_phase(const Params& p, int bid, int nblk, char* smem) {
  if constexpr (PH == 0) phase_prep(p, bid, nblk, smem);
  else if constexpr (PH == 1) phase_gemm1(p, bid, nblk, smem);
  else if constexpr (PH == 2) phase_2a(p, bid, nblk, smem);
  else if constexpr (PH == 3) phase_2b(p, bid, nblk, smem);
  else if constexpr (PH == 4) phase_2c(p, bid, nblk, smem);
  else if constexpr (PH == 5) phase_attn(p, bid, nblk, smem);
  else if constexpr (PH == 6) phase_scan(p, bid, nblk, smem);
  else if constexpr (PH == 7) phase_3c(p, bid, nblk, smem);
  else if constexpr (PH == 8) phase_wo(p, bid, nblk, smem);
  else if constexpr (PH == 9) phase_5(p, bid, nblk, smem);
  else if constexpr (PH == 10) phase_6(p, bid, nblk, smem);
  else if constexpr (PH == 11) { phase_7(p, bid, nblk, smem); }
  else if constexpr (PH == 12) phase_peer_queue<0>(p, bid, nblk, smem);
  else if constexpr (PH == 13) phase_peer_w(p, bid, nblk, smem);
  else phase_peer_queue<1>(p, bid, nblk, smem);
}

constexpr int SMEM_BYTES = 49152;

#if MEGA
__global__ void __launch_bounds__(NTHR, 2) mega_kernel(Params p) {
  __shared__ __attribute__((aligned(16))) char smem[SMEM_BYTES];
  __shared__ uint4 xb_words;
  cg::grid_group grid = cg::this_grid();
  const int bid = blockIdx.x, nblk = gridDim.x;
  if (threadIdx.x == 0) xb_words = make_uint4(0u, 0u, 0u, 0u);
  __syncthreads();
  XcdBarrier xb = xcd_barrier_post((unsigned*)(p.ws + OFF_BAR), (volatile LAS unsigned*)&xb_words);
  run_phase<0>(p, bid, nblk, smem); grid.sync();
  run_phase<1>(p, bid, nblk, smem); xcd_barrier(xb);
  run_phase<2>(p, bid, nblk, smem); xcd_barrier(xb);
  run_phase<3>(p, bid, nblk, smem); xcd_barrier(xb);
  run_phase<4>(p, bid, nblk, smem); xcd_barrier(xb);
  run_phase<5>(p, bid, nblk, smem); xcd_barrier(xb);
  run_phase<6>(p, bid, nblk, smem); xcd_barrier(xb);
  run_phase<7>(p, bid, nblk, smem); xcd_barrier(xb);
  run_phase<8>(p, bid, nblk, smem); xcd_barrier(xb);
  run_phase<9>(p, bid, nblk, smem); xcd_barrier(xb);
  run_phase<10>(p, bid, nblk, smem); xcd_barrier(xb);
  run_phase<11>(p, bid, nblk, smem); xcd_barrier(xb);
  run_phase<12>(p, bid, nblk, smem); xcd_barrier(xb);
  run_phase<13>(p, bid, nblk, smem); xcd_barrier(xb);
  run_phase<14>(p, bid, nblk, smem);
}
#else
template <int PH>
__global__ void __launch_bounds__(NTHR, 2) phase_kernel(Params p) {
  __shared__ __attribute__((aligned(16))) char smem[SMEM_BYTES];
  run_phase<PH>(p, blockIdx.x, gridDim.x, smem);
}
#endif

extern "C" void kernel_launch(void* const* d_in, const int* in_sizes, int n_in, void* d_out, int out_size, void* d_ws,
                              size_t ws_size, hipStream_t stream) {
  Params p{};
  p.x = (const float*)d_in[0]; p.pos = (const int*)d_in[1];
  p.g_mix = (const float*)d_in[2]; p.w_in = (const float*)d_in[3]; p.rwkv_mu = (const float*)d_in[4];
  p.g_cq = (const float*)d_in[5]; p.g_ckv = (const float*)d_in[6]; p.w_uq = (const float*)d_in[7];
  p.w_uk = (const float*)d_in[8]; p.w_uv = (const float*)d_in[9]; p.g_qnorm = (const float*)d_in[10];
  p.g_knorm = (const float*)d_in[11]; p.g_attn_out = (const float*)d_in[12]; p.w0 = (const float*)d_in[13];
  p.w2 = (const float*)d_in[14]; p.a0 = (const float*)d_in[15]; p.a2 = (const float*)d_in[16];
  p.g2 = (const float*)d_in[17]; p.k_k = (const float*)d_in[18]; p.k_a = (const float*)d_in[19];
  p.r_k = (const float*)d_in[20]; p.ln_x_w = (const float*)d_in[21]; p.ln_x_b = (const float*)d_in[22];
  p.w_o = (const float*)d_in[23]; p.g_ffn = (const float*)d_in[24]; p.w_pq = (const float*)d_in[25];
  p.sub_keys = (const float*)d_in[26]; p.expert_u = (const float*)d_in[27]; p.expert_v = (const float*)d_in[28];
  p.out = (float*)d_out; p.ws = (char*)d_ws;
#if MEGA
  static int grid_blocks = 0;
  if (!grid_blocks) {
    int dev = 0, cus = 0, per_cu = 0;
    hipGetDevice(&dev);
    hipDeviceGetAttribute(&cus, hipDeviceAttributeMultiprocessorCount, dev);
    (void)hipOccupancyMaxActiveBlocksPerMultiprocessor(&per_cu, mega_kernel, NTHR, 0);
    if (per_cu > 2) per_cu = 2;
    grid_blocks = cus * per_cu;
  }
  (void)hipMemsetAsync((char*)d_ws + OFF_BAR, 0, 32768, stream);
  void* args[] = {&p};
  hipError_t e = hipLaunchCooperativeKernel((void*)mega_kernel, dim3(grid_blocks), dim3(NTHR), args, 0, stream);
  if (e != hipSuccess) fprintf(stderr, "cooperative launch failed: %s (grid %d)\n", hipGetErrorString(e), grid_blocks);
#else
  const int NB = 512;
  phase_kernel<0><<<NB, NTHR, 0, stream>>>(p);
  phase_kernel<1><<<NB, NTHR, 0, stream>>>(p);
  phase_kernel<2><<<NB, NTHR, 0, stream>>>(p);
  phase_kernel<3><<<NB, NTHR, 0, stream>>>(p);
  phase_kernel<4><<<NB, NTHR, 0, stream>>>(p);
  phase_kernel<5><<<NB, NTHR, 0, stream>>>(p);
  phase_kernel<6><<<NB, NTHR, 0, stream>>>(p);
  phase_kernel<7><<<NB, NTHR, 0, stream>>>(p);
  phase_kernel<8><<<NB, NTHR, 0, stream>>>(p);
  phase_kernel<9><<<NB, NTHR, 0, stream>>>(p);
  phase_kernel<10><<<NB, NTHR, 0, stream>>>(p);
  phase_kernel<11><<<NB, NTHR, 0, stream>>>(p);
  phase_kernel<12><<<NB, NTHR, 0, stream>>>(p);
  phase_kernel<13><<<NB, NTHR, 0, stream>>>(p);
  phase_kernel<14><<<NB, NTHR, 0, stream>>>(p);
#endif
}
```

```cpp
#include <hip/hip_runtime.h>
#include <hip/hip_cooperative_groups.h>
#include <cstdio>
#include <cstdint>
namespace cg = cooperative_groups;

#ifndef MEGA
#define MEGA 1
#endif

typedef unsigned short u16;
using bf16x8 = __attribute__((ext_vector_type(8))) short;
using s16x4  = __attribute__((ext_vector_type(4))) short;
using f32x4  = __attribute__((ext_vector_type(4))) float;
using f32x16 = __attribute__((ext_vector_type(16))) float;
#define DI __device__ __forceinline__

constexpr int T = 32768, SEQ = 2048, DM = 1024;
constexpr int INC = 2464, MLAC = 672, RWC = 1792;
constexpr int NTHR = 256;
constexpr float EPS = 1e-6f;

constexpr size_t MiB = 1048576;
constexpr size_t OFF_WINT  = 0;
constexpr size_t OFF_WUQT  = OFF_WINT  + 2560 * 1024 * 2;
constexpr size_t OFF_WUKVT = OFF_WUQT  + 768 * 384 * 2;
constexpr size_t OFF_W2T   = OFF_WUKVT + 1024 * 256 * 2;
constexpr size_t OFF_A2T   = OFF_W2T   + 512 * 64 * 2;
constexpr size_t OFF_G2T   = OFF_A2T   + 512 * 64 * 2;
constexpr size_t OFF_WOT   = OFF_G2T   + 512 * 128 * 2;
constexpr size_t OFF_WPQT  = OFF_WOT   + 1024 * 1024 * 2;
constexpr size_t OFF_SUBK  = OFF_WPQT  + 2048 * 1024 * 2;
constexpr size_t OFF_ROPE  = OFF_SUBK  + 16 * 128 * 128 * 2;
constexpr size_t OFF_RSTD1 = OFF_ROPE  + (size_t)T * 32 * 4;
constexpr size_t OFF_RSTDQ = OFF_RSTD1 + (size_t)T * 4;
constexpr size_t OFF_RSTDKV= OFF_RSTDQ + (size_t)T * 4;
constexpr size_t OFF_RSTD2 = OFF_RSTDKV+ (size_t)T * 4;
constexpr size_t OFF_A_END = OFF_RSTD2 + (size_t)T * 4;
static_assert(OFF_A_END <= 19 * MiB, "region A");
constexpr size_t OFF_BAR   = 19 * MiB;
constexpr size_t OFF_QCTR  = OFF_BAR + 16384;
constexpr size_t OFF_XB    = 20 * MiB;
constexpr size_t OFF_Y     = OFF_XB;
constexpr size_t OFF_PM    = 84 * MiB;
constexpr size_t OFF_PR    = 126 * MiB;
constexpr size_t OFF_U     = OFF_PR;
constexpr size_t OFF_G     = OFF_PR + 32 * MiB;
constexpr size_t OFF_KK    = OFF_PR + 64 * MiB;
constexpr size_t OFF_KVRAW = 238 * MiB;
constexpr size_t OFF_QRAW  = 302 * MiB;
constexpr size_t OFF_LORAIN= 350 * MiB;
constexpr size_t OFF_YRAW  = 302 * MiB;
constexpr size_t OFF_RS    = 366 * MiB;
constexpr size_t OFF_KS    = 398 * MiB;
constexpr size_t OFF_VS    = 430 * MiB;
constexpr size_t OFF_BB    = 462 * MiB;
constexpr size_t OFF_EU    = 84 * MiB;
constexpr size_t OFF_EV    = 100 * MiB;
constexpr size_t OFF_X2B   = 148 * MiB;
constexpr size_t OFF_QP    = 238 * MiB;
constexpr size_t OFF_IDX   = 20 * MiB;
constexpr size_t OFF_GATE  = 28 * MiB;
constexpr size_t OFF_WGT   = 44 * MiB;
constexpr size_t OFF_PART  = 238 * MiB;
constexpr int NSL = 8;
constexpr float SU8 = 256.f, SV8 = 16.f;
constexpr size_t DO_Q = 0, DO_K = (size_t)T * 768 * 2, DO_AA = (size_t)T * 768 * 4;

struct Params {
  const float* x; const int* pos;
  const float *g_mix, *w_in, *rwkv_mu, *g_cq, *g_ckv, *w_uq, *w_uk, *w_uv, *g_qnorm, *g_knorm, *g_attn_out;
  const float *w0, *w2, *a0, *a2, *g2, *k_k, *k_a, *r_k, *ln_x_w, *ln_x_b, *w_o, *g_ffn, *w_pq, *sub_keys, *expert_u, *expert_v;
  float* out; char* ws;
};

DI u16 f2bf(float x) { unsigned u = __float_as_uint(x); u += 0x7fffu + ((u >> 16) & 1u); return (u16)(u >> 16); }
DI float bf2f(u16 h) { return __uint_as_float(((unsigned)h) << 16); }
DI unsigned pack2(float a, float b) { return (unsigned)f2bf(a) | ((unsigned)f2bf(b) << 16); }
DI float bflo(unsigned u) { return __uint_as_float(u << 16); }
DI float bfhi(unsigned u) { return __uint_as_float(u & 0xffff0000u); }
DI float wave_allsum(float v) {
#pragma unroll
  for (int o = 32; o > 0; o >>= 1) v += __shfl_xor(v, o);
  return v;
}
DI float sigmoidf_(float x) { return 1.f / (1.f + __expf(-x)); }

DI void tconv(const float* __restrict__ src, int K, int N, const float* __restrict__ scale, u16* __restrict__ dst,
              int ldd, int noff, int bid, int nblk, float* tile) {
  const int tid = threadIdx.x, tx = tid & 31, ty = tid >> 5;
  const int nbn = N / 32, ntl = (K / 32) * nbn;
  for (int tl = bid; tl < ntl; tl += nblk) {
    const int kb = tl / nbn, nb = tl % nbn;
#pragma unroll
    for (int i = 0; i < 4; ++i) {
      const int k = kb * 32 + ty + 8 * i;
      float v = src[(size_t)k * N + nb * 32 + tx];
      if (scale) v *= scale[k];
      tile[(ty + 8 * i) * 33 + tx] = v;
    }
    __syncthreads();
#pragma unroll
    for (int i = 0; i < 4; ++i) {
      const int n = nb * 32 + ty + 8 * i;
      dst[(size_t)(noff + n) * ldd + kb * 32 + tx] = f2bf(tile[tx * 33 + ty + 8 * i]);
    }
    __syncthreads();
  }
}

DI void phase_prep(const Params& p, int bid, int nblk, char* smem) {
  float* tile = (float*)smem;
  char* ws = p.ws;
  const int tid = threadIdx.x;
  tconv(p.w_in, 1024, INC, p.g_mix, (u16*)(ws + OFF_WINT), 1024, 0, bid, nblk, tile);
  for (int i = bid * NTHR + tid; i < 96 * 1024; i += nblk * NTHR) ((u16*)(ws + OFF_WINT))[2464 * 1024 + i] = 0;
  tconv(p.w_uq, 384, 768, p.g_cq, (u16*)(ws + OFF_WUQT), 384, 0, bid, nblk, tile);
  tconv(p.w_uk, 256, 512, p.g_ckv, (u16*)(ws + OFF_WUKVT), 256, 0, bid, nblk, tile);
  tconv(p.w_uv, 256, 512, p.g_ckv, (u16*)(ws + OFF_WUKVT), 256, 512, bid, nblk, tile);
  tconv(p.w2, 64, 512, nullptr, (u16*)(ws + OFF_W2T), 64, 0, bid, nblk, tile);
  tconv(p.a2, 64, 512, nullptr, (u16*)(ws + OFF_A2T), 64, 0, bid, nblk, tile);
  tconv(p.g2, 128, 512, nullptr, (u16*)(ws + OFF_G2T), 128, 0, bid, nblk, tile);
  tconv(p.w_o, 1024, 1024, nullptr, (u16*)(ws + OFF_WOT), 1024, 0, bid, nblk, tile);
  tconv(p.w_pq, 1024, 2048, p.g_ffn, (u16*)(ws + OFF_WPQT), 1024, 0, bid, nblk, tile);
  for (int i = bid * NTHR + tid; i < 16 * 128 * 128; i += nblk * NTHR) ((u16*)(ws + OFF_SUBK))[i] = f2bf(p.sub_keys[i]);
  for (int i = bid * NTHR + tid; i < T * 16; i += nblk * NTHR) {
    const int t = i >> 4, j = i & 15;
    const float inv = powf(10000.0f, -(float)j / 16.0f);
    const float ang = (float)p.pos[t] * inv;
    float s, c; sincosf(ang, &s, &c);
    float* rp = (float*)(ws + OFF_ROPE) + (size_t)t * 32;
    rp[j] = c; rp[16 + j] = s;
  }
  const int wid = tid >> 6, lane = tid & 63;
  for (int row = bid * 4 + wid; row < T; row += nblk * 4) {
    const float4* xr = (const float4*)(p.x + (size_t)row * DM);
    uint2* xb = (uint2*)(ws + OFF_XB + (size_t)row * DM * 2);
    float ss = 0.f;
#pragma unroll
    for (int i = 0; i < 4; ++i) {
      const float4 v = xr[lane + 64 * i];
      ss += v.x * v.x + v.y * v.y + v.z * v.z + v.w * v.w;
      xb[lane + 64 * i] = make_uint2(pack2(v.x, v.y), pack2(v.z, v.w));
    }
    ss = wave_allsum(ss);
    if (lane == 0) ((float*)(ws + OFF_RSTD1))[row] = rsqrtf(ss * (1.f / DM) + EPS);
  }
}

template <class Epi>
DI void gemm_tile(const u16* __restrict__ A, int lda, const u16* __restrict__ Bt, int ldb, int K, int m0, int n0,
                  Epi epi, char* smem) {
  u16* SA = (u16*)smem;
  u16* SB = SA + 128 * 32;
  const int tid = threadIdx.x, wid = tid >> 6, lane = tid & 63, wr = wid >> 1, wc = wid & 1, fr = lane & 15, fq = lane >> 4;
  f32x4 acc[4][4];
#pragma unroll
  for (int m = 0; m < 4; ++m)
#pragma unroll
    for (int n = 0; n < 4; ++n) acc[m][n] = f32x4{0.f, 0.f, 0.f, 0.f};
  const int nk = K / 32;
  for (int kt = 0; kt < nk; ++kt) {
#pragma unroll
    for (int i = 0; i < 2; ++i) {
      const int b = tid * 16 + i * 4096, r = b / 64, c = (b % 64) / 2;
      __builtin_amdgcn_global_load_lds((const unsigned*)(A + (size_t)(m0 + r) * lda + kt * 32 + c),
                                       (__attribute__((address_space(3))) unsigned*)((char*)SA + b), 16, 0, 0);
      __builtin_amdgcn_global_load_lds((const unsigned*)(Bt + (size_t)(n0 + r) * ldb + kt * 32 + c),
                                       (__attribute__((address_space(3))) unsigned*)((char*)SB + b), 16, 0, 0);
    }
    asm volatile("s_waitcnt vmcnt(0)" ::: "memory");
    __syncthreads();
    bf16x8 af[4], bfr[4];
#pragma unroll
    for (int m = 0; m < 4; ++m) af[m] = *reinterpret_cast<const bf16x8*>((char*)SA + (wr * 64 + m * 16 + fr) * 64 + fq * 16);
#pragma unroll
    for (int n = 0; n < 4; ++n) bfr[n] = *reinterpret_cast<const bf16x8*>((char*)SB + (wc * 64 + n * 16 + fr) * 64 + fq * 16);
#pragma unroll
    for (int m = 0; m < 4; ++m)
#pragma unroll
      for (int n = 0; n < 4; ++n) acc[m][n] = __builtin_amdgcn_mfma_f32_16x16x32_bf16(af[m], bfr[n], acc[m][n], 0, 0, 0);
    __syncthreads();
  }
#pragma unroll
  for (int m = 0; m < 4; ++m)
#pragma unroll
    for (int n = 0; n < 4; ++n)
#pragma unroll
      for (int j = 0; j < 4; ++j) epi(m0 + wr * 64 + m * 16 + fq * 4 + j, n0 + wc * 64 + n * 16 + fr, acc[m][n][j]);
}

DI void phase_gemm1(const Params& p, int bid, int nblk, char* smem) {
  char* ws = p.ws;
  const u16* A = (const u16*)(ws + OFF_XB);
  const u16* Bt = (const u16*)(ws + OFF_WINT);
  const float* rstd = (const float*)(ws + OFF_RSTD1);
  u16* PM = (u16*)(ws + OFF_PM);
  u16* PR = (u16*)(ws + OFF_PR);
  const int NT = 20;
  for (int tl = bid; tl < 256 * NT; tl += nblk) {
    const int mt = tl / NT, nt = tl % NT;
    gemm_tile(A, 1024, Bt, 1024, 1024, mt * 128, nt * 128,
              [&](int r, int c, float v) {
                if (c < INC) {
                  const u16 o = f2bf(v * rstd[r]);
                  if (c < MLAC) PM[(size_t)r * MLAC + c] = o; else PR[(size_t)r * RWC + (c - MLAC)] = o;
                }
              }, smem);
  }
}

DI void unpack8(const uint4& r, float (&v)[8]) {
  v[0] = bflo(r.x); v[1] = bfhi(r.x); v[2] = bflo(r.y); v[3] = bfhi(r.y); v[4] = bflo(r.z); v[5] = bfhi(r.z); v[6] = bflo(r.w); v[7] = bfhi(r.w);
}
DI uint4 pack8(const float (&v)[8]) { return make_uint4(pack2(v[0], v[1]), pack2(v[2], v[3]), pack2(v[4], v[5]), pack2(v[6], v[7])); }
DI float sumsq8(const uint4& r) { float v[8]; unpack8(r, v); float s = 0.f;
#pragma unroll
  for (int i = 0; i < 8; ++i) s += v[i] * v[i];
  return s; }
DI void phase_2a(const Params& p, int bid, int nblk, char* smem) {
  char* ws = p.ws;
  const u16* PM = (const u16*)(ws + OFF_PM);
  const u16* PR = (const u16*)(ws + OFF_PR);
  u16* RS = (u16*)(ws + OFF_RS); u16* KS = (u16*)(ws + OFF_KS); u16* VS = (u16*)(ws + OFF_VS);
  u16* LI = (u16*)(ws + OFF_LORAIN);
  const int tid = threadIdx.x, wid = tid >> 6, lane = tid & 63;
  float mu[4][8];
#pragma unroll
  for (int i = 0; i < 4; ++i) {
    const int ch = lane + 64 * i;
#pragma unroll
    for (int j = 0; j < 8; ++j) mu[i][j] = ch < 224 ? p.rwkv_mu[8 * ch + j] : 0.f;
  }
  for (int t = bid * 4 + wid; t < T; t += nblk * 4) {
    {
      const uint4 a = *(const uint4*)(PM + (size_t)t * MLAC + 8 * lane);
      const float sa = sumsq8(a);
      float sq = lane < 48 ? sa : 0.f, skv = lane < 48 ? 0.f : sa;
      if (lane < 16) skv += sumsq8(*(const uint4*)(PM + (size_t)t * MLAC + 512 + 8 * lane));
      sq = wave_allsum(sq); skv = wave_allsum(skv);
      if (lane == 0) {
        ((float*)(ws + OFF_RSTDQ))[t] = rsqrtf(sq * (1.f / 384.f) + EPS);
        ((float*)(ws + OFF_RSTDKV))[t] = rsqrtf(skv * (1.f / 256.f) + EPS);
      }
    }
    const bool first = (t % SEQ) == 0;
    const u16* cur = PR + (size_t)t * RWC;
#pragma unroll
    for (int i = 0; i < 4; ++i) {
      const int ch = lane + 64 * i;
      if (ch < 224) {
        float cv[8], pv[8], o[8];
        unpack8(*(const uint4*)(cur + 8 * ch), cv);
        if (first) {
#pragma unroll
          for (int j = 0; j < 8; ++j) pv[j] = 0.f;
        } else unpack8(*(const uint4*)(cur - RWC + 8 * ch), pv);
#pragma unroll
        for (int j = 0; j < 8; ++j) o[j] = cv[j] + (pv[j] - cv[j]) * mu[i][j];
        const int c = 8 * ch;
        if (c < 512) *(uint4*)(RS + (size_t)t * 512 + c) = pack8(o);
        else if (c < 1024) *(uint4*)(KS + (size_t)t * 512 + c - 512) = pack8(o);
        else if (c < 1536) *(uint4*)(VS + (size_t)t * 512 + c - 1024) = pack8(o);
        else {
          if (c < 1600) {
#pragma unroll
            for (int j = 0; j < 8; ++j) o[j] = tanhf(o[j]);
          } else if (c >= 1664) {
#pragma unroll
            for (int j = 0; j < 8; ++j) o[j] = sigmoidf_(o[j]);
          }
          *(uint4*)(LI + (size_t)t * 256 + c - 1536) = pack8(o);
        }
      }
    }
  }
}

DI void phase_2b(const Params& p, int bid, int nblk, char* smem) {
  char* ws = p.ws;
  const u16* PM = (const u16*)(ws + OFF_PM);
  const u16* LI = (const u16*)(ws + OFF_LORAIN);
  const float* rq = (const float*)(ws + OFF_RSTDQ);
  const float* rkv = (const float*)(ws + OFF_RSTDKV);
  u16* QRAW = (u16*)(ws + OFF_QRAW); u16* KVRAW = (u16*)(ws + OFF_KVRAW);
  u16* U = (u16*)(ws + OFF_U); u16* G = (u16*)(ws + OFF_G);
  u16* AA = (u16*)((char*)p.out + DO_AA);
  const int NT = 26;
  for (int tl = bid; tl < 256 * NT; tl += nblk) {
    const int mt = tl / NT, j = tl % NT, m0 = mt * 128;
    if (j < 6) {
      gemm_tile(PM, MLAC, (const u16*)(ws + OFF_WUQT), 384, 384, m0, j * 128,
                [&](int r, int c, float v) { QRAW[(size_t)r * 768 + c] = f2bf(v * rq[r]); }, smem);
    } else if (j < 14) {
      gemm_tile(PM + 384, MLAC, (const u16*)(ws + OFF_WUKVT), 256, 256, m0, (j - 6) * 128,
                [&](int r, int c, float v) { KVRAW[(size_t)r * 1024 + c] = f2bf(v * rkv[r]); }, smem);
    } else if (j < 18) {
      gemm_tile(LI, 256, (const u16*)(ws + OFF_W2T), 64, 64, m0, (j - 14) * 128,
                [&](int r, int c, float v) {
                  const float sg = sigmoidf_(p.w0[c] + v);
                  U[(size_t)r * 512 + c] = f2bf(-expm1f(-0.6065306597126334f * sg));
                }, smem);
    } else if (j < 22) {
      gemm_tile(LI + 64, 256, (const u16*)(ws + OFF_A2T), 64, 64, m0, (j - 18) * 128,
                [&](int r, int c, float v) { AA[(size_t)r * 512 + c] = f2bf(sigmoidf_(p.a0[c] + v)); }, smem);
    } else {
      gemm_tile(LI + 128, 256, (const u16*)(ws + OFF_G2T), 128, 128, m0, (j - 22) * 128,
                [&](int r, int c, float v) { G[(size_t)r * 512 + c] = f2bf(v); }, smem);
    }
  }
}

DI void phase_2c(const Params& p, int bid, int nblk, char* smem) {
  char* ws = p.ws;
  const u16* PM = (const u16*)(ws + OFF_PM);
  const u16* QRAW = (const u16*)(ws + OFF_QRAW);
  const u16* KVRAW = (const u16*)(ws + OFF_KVRAW);
  u16* Q = (u16*)((char*)p.out + DO_Q); u16* Kd = (u16*)((char*)p.out + DO_K);
  const u16* AA = (const u16*)((char*)p.out + DO_AA);
  u16* KS = (u16*)(ws + OFF_KS); u16* KK = (u16*)(ws + OFF_KK); u16* BB = (u16*)(ws + OFF_BB);
  const float* rope = (const float*)(ws + OFF_ROPE);
  const int tid = threadIdx.x, wid = tid >> 6, lane = tid & 63;
  const float QSCALE = 0.10206207261596575f * 1.4426950408889634f;
  for (int t = bid * 4 + wid; t < T; t += nblk * 4) {
    const int e0 = 2 * lane;
    const bool act = lane < 48;
    const bool isrope = lane >= 32 && lane < 48;
    const bool second = lane >= 40;
    float cs0 = 0.f, cs1 = 0.f, sn0 = 0.f, sn1 = 0.f;
    if (isrope) {
      const int i0 = e0 - (second ? 80 : 64);
      cs0 = rope[(size_t)t * 32 + i0]; cs1 = rope[(size_t)t * 32 + i0 + 1];
      sn0 = rope[(size_t)t * 32 + 16 + i0]; sn1 = rope[(size_t)t * 32 + 16 + i0 + 1];
    }
    float gq0 = 0.f, gq1 = 0.f, gk0 = 0.f, gk1 = 0.f;
    if (act) { gq0 = p.g_qnorm[e0]; gq1 = p.g_qnorm[e0 + 1]; gk0 = p.g_knorm[e0]; gk1 = p.g_knorm[e0 + 1]; }
    for (int h = 0; h < 8; ++h) {
#pragma unroll
      for (int which = 0; which < 2; ++which) {
        float v0 = 0.f, v1 = 0.f;
        if (act) {
          unsigned raw;
          if (which == 0) raw = *(const unsigned*)(QRAW + (size_t)t * 768 + h * 96 + e0);
          else if (e0 < 64) raw = *(const unsigned*)(KVRAW + (size_t)t * 1024 + h * 64 + e0);
          else raw = *(const unsigned*)(PM + (size_t)t * MLAC + 640 + (e0 - 64));
          v0 = bflo(raw); v1 = bfhi(raw);
        }
        const float ss = wave_allsum(v0 * v0 + v1 * v1);
        const float rs = rsqrtf(ss * (1.f / 96.f) + EPS);
        v0 *= rs * (which == 0 ? gq0 : gk0);
        v1 *= rs * (which == 0 ? gq1 : gk1);
        const float o0 = __shfl_xor(v0, 8), o1 = __shfl_xor(v1, 8);
        if (isrope) {
          if (!second) { v0 = v0 * cs0 - o0 * sn0; v1 = v1 * cs1 - o1 * sn1; }
          else { v0 = o0 * sn0 + v0 * cs0; v1 = o1 * sn1 + v1 * cs1; }
        }
        if (act) {
          if (which == 0) *(unsigned*)(Q + (size_t)t * 768 + h * 96 + e0) = pack2(v0 * QSCALE, v1 * QSCALE);
          else *(unsigned*)(Kd + (size_t)t * 768 + h * 96 + e0) = pack2(v0, v1);
        }
      }
    }
    {
      const int c0 = 8 * lane;
      const uint4 kraw = *(const uint4*)(KS + (size_t)t * 512 + c0);
      const uint4 araw = *(const uint4*)(AA + (size_t)t * 512 + c0);
      float kv[8], av[8], kkv[8];
      kv[0] = bflo(kraw.x); kv[1] = bfhi(kraw.x); kv[2] = bflo(kraw.y); kv[3] = bfhi(kraw.y);
      kv[4] = bflo(kraw.z); kv[5] = bfhi(kraw.z); kv[6] = bflo(kraw.w); kv[7] = bfhi(kraw.w);
      av[0] = bflo(araw.x); av[1] = bfhi(araw.x); av[2] = bflo(araw.y); av[3] = bfhi(araw.y);
      av[4] = bflo(araw.z); av[5] = bfhi(araw.z); av[6] = bflo(araw.w); av[7] = bfhi(araw.w);
      float ss = 0.f;
#pragma unroll
      for (int i = 0; i < 8; ++i) { kkv[i] = kv[i] * p.k_k[c0 + i]; ss += kkv[i] * kkv[i]; }
      ss += __shfl_xor(ss, 1); ss += __shfl_xor(ss, 2); ss += __shfl_xor(ss, 4);
      const float inv = 1.f / fmaxf(sqrtf(ss), 1e-12f);
      float kn[8], bb[8], k2[8];
#pragma unroll
      for (int i = 0; i < 8; ++i) {
        kn[i] = kkv[i] * inv;
        bb[i] = kn[i] * av[i];
        k2[i] = kv[i] * (1.f + (av[i] - 1.f) * p.k_a[c0 + i]);
      }
      *(uint4*)(KK + (size_t)t * 512 + c0) = make_uint4(pack2(kn[0], kn[1]), pack2(kn[2], kn[3]), pack2(kn[4], kn[5]), pack2(kn[6], kn[7]));
      *(uint4*)(BB + (size_t)t * 512 + c0) = make_uint4(pack2(bb[0], bb[1]), pack2(bb[2], bb[3]), pack2(bb[4], bb[5]), pack2(bb[6], bb[7]));
      *(uint4*)(KS + (size_t)t * 512 + c0) = make_uint4(pack2(k2[0], k2[1]), pack2(k2[2], k2[3]), pack2(k2[4], k2[5]), pack2(k2[6], k2[7]));
    }
  }
}

DI s16x4 tr_read(unsigned lds_addr) {
  s16x4 r;
  asm volatile("ds_read_b64_tr_b16 %0, %1\n\ts_waitcnt lgkmcnt(0)" : "=&v"(r) : "v"(lds_addr) : "memory");
  return r;
}
#define MFMA32(a, b, c) __builtin_amdgcn_mfma_f32_32x32x16_bf16((a), (b), (c), 0, 0, 0)

constexpr int KLD = 208, VLD = 192;
constexpr int ATT_KOFF = 0, ATT_VOFF = 64 * KLD;
DI void phase_attn(const Params& p, int bid, int nblk, char* smem) {
  char* ws = p.ws;
  const u16* Q = (const u16*)((char*)p.out + DO_Q);
  const u16* Kd = (const u16*)((char*)p.out + DO_K);
  const u16* KVRAW = (const u16*)(ws + OFF_KVRAW);
  u16* Y = (u16*)(ws + OFF_Y);
  const int tid = threadIdx.x, w = tid >> 6, lane = tid & 63, r = lane & 31, hh = lane >> 5;
  const unsigned lds_base = (unsigned)(size_t)smem;
  for (int it = bid; it < 2048; it += nblk) {
    const int rd = it >> 9, pos = it & 511, g = pos >> 7, bh = pos & 127;
    const int m = rd == 0 ? 15 - g : rd == 1 ? 8 + g : rd == 2 ? 7 - g : g;
    const int b = bh >> 3, h = bh & 7;
    const int t0 = b * SEQ + 128 * m;
    const int cw = 2 * m + (w >> 1);
    const int tq = t0 + 32 * w + r;
    bf16x8 qf[6];
#pragma unroll
    for (int ks = 0; ks < 6; ++ks) qf[ks] = *reinterpret_cast<const bf16x8*>(Q + (size_t)tq * 768 + h * 96 + 16 * ks + 8 * hh);
    f32x16 O0, O1;
#pragma unroll
    for (int i = 0; i < 16; ++i) { O0[i] = 0.f; O1[i] = 0.f; }
    float mrun = -1e30f, lrun = 0.f;
    const int nkt = 2 * m + 2;
    for (int kt = 0; kt < nkt; ++kt) {
      __syncthreads();
      const int tk0 = b * SEQ + 64 * kt;
#pragma unroll
      for (int i = 0; i < 3; ++i) {
        const int c = tid + 256 * i, row = c / 12, cc = c % 12;
        const uint4 v = *(const uint4*)(Kd + (size_t)(tk0 + row) * 768 + h * 96 + cc * 8);
        *(uint4*)(smem + ATT_KOFF + row * KLD + cc * 16) = v;
      }
#pragma unroll
      for (int i = 0; i < 2; ++i) {
        const int c = tid + 256 * i, row = c >> 3, cc = c & 7;
        const uint4 v = *(const uint4*)(KVRAW + (size_t)(tk0 + row) * 1024 + 512 + h * 64 + cc * 8);
        *(uint4*)(smem + ATT_VOFF + row * VLD + cc * 16) = v;
      }
      __syncthreads();
      if (kt <= cw) {
        f32x16 X[2];
#pragma unroll
        for (int sub = 0; sub < 2; ++sub) {
#pragma unroll
          for (int i = 0; i < 16; ++i) X[sub][i] = 0.f;
#pragma unroll
          for (int ks = 0; ks < 6; ++ks) {
            const bf16x8 a = *reinterpret_cast<const bf16x8*>(smem + ATT_KOFF + (32 * sub + r) * KLD + (16 * ks + 8 * hh) * 2);
            X[sub] = MFMA32(a, qf[ks], X[sub]);
          }
        }
        float mx = X[0][0];
#pragma unroll
        for (int i = 0; i < 16; ++i) { mx = fmaxf(mx, X[0][i]); mx = fmaxf(mx, X[1][i]); }
        mx = fmaxf(mx, __shfl_xor(mx, 32));
        const float mnew = fmaxf(mrun, mx);
        const float alpha = exp2f(mrun - mnew);
        mrun = mnew;
        float rsum = 0.f;
#pragma unroll
        for (int sub = 0; sub < 2; ++sub)
#pragma unroll
          for (int i = 0; i < 16; ++i) { const float e = exp2f(X[sub][i] - mnew); X[sub][i] = e; rsum += e; }
        lrun = lrun * alpha + rsum;
#pragma unroll
        for (int i = 0; i < 16; ++i) { O0[i] *= alpha; O1[i] *= alpha; }
        const int i16 = lane & 15, q4 = i16 >> 2, p4 = i16 & 3, blk = (lane >> 4) & 1;
#pragma unroll
        for (int sub = 0; sub < 2; ++sub) {
#pragma unroll
          for (int s = 0; s < 2; ++s) {
            bf16x8 pb;
#pragma unroll
            for (int j = 0; j < 8; ++j) pb[j] = (short)f2bf(X[sub][8 * s + j]);
            const unsigned rowlo = 32 * sub + 16 * s + 4 * hh + q4;
#pragma unroll
            for (int dt = 0; dt < 2; ++dt) {
              const unsigned colb = (32 * dt + 16 * blk) * 2 + 8 * p4;
              const s16x4 lo = tr_read(lds_base + ATT_VOFF + rowlo * VLD + colb);
              const s16x4 hi = tr_read(lds_base + ATT_VOFF + (rowlo + 8) * VLD + colb);
              const bf16x8 a = __builtin_shufflevector(lo, hi, 0, 1, 2, 3, 4, 5, 6, 7);
              if (dt == 0) O0 = MFMA32(a, pb, O0); else O1 = MFMA32(a, pb, O1);
            }
          }
        }
      }
    }
    const float ltot = lrun + __shfl_xor(lrun, 32);
    const float inv = 1.f / ltot;
    float ss = 0.f;
#pragma unroll
    for (int i = 0; i < 16; ++i) { O0[i] *= inv; O1[i] *= inv; ss += O0[i] * O0[i] + O1[i] * O1[i]; }
    ss += __shfl_xor(ss, 32);
    const float rs = rsqrtf(ss * (1.f / 64.f) + EPS);
#pragma unroll
    for (int dt = 0; dt < 2; ++dt)
#pragma unroll
      for (int gq = 0; gq < 4; ++gq) {
        const int d = 32 * dt + 8 * gq + 4 * hh;
        const float* gp = p.g_attn_out + h * 64 + d;
        float o[4];
#pragma unroll
        for (int j = 0; j < 4; ++j) o[j] = (dt == 0 ? O0[4 * gq + j] : O1[4 * gq + j]) * rs * gp[j];
        *(uint2*)(Y + (size_t)tq * 1024 + h * 64 + d) = make_uint2(pack2(o[0], o[1]), pack2(o[2], o[3]));
      }
  }
}

template <int N> DI float dpp_ror(float v) {
  return __builtin_bit_cast(float, __builtin_amdgcn_update_dpp(0, __builtin_bit_cast(int, v), 0x120 + N, 0xF, 0xF, false));
}
DI float row16_allsum(float v) {
  v += dpp_ror<8>(v); v += dpp_ror<4>(v); v += dpp_ror<2>(v); v += dpp_ror<1>(v);
  return v;
}
constexpr int SC_CH = 16, SC_BUFB = 21504;
DI void phase_scan(const Params& p, int bid, int nblk, char* smem) {
  char* ws = p.ws;
  const u16* KK = (const u16*)(ws + OFF_KK); const u16* U = (const u16*)(ws + OFF_U); const u16* BB = (const u16*)(ws + OFF_BB);
  const u16* KS = (const u16*)(ws + OFF_KS); const u16* RS = (const u16*)(ws + OFF_RS); const u16* VS = (const u16*)(ws + OFF_VS);
  float* YRAW = (float*)(ws + OFF_YRAW);
  const int tid = threadIdx.x, w = tid >> 6, lane = tid & 63, jq = lane & 15, r4 = lane >> 4;
  const int st = tid >> 4, q16 = tid & 15;
  float* Yl = (float*)(smem + 2 * SC_BUFB);
  for (int unit = bid; unit < 512; unit += nblk) {
    const int bh = unit >> 2, rg = unit & 3, b = bh >> 3, h = bh & 7;
    const size_t tb = (size_t)b * SEQ;
    const int cj = h * 64 + 4 * q16, ci = h * 64 + 16 * rg + q16;
    uint2 lkk, lu, lb, lk, lr; u16 lv;
    auto gload = [&](int s0) {
      const size_t o = (tb + s0 + st) * 512;
      lkk = *(const uint2*)(KK + o + cj); lu = *(const uint2*)(U + o + cj); lb = *(const uint2*)(BB + o + cj);
      lk = *(const uint2*)(KS + o + cj); lr = *(const uint2*)(RS + o + cj); lv = VS[o + ci];
    };
    auto lstore = [&](int buf) {
      float* base = (float*)(smem + buf * SC_BUFB);
      const int o = st * 64 + 4 * q16;
      *(float4*)(base + o) = make_float4(bflo(lkk.x), bfhi(lkk.x), bflo(lkk.y), bfhi(lkk.y));
      *(float4*)(base + 1024 + o) = make_float4(1.f - bflo(lu.x), 1.f - bfhi(lu.x), 1.f - bflo(lu.y), 1.f - bfhi(lu.y));
      *(float4*)(base + 2048 + o) = make_float4(bflo(lb.x), bfhi(lb.x), bflo(lb.y), bfhi(lb.y));
      *(float4*)(base + 3072 + o) = make_float4(bflo(lk.x), bfhi(lk.x), bflo(lk.y), bfhi(lk.y));
      *(float4*)(base + 4096 + o) = make_float4(bflo(lr.x), bfhi(lr.x), bflo(lr.y), bfhi(lr.y));
      base[5120 + st * 16 + q16] = bf2f(lv);
    };
    __syncthreads();
    gload(0); lstore(0);
    __syncthreads();
    float S0 = 0.f, S1 = 0.f, S2 = 0.f, S3 = 0.f;
    for (int c = 0; c < SEQ / SC_CH; ++c) {
      const bool more = c + 1 < SEQ / SC_CH;
      if (more) gload((c + 1) * SC_CH);
      const float* base = (const float*)(smem + (c & 1) * SC_BUFB);
#pragma unroll
      for (int s = 0; s < SC_CH; ++s) {
        const float4 kk = *(const float4*)(base + s * 64 + 4 * jq);
        const float4 wv = *(const float4*)(base + 1024 + s * 64 + 4 * jq);
        const float4 bv = *(const float4*)(base + 2048 + s * 64 + 4 * jq);
        const float4 kv = *(const float4*)(base + 3072 + s * 64 + 4 * jq);
        const float4 rv = *(const float4*)(base + 4096 + s * 64 + 4 * jq);
        const float v = base[5120 + s * 16 + 4 * w + r4];
        float sk = S0 * kk.x + S1 * kk.y + S2 * kk.z + S3 * kk.w;
        sk = row16_allsum(sk);
        S0 = S0 * wv.x - sk * bv.x + v * kv.x;
        S1 = S1 * wv.y - sk * bv.y + v * kv.y;
        S2 = S2 * wv.z - sk * bv.z + v * kv.z;
        S3 = S3 * wv.w - sk * bv.w + v * kv.w;
        float y = S0 * rv.x + S1 * rv.y + S2 * rv.z + S3 * rv.w;
        y = row16_allsum(y);
        Yl[s * 16 + 4 * w + r4] = y;
      }
      __syncthreads();
      YRAW[(tb + c * SC_CH + st) * 512 + ci] = Yl[st * 16 + q16];
      if (more) lstore((c + 1) & 1);
      __syncthreads();
    }
  }
}

DI void phase_3c(const Params& p, int bid, int nblk, char* smem) {
  char* ws = p.ws;
  const float* YRAW = (const float*)(ws + OFF_YRAW);
  const u16* KS = (const u16*)(ws + OFF_KS); const u16* RS = (const u16*)(ws + OFF_RS); const u16* VS = (const u16*)(ws + OFF_VS);
  const u16* G = (const u16*)(ws + OFF_G);
  u16* Y = (u16*)(ws + OFF_Y);
  const int tid = threadIdx.x, wid = tid >> 6, lane = tid & 63;
  for (int t = bid * 4 + wid; t < T; t += nblk * 4) {
    const int c0 = 8 * lane;
    const float4 y0 = *(const float4*)(YRAW + (size_t)t * 512 + c0);
    const float4 y1 = *(const float4*)(YRAW + (size_t)t * 512 + c0 + 4);
    float y[8] = {y0.x, y0.y, y0.z, y0.w, y1.x, y1.y, y1.z, y1.w};
    const uint4 rr = *(const uint4*)(RS + (size_t)t * 512 + c0);
    const uint4 kr = *(const uint4*)(KS + (size_t)t * 512 + c0);
    const uint4 vr = *(const uint4*)(VS + (size_t)t * 512 + c0);
    const uint4 gr = *(const uint4*)(G + (size_t)t * 512 + c0);
    float rv[8] = {bflo(rr.x), bfhi(rr.x), bflo(rr.y), bfhi(rr.y), bflo(rr.z), bfhi(rr.z), bflo(rr.w), bfhi(rr.w)};
    float kv[8] = {bflo(kr.x), bfhi(kr.x), bflo(kr.y), bfhi(kr.y), bflo(kr.z), bfhi(kr.z), bflo(kr.w), bfhi(kr.w)};
    float vv[8] = {bflo(vr.x), bfhi(vr.x), bflo(vr.y), bfhi(vr.y), bflo(vr.z), bfhi(vr.z), bflo(vr.w), bfhi(vr.w)};
    float gv[8] = {bflo(gr.x), bfhi(gr.x), bflo(gr.y), bfhi(gr.y), bflo(gr.z), bfhi(gr.z), bflo(gr.w), bfhi(gr.w)};
    float sm = 0.f, bsum = 0.f;
#pragma unroll
    for (int i = 0; i < 8; ++i) { sm += y[i]; bsum += rv[i] * kv[i] * p.r_k[c0 + i]; }
    sm += __shfl_xor(sm, 1); sm += __shfl_xor(sm, 2); sm += __shfl_xor(sm, 4);
    bsum += __shfl_xor(bsum, 1); bsum += __shfl_xor(bsum, 2); bsum += __shfl_xor(bsum, 4);
    const float mu = sm * (1.f / 64.f);
    float var = 0.f;
#pragma unroll
    for (int i = 0; i < 8; ++i) { const float d = y[i] - mu; var += d * d; }
    var += __shfl_xor(var, 1); var += __shfl_xor(var, 2); var += __shfl_xor(var, 4);
    const float rs = rsqrtf(var * (1.f / 64.f) + 64e-5f);
    float o[8];
#pragma unroll
    for (int i = 0; i < 8; ++i) o[i] = ((y[i] - mu) * rs * p.ln_x_w[c0 + i] + p.ln_x_b[c0 + i] + bsum * vv[i]) * gv[i];
    *(uint4*)(Y + (size_t)t * 1024 + 512 + c0) = make_uint4(pack2(o[0], o[1]), pack2(o[2], o[3]), pack2(o[4], o[5]), pack2(o[6], o[7]));
  }
}

DI void phase_wo(const Params& p, int bid, int nblk, char* smem) {
  char* ws = p.ws;
  const int tid = threadIdx.x;
  {
    unsigned* EU = (unsigned*)(ws + OFF_EU); unsigned* EV = (unsigned*)(ws + OFF_EV);
    const float4* su = (const float4*)p.expert_u; const float4* sv = (const float4*)p.expert_v;
    const float4* gf = (const float4*)p.g_ffn;
    for (size_t i = (size_t)bid * NTHR + tid; i < (size_t)16384 * 256; i += (size_t)nblk * NTHR) {
      const float4 g = gf[i & 255];
      const float4 a = su[i], b = sv[i];
      int pu = 0, pv = 0;
      pu = __builtin_amdgcn_cvt_pk_fp8_f32(a.x * g.x * SU8, a.y * g.y * SU8, pu, false);
      pu = __builtin_amdgcn_cvt_pk_fp8_f32(a.z * g.z * SU8, a.w * g.w * SU8, pu, true);
      pv = __builtin_amdgcn_cvt_pk_fp8_f32(b.x * SV8, b.y * SV8, pv, false);
      pv = __builtin_amdgcn_cvt_pk_fp8_f32(b.z * SV8, b.w * SV8, pv, true);
      EU[i] = (unsigned)pu; EV[i] = (unsigned)pv;
    }
  }
  const u16* Y = (const u16*)(ws + OFF_Y);
  const int NT = 8;
  for (int tl = bid; tl < 256 * NT; tl += nblk) {
    const int mt = tl / NT, nt = tl % NT;
    gemm_tile(Y, 1024, (const u16*)(ws + OFF_WOT), 1024, 1024, mt * 128, nt * 128,
              [&](int r, int c, float v) { p.out[(size_t)r * DM + c] = p.x[(size_t)r * DM + c] + v; }, smem);
  }
}

DI void phase_5(const Params& p, int bid, int nblk, char* smem) {
  char* ws = p.ws;
  const int tid = threadIdx.x, wid = tid >> 6, lane = tid & 63;
  for (int row = bid * 4 + wid; row < T; row += nblk * 4) {
    const float4* xr = (const float4*)(p.out + (size_t)row * DM);
    uint2* xb = (uint2*)(ws + OFF_X2B + (size_t)row * DM * 2);
    float ss = 0.f;
#pragma unroll
    for (int i = 0; i < 4; ++i) {
      const float4 v = xr[lane + 64 * i];
      ss += v.x * v.x + v.y * v.y + v.z * v.z + v.w * v.w;
      xb[lane + 64 * i] = make_uint2(pack2(v.x, v.y), pack2(v.z, v.w));
    }
    ss = wave_allsum(ss);
    if (lane == 0) ((float*)(ws + OFF_RSTD2))[row] = rsqrtf(ss * (1.f / DM) + EPS);
  }
}

DI void phase_6(const Params& p, int bid, int nblk, char* smem) {
  char* ws = p.ws;
  const float* rstd = (const float*)(ws + OFF_RSTD2);
  u16* QP = (u16*)(ws + OFF_QP);
  const int NT = 16;
  for (int tl = bid; tl < 256 * NT; tl += nblk) {
    const int mt = tl / NT, nt = tl % NT;
    gemm_tile((const u16*)(ws + OFF_X2B), 1024, (const u16*)(ws + OFF_WPQT), 1024, 1024, mt * 128, nt * 128,
              [&](int r, int c, float v) { QP[(size_t)r * 2048 + c] = f2bf(v * rstd[r]); }, smem);
  }
}

DI void ins16(float (&top)[16], float x) {
#pragma unroll
  for (int i = 0; i < 16; ++i) { const float hi = fmaxf(top[i], x); x = fminf(top[i], x); top[i] = hi; }
}
DI void phase_7(const Params& p, int bid, int nblk, char* smem) {
  char* ws = p.ws;
  const u16* QP = (const u16*)(ws + OFF_QP);
  const u16* SUBK = (const u16*)(ws + OFF_SUBK);
  u16* IDX = (u16*)(ws + OFF_IDX); float* GATE = (float*)(ws + OFF_GATE);
  float* lists = (float*)smem;
  const int tid = threadIdx.x, w = tid >> 6, lane = tid & 63, r = lane & 31, hh = lane >> 5;
  const int th = w & 1, pp = w >> 1;
  for (int it = bid; it < 512 * 8; it += nblk) {
    const int tt = it >> 3, h = it & 7;
    const int t = tt * 64 + 32 * th + r;
    bf16x8 qf[8];
#pragma unroll
    for (int ks = 0; ks < 8; ++ks) qf[ks] = *reinterpret_cast<const bf16x8*>(QP + (size_t)t * 2048 + h * 256 + pp * 128 + 16 * ks + 8 * hh);
    const u16* sk = SUBK + (size_t)(h * 2 + pp) * 128 * 128;
    float top[16];
#pragma unroll
    for (int i = 0; i < 16; ++i) top[i] = -INFINITY;
#pragma unroll
    for (int kt = 0; kt < 4; ++kt) {
      f32x16 acc;
#pragma unroll
      for (int i = 0; i < 16; ++i) acc[i] = 0.f;
#pragma unroll
      for (int ks = 0; ks < 8; ++ks) {
        const bf16x8 a = *reinterpret_cast<const bf16x8*>(sk + (size_t)(32 * kt + r) * 128 + 16 * ks + 8 * hh);
        acc = MFMA32(a, qf[ks], acc);
      }
#pragma unroll
      for (int i = 0; i < 16; ++i) {
        const unsigned key = 32 * kt + (i & 3) + 8 * (i >> 2) + 4 * hh;
        const float v = __uint_as_float((__float_as_uint(acc[i]) & ~127u) | key);
        ins16(top, v);
      }
    }
    float oth[16];
#pragma unroll
    for (int i = 0; i < 16; ++i) oth[i] = __shfl_xor(top[i], 32);
#pragma unroll
    for (int i = 0; i < 16; ++i) ins16(top, oth[i]);
    __syncthreads();
    if (hh == 0) {
      float* dst = lists + ((32 * th + r) * 2 + pp) * 16;
#pragma unroll
      for (int i = 0; i < 16; i += 4) *(float4*)(dst + i) = make_float4(top[i], top[i + 1], top[i + 2], top[i + 3]);
    }
    __syncthreads();
    if (tid < 64) {
      const float* l1 = lists + (tid * 2 + 0) * 16;
      const float* l2 = lists + (tid * 2 + 1) * 16;
      float s1[16], s2[16];
#pragma unroll
      for (int i = 0; i < 16; ++i) {
        s1[i] = __uint_as_float(__float_as_uint(l1[i]) & ~127u);
        s2[i] = __uint_as_float(__float_as_uint(l2[i]) & ~127u);
      }
      float ts[16];
#pragma unroll
      for (int i = 0; i < 16; ++i) ts[i] = -INFINITY;
#pragma unroll
      for (int a = 0; a < 16; ++a)
#pragma unroll
        for (int b = 0; b < 16; ++b)
          if ((a + 1) * (b + 1) <= 16) {
            const float sm = s1[a] + s2[b];
            ins16(ts, __uint_as_float((__float_as_uint(sm) & ~255u) | (unsigned)(a * 16 + b)));
          }
      const size_t ob = ((size_t)(tt * 64 + tid) * 8 + h) * 16;
      float e[16], esum = 0.f;
      const float mx = __uint_as_float(__float_as_uint(ts[0]) & ~255u);
#pragma unroll
      for (int i = 0; i < 16; ++i) {
        const unsigned bits = __float_as_uint(ts[i]);
        const unsigned cid = bits & 255u;
        const float val = __uint_as_float(bits & ~255u);
        e[i] = __expf(val - mx); esum += e[i];
        const unsigned i1 = __float_as_uint(l1[cid >> 4]) & 127u, i2 = __float_as_uint(l2[cid & 15]) & 127u;
        IDX[ob + i] = (u16)(i1 * 128 + i2);
      }
      const float inv = 1.f / esum;
#pragma unroll
      for (int i = 0; i < 16; ++i) GATE[ob + i] = e[i] * inv;
    }
  }
}

typedef __bf16 bf2_t __attribute__((ext_vector_type(2)));
DI float dot2bf(unsigned a, unsigned b, float c) {
  return __builtin_amdgcn_fdot2_f32_bf16(__builtin_bit_cast(bf2_t, a), __builtin_bit_cast(bf2_t, b), c, false);
}
DI unsigned xcc_id_() { return (unsigned)__builtin_amdgcn_s_getreg((3 << 11) | 20) & 0xFu; }
DI unsigned idx_get(const uint4& a, const uint4& b, int j) {
  const unsigned w = j < 8 ? (j < 2 ? a.x : j < 4 ? a.y : j < 6 ? a.z : a.w) : (j < 10 ? b.x : j < 12 ? b.y : j < 14 ? b.z : b.w);
  return (j & 1) ? (w >> 16) : (w & 0xffffu);
}

typedef float f32x2_t __attribute__((ext_vector_type(2)));
DI void fp8x16_to_f32(const uint4& r, float (&v)[16]) {
  const unsigned w[4] = {r.x, r.y, r.z, r.w};
#pragma unroll
  for (int q = 0; q < 4; ++q) {
    const f32x2_t lo = __builtin_amdgcn_cvt_pk_f32_fp8((int)w[q], false);
    const f32x2_t hi = __builtin_amdgcn_cvt_pk_f32_fp8((int)w[q], true);
    v[4 * q] = lo.x; v[4 * q + 1] = lo.y; v[4 * q + 2] = hi.x; v[4 * q + 3] = hi.y;
  }
}
DI void pin4(uint4& r) { asm volatile("" : "+v"(r.x), "+v"(r.y), "+v"(r.z), "+v"(r.w)); }
DI void pin16(float (&a)[16]) {
  asm volatile("" : "+v"(a[0]), "+v"(a[1]), "+v"(a[2]), "+v"(a[3]), "+v"(a[4]), "+v"(a[5]), "+v"(a[6]), "+v"(a[7]),
                    "+v"(a[8]), "+v"(a[9]), "+v"(a[10]), "+v"(a[11]), "+v"(a[12]), "+v"(a[13]), "+v"(a[14]), "+v"(a[15]));
}
DI void peer_u_item(const Params& p, int s, int item) {
  char* ws = p.ws;
  const u16* X2B = (const u16*)(ws + OFF_X2B);
  const unsigned char* EU = (const unsigned char*)(ws + OFF_EU);
  const u16* IDX = (const u16*)(ws + OFF_IDX);
  float* PART = (float*)(ws + OFF_PART) + (size_t)s * T * 128;
  const int tid = threadIdx.x, w = tid >> 6, lane = tid & 63, g8 = lane >> 3, c = lane & 7;
  const int tw = item * 64 + 16 * w;
  const size_t coff = 128 * s + 16 * c;
  uint4 i0 = *(const uint4*)(IDX + (size_t)tw * 128 + 16 * g8);
  uint4 i1 = *(const uint4*)(IDX + (size_t)tw * 128 + 16 * g8 + 8);
  for (int tt = 0; tt < 16; ++tt) {
    const int t = tw + tt;
    float xf[16];
    {
      const uint4 xa = *(const uint4*)(X2B + (size_t)t * DM + coff);
      const uint4 xb = *(const uint4*)(X2B + (size_t)t * DM + coff + 8);
      float lo[8], hi[8]; unpack8(xa, lo); unpack8(xb, hi);
#pragma unroll
      for (int i = 0; i < 8; ++i) { xf[i] = lo[i]; xf[8 + i] = hi[i]; }
    }
    uint4 rows[16];
#pragma unroll
    for (int j = 0; j < 16; ++j) rows[j] = *(const uint4*)(EU + (size_t)idx_get(i0, i1, j) * DM + coff);
    if (tt < 15) {
      i0 = *(const uint4*)(IDX + (size_t)(t + 1) * 128 + 16 * g8);
      i1 = *(const uint4*)(IDX + (size_t)(t + 1) * 128 + 16 * g8 + 8);
    }
    float r[16];
#pragma unroll
    for (int j = 0; j < 16; ++j) {
      pin4(rows[j]);
      float e[16]; fp8x16_to_f32(rows[j], e);
      float d = 0.f;
#pragma unroll
      for (int i = 0; i < 16; ++i) d += xf[i] * e[i];
      asm volatile("" : "+v"(d));
      r[j] = d;
    }
#pragma unroll
    for (int j = 0; j < 8; ++j) { const bool hi = c & 4; const float keep = hi ? r[j + 8] : r[j], send = hi ? r[j] : r[j + 8]; r[j] = keep + __shfl_xor(send, 4); }
#pragma unroll
    for (int j = 0; j < 4; ++j) { const bool hi = c & 2; const float keep = hi ? r[j + 4] : r[j], send = hi ? r[j] : r[j + 4]; r[j] = keep + __shfl_xor(send, 2); }
#pragma unroll
    for (int j = 0; j < 2; ++j) { const bool hi = c & 1; const float keep = hi ? r[j + 2] : r[j], send = hi ? r[j] : r[j + 2]; r[j] = keep + __shfl_xor(send, 1); }
    *(float2*)(PART + (size_t)t * 128 + 2 * lane) = make_float2(r[0], r[1]);
  }
}

DI void peer_v_item(const Params& p, int s, int item) {
  char* ws = p.ws;
  const unsigned char* EV = (const unsigned char*)(ws + OFF_EV);
  const u16* IDX = (const u16*)(ws + OFF_IDX);
  const float* WGT = (const float*)(ws + OFF_WGT);
  const int tid = threadIdx.x, w = tid >> 6, lane = tid & 63, g8 = lane >> 3, c = lane & 7;
  const int tw = item * 64 + 16 * w;
  const size_t coff = 128 * s + 16 * c;
  uint4 i0 = *(const uint4*)(IDX + (size_t)tw * 128 + 16 * g8);
  uint4 i1 = *(const uint4*)(IDX + (size_t)tw * 128 + 16 * g8 + 8);
  for (int tt = 0; tt < 16; ++tt) {
    const int t = tw + tt;
    float wg[16];
    {
      const float4* wp = (const float4*)(WGT + (size_t)t * 128 + 16 * g8);
#pragma unroll
      for (int q = 0; q < 4; ++q) { const float4 v = wp[q]; wg[4 * q] = v.x; wg[4 * q + 1] = v.y; wg[4 * q + 2] = v.z; wg[4 * q + 3] = v.w; }
    }
    uint4 rows[16];
#pragma unroll
    for (int j = 0; j < 16; ++j) rows[j] = *(const uint4*)(EV + (size_t)idx_get(i0, i1, j) * DM + coff);
    if (tt < 15) {
      i0 = *(const uint4*)(IDX + (size_t)(t + 1) * 128 + 16 * g8);
      i1 = *(const uint4*)(IDX + (size_t)(t + 1) * 128 + 16 * g8 + 8);
    }
    float a[16];
#pragma unroll
    for (int i = 0; i < 16; ++i) a[i] = 0.f;
#pragma unroll
    for (int j = 0; j < 16; ++j) {
      pin4(rows[j]);
      float e[16]; fp8x16_to_f32(rows[j], e);
#pragma unroll
      for (int i = 0; i < 16; ++i) a[i] += wg[j] * e[i];
      pin16(a);
    }
#pragma unroll
    for (int i = 0; i < 8; ++i) { const bool hi = g8 & 4; const float keep = hi ? a[i + 8] : a[i], send = hi ? a[i] : a[i + 8]; a[i] = keep + __shfl_xor(send, 32); }
#pragma unroll
    for (int i = 0; i < 4; ++i) { const bool hi = g8 & 2; const float keep = hi ? a[i + 4] : a[i], send = hi ? a[i] : a[i + 4]; a[i] = keep + __shfl_xor(send, 16); }
#pragma unroll
    for (int i = 0; i < 2; ++i) { const bool hi = g8 & 1; const float keep = hi ? a[i + 2] : a[i], send = hi ? a[i] : a[i + 2]; a[i] = keep + __shfl_xor(send, 8); }
    float2* op = (float2*)(p.out + (size_t)t * DM + coff + 2 * g8);
    float2 o = *op; o.x += a[0]; o.y += a[1]; *op = o;
  }
}

template <int WHICH>
DI void phase_peer_queue(const Params& p, int bid, int nblk, char* smem) {
  unsigned* ctr = (unsigned*)(p.ws + OFF_QCTR) + WHICH * NSL * 64;
  int* s_item = (int*)smem;
  const unsigned x = xcc_id_() & 7u;
  for (int rr = 0; rr < NSL; ++rr) {
    const int s = (int)((x + (unsigned)rr) & 7u);
    for (;;) {
      __syncthreads();
      if (threadIdx.x == 0) *s_item = (int)atomicAdd(&ctr[s * 64], 1u);
      __syncthreads();
      const int item = *s_item;
      if (item >= T / 64) break;
      if (WHICH == 0) peer_u_item(p, s, item); else peer_v_item(p, s, item);
    }
  }
}

DI void phase_peer_w(const Params& p, int bid, int nblk, char* smem) {
  char* ws = p.ws;
  const float* PART = (const float*)(ws + OFF_PART);
  const float* GATE = (const float*)(ws + OFF_GATE);
  const float* rstd2 = (const float*)(ws + OFF_RSTD2);
  float* WGT = (float*)(ws + OFF_WGT);
  for (size_t i = (size_t)bid * NTHR + threadIdx.x; i < (size_t)T * 128; i += (size_t)nblk * NTHR) {
    float sum = 0.f;
#pragma unroll
    for (int s = 0; s < NSL; ++s) sum += PART[(size_t)s * T * 128 + i];
    const float d = sum * rstd2[i >> 7] * (1.f / SU8);
    WGT[i] = GATE[i] * (0.5f / SV8) * d * (1.f + erff(d * 0.70710678118654752f));
  }
}

#define XB_TMO      128
#define XB_XCNT(j)  (256  + 64 * (j))
#define XB_XSUB(j)  (1280 + 64 * (j))
#define XB_XGEN(j)  (2304 + 64 * (j))
#define XB_TOP      3328
#define XB_TOPGEN   3392
#define XCD_BAR_WORDS 3456
#define XB_SPIN_CAP (1u << 20)
#define LAS __attribute__((address_space(3)))
DI unsigned xb_ld(unsigned* p) { return __hip_atomic_load(p, __ATOMIC_RELAXED, __HIP_MEMORY_SCOPE_AGENT); }
DI unsigned xb_add(unsigned* p, unsigned v) { return __hip_atomic_fetch_add(p, v, __ATOMIC_RELAXED, __HIP_MEMORY_SCOPE_AGENT); }
DI unsigned xb_xcc_id() { return (unsigned)__builtin_amdgcn_s_getreg((3 << 11) | 20) & 0xFu; }
#define XB_SPIN(cond, bar) do { unsigned _sp = 0; while (cond) { __builtin_amdgcn_s_sleep(1); \
    if ((++_sp & 255u) == 0u) { if (xb_ld(&(bar)[XB_TMO])) break; if (_sp > XB_SPIN_CAP) { atomicAdd(&(bar)[XB_TMO], 1u); break; } } } } while (0)
struct XcdBarrier { unsigned* bar; unsigned x; volatile LAS unsigned* st; };
DI XcdBarrier xcd_barrier_post(unsigned* bar, volatile LAS unsigned* st) {
  XcdBarrier b; b.bar = bar; b.x = xb_xcc_id(); b.st = st;
  if (threadIdx.x == 0) (void)xb_add(&bar[XB_XCNT(b.x)], 1u);
  return b;
}
DI void xcd_barrier_complete(unsigned* bar, unsigned x, unsigned& nloc, unsigned& nx) {
  const unsigned G = gridDim.x * gridDim.y * gridDim.z;
  unsigned sum, cnt, mine, sp = 0u;
  for (;;) {
    sum = 0u; cnt = 0u; mine = 0u;
#pragma unroll
    for (unsigned j = 0; j < 16; ++j) { const unsigned c = xb_ld(&bar[XB_XCNT(j)]); sum += c; cnt += (c > 0u) ? 1u : 0u; mine = (j == x) ? c : mine; }
    if (sum == G) break;
    __builtin_amdgcn_s_sleep(1);
    if ((++sp & 255u) == 0u) { if (xb_ld(&bar[XB_TMO])) break; if (sp > XB_SPIN_CAP) { atomicAdd(&bar[XB_TMO], 1u); break; } }
  }
  nloc = mine > 0u ? mine : 1u; nx = cnt > 0u ? cnt : 1u;
}
DI void xcd_barrier(const XcdBarrier& b) {
  asm volatile("s_waitcnt vmcnt(0)" ::: "memory");
  __syncthreads();
  if (threadIdx.x == 0) {
    unsigned* bar = b.bar;
    __builtin_amdgcn_s_waitcnt(0);
    unsigned nloc = b.st[0], nx = b.st[1];
    if (nloc == 0u) { xcd_barrier_complete(bar, b.x, nloc, nx); b.st[0] = nloc; b.st[1] = nx; }
    const unsigned old = xb_add(&bar[XB_XSUB(b.x)], 1u);
    const unsigned gen = old / nloc;
    if (old + 1u == (gen + 1u) * nloc) {
      __builtin_amdgcn_fence(__ATOMIC_RELEASE, "agent");
      asm volatile("s_waitcnt vmcnt(0)" ::: "memory");
      const unsigned og = xb_add(&bar[XB_TOP], 1u);
      const unsigned tg = og / nx;
      if (og + 1u == (tg + 1u) * nx) xb_add(&bar[XB_TOPGEN], 1u);
      else XB_SPIN(xb_ld(&bar[XB_TOPGEN]) == tg, bar);
      __builtin_amdgcn_fence(__ATOMIC_ACQUIRE, "agent");
      xb_add(&bar[XB_XGEN(b.x)], 1u);
      asm volatile("s_waitcnt vmcnt(0)" ::: "memory");
    } else {
      XB_SPIN(xb_ld(&bar[XB_XGEN(b.x)]) == gen, bar);
      __builtin_amdgcn_fence(__ATOMIC_ACQUIRE, "agent");
      asm volatile("s_waitcnt vmcnt(0)" ::: "memory");
    }
  }
  __syncthreads();
}

constexpr int NPHASE = 12;
template <int PH>
DI void run_phase(const Params& p, int bid, int nblk, char* smem) {
  if constexpr (PH == 0) phase_prep(p, bid, nblk, smem);
  else if constexpr (PH == 1) phase_gemm1(p, bid, nblk, smem);
  else if constexpr (PH == 2) phase_2a(p, bid, nblk, smem);
  else if constexpr (PH == 3) phase_2b(p, bid, nblk, smem);
  else if constexpr (PH == 4) phase_2c(p, bid, nblk, smem);
  else if constexpr (PH == 5) phase_attn(p, bid, nblk, smem);
  else if constexpr (PH == 6) phase_scan(p, bid, nblk, smem);
  else if constexpr (PH == 7) phase_3c(p, bid, nblk, smem);
  else if constexpr (PH == 8) phase_wo(p, bid, nblk, smem);
  else if constexpr (PH == 9) phase_5(p, bid, nblk, smem);
  else if constexpr (PH == 10) phase_6(p, bid, nblk, smem);
  else if constexpr (PH == 11) { phase_7(p, bid, nblk, smem); }
  else if constexpr (PH == 12) phase_peer_queue<0>(p, bid, nblk, smem);
  else if constexpr (PH == 13) phase_peer_w(p, bid, nblk, smem);
  else phase_peer_queue<1>(p, bid, nblk, smem);
}

constexpr int SMEM_BYTES = 49152;

#if MEGA
__global__ void __launch_bounds__(NTHR, 2) mega_kernel(Params p) {
  __shared__ __attribute__((aligned(16))) char smem[SMEM_BYTES];
  __shared__ uint4 xb_words;
  cg::grid_group grid = cg::this_grid();
  const int bid = blockIdx.x, nblk = gridDim.x;
  if (threadIdx.x == 0) xb_words = make_uint4(0u, 0u, 0u, 0u);
  __syncthreads();
  XcdBarrier xb = xcd_barrier_post((unsigned*)(p.ws + OFF_BAR), (volatile LAS unsigned*)&xb_words);
  run_phase<0>(p, bid, nblk, smem); grid.sync();
  run_phase<1>(p, bid, nblk, smem); xcd_barrier(xb);
  run_phase<2>(p, bid, nblk, smem); xcd_barrier(xb);
  run_phase<3>(p, bid, nblk, smem); xcd_barrier(xb);
  run_phase<4>(p, bid, nblk, smem); xcd_barrier(xb);
  run_phase<5>(p, bid, nblk, smem); xcd_barrier(xb);
  run_phase<6>(p, bid, nblk, smem); xcd_barrier(xb);
  run_phase<7>(p, bid, nblk, smem); xcd_barrier(xb);
  run_phase<8>(p, bid, nblk, smem); xcd_barrier(xb);
  run_phase<9>(p, bid, nblk, smem); xcd_barrier(xb);
  run_phase<10>(p, bid, nblk, smem); xcd_barrier(xb);
  run_phase<11>(p, bid, nblk, smem); xcd_barrier(xb);
  run_phase<12>(p, bid, nblk, smem); xcd_barrier(xb);
  run_phase<13>(p, bid, nblk, smem); xcd_barrier(xb);
  run_phase<14>(p, bid, nblk, smem);
}
#else
template <int PH>
__global__ void __launch_bounds__(NTHR, 2) phase_kernel(Params p) {
  __shared__ __attribute__((aligned(16))) char smem[SMEM_BYTES];
  run_phase<PH>(p, blockIdx.x, gridDim.x, smem);
}
#endif

extern "C" void kernel_launch(void* const* d_in, const int* in_sizes, int n_in, void* d_out, int out_size, void* d_ws,
                              size_t ws_size, hipStream_t stream) {
  Params p{};
  p.x = (const float*)d_in[0]; p.pos = (const int*)d_in[1];
  p.g_mix = (const float*)d_in[2]; p.w_in = (const float*)d_in[3]; p.rwkv_mu = (const float*)d_in[4];
  p.g_cq = (const float*)d_in[5]; p.g_ckv = (const float*)d_in[6]; p.w_uq = (const float*)d_in[7];
  p.w_uk = (const float*)d_in[8]; p.w_uv = (const float*)d_in[9]; p.g_qnorm = (const float*)d_in[10];
  p.g_knorm = (const float*)d_in[11]; p.g_attn_out = (const float*)d_in[12]; p.w0 = (const float*)d_in[13];
  p.w2 = (const float*)d_in[14]; p.a0 = (const float*)d_in[15]; p.a2 = (const float*)d_in[16];
  p.g2 = (const float*)d_in[17]; p.k_k = (const float*)d_in[18]; p.k_a = (const float*)d_in[19];
  p.r_k = (const float*)d_in[20]; p.ln_x_w = (const float*)d_in[21]; p.ln_x_b = (const float*)d_in[22];
  p.w_o = (const float*)d_in[23]; p.g_ffn = (const float*)d_in[24]; p.w_pq = (const float*)d_in[25];
  p.sub_keys = (const float*)d_in[26]; p.expert_u = (const float*)d_in[27]; p.expert_v = (const float*)d_in[28];
  p.out = (float*)d_out; p.ws = (char*)d_ws;
#if MEGA
  static int grid_blocks = 0;
  if (!grid_blocks) {
    int dev = 0, cus = 0, per_cu = 0;
    hipGetDevice(&dev);
    hipDeviceGetAttribute(&cus, hipDeviceAttributeMultiprocessorCount, dev);
    (void)hipOccupancyMaxActiveBlocksPerMultiprocessor(&per_cu, mega_kernel, NTHR, 0);
    if (per_cu > 2) per_cu = 2;
    grid_blocks = cus * per_cu;
  }
  (void)hipMemsetAsync((char*)d_ws + OFF_BAR, 0, 32768, stream);
  void* args[] = {&p};
  hipError_t e = hipLaunchCooperativeKernel((void*)mega_kernel, dim3(grid_blocks), dim3(NTHR), args, 0, stream);
  if (e != hipSuccess) fprintf(stderr, "cooperative launch failed: %s (grid %d)\n", hipGetErrorString(e), grid_blocks);
#else
  const int NB = 512;
  phase_kernel<0><<<NB, NTHR, 0, stream>>>(p);
  phase_kernel<1><<<NB, NTHR, 0, stream>>>(p);
  phase_kernel<2><<<NB, NTHR, 0, stream>>>(p);
  phase_kernel<3><<<NB, NTHR, 0, stream>>>(p);
  phase_kernel<4><<<NB, NTHR, 0, stream>>>(p);
  phase_kernel<5><<<NB, NTHR, 0, stream>>>(p);
  phase_kernel<6><<<NB, NTHR, 0, stream>>>(p);
  phase_kernel<7><<<NB, NTHR, 0, stream>>>(p);
  phase_kernel<8><<<NB, NTHR, 0, stream>>>(p);
  phase_kernel<9><<<NB, NTHR, 0, stream>>>(p);
  phase_kernel<10><<<NB, NTHR, 0, stream>>>(p);
  phase_kernel<11><<<NB, NTHR, 0, stream>>>(p);
  phase_kernel<12><<<NB, NTHR, 0, stream>>>(p);
  phase_kernel<13><<<NB, NTHR, 0, stream>>>(p);
  phase_kernel<14><<<NB, NTHR, 0, stream>>>(p);
#endif
}
```

```cpp
#include <hip/hip_runtime.h>
#include <hip/hip_cooperative_groups.h>
#include <cstdio>
#include <cstdint>
namespace cg = cooperative_groups;

#ifndef MEGA
#define MEGA 1
#endif

typedef unsigned short u16;
using bf16x8 = __attribute__((ext_vector_type(8))) short;
using s16x4  = __attribute__((ext_vector_type(4))) short;
using f32x4  = __attribute__((ext_vector_type(4))) float;
using f32x16 = __attribute__((ext_vector_type(16))) float;
#define DI __device__ __forceinline__

constexpr int T = 32768, SEQ = 2048, DM = 1024;
constexpr int INC = 2464, MLAC = 672, RWC = 1792;
constexpr int NTHR = 512, NW = NTHR / 64;
constexpr float EPS = 1e-6f;

constexpr size_t MiB = 1048576;
constexpr size_t OFF_WINT  = 0;
constexpr size_t OFF_WUQT  = OFF_WINT  + 2560 * 1024 * 2;
constexpr size_t OFF_WUKVT = OFF_WUQT  + 768 * 384 * 2;
constexpr size_t OFF_WLT   = OFF_WUKVT + 1024 * 256 * 2;
constexpr size_t OFF_WOT   = OFF_WLT   + 1536 * 256 * 2;
constexpr size_t OFF_WPQT  = OFF_WOT   + 1024 * 1024 * 2;
constexpr size_t OFF_SUBK  = OFF_WPQT  + 2048 * 1024 * 2;
constexpr size_t OFF_ROPE  = OFF_SUBK  + 16 * 128 * 128 * 2;
constexpr size_t OFF_RSTD1 = OFF_ROPE  + (size_t)T * 32 * 4;
constexpr size_t OFF_RSTDQ = OFF_RSTD1 + (size_t)T * 4;
constexpr size_t OFF_RSTDKV= OFF_RSTDQ + (size_t)T * 4;
constexpr size_t OFF_RSTD2 = OFF_RSTDKV+ (size_t)T * 4;
constexpr size_t OFF_SS2   = OFF_RSTD2 + (size_t)T * 4;
constexpr size_t OFF_A_END = OFF_SS2 + (size_t)T * 8;
static_assert(OFF_A_END <= 19 * MiB, "region A");
constexpr size_t OFF_BAR   = 19 * MiB;
constexpr size_t OFF_QCTR  = OFF_BAR + 16384;
constexpr size_t OFF_XB    = 20 * MiB;
constexpr size_t OFF_Y     = OFF_XB;
constexpr size_t OFF_PM    = 84 * MiB;
constexpr size_t OFF_PR    = 126 * MiB;
constexpr size_t OFF_U     = 366 * MiB;
constexpr size_t OFF_G     = 398 * MiB;
constexpr size_t OFF_KK    = OFF_PR + 64 * MiB;
constexpr size_t OFF_KVRAW = 238 * MiB;
constexpr size_t OFF_QRAW  = 302 * MiB;
constexpr size_t OFF_LORAIN= 350 * MiB;
constexpr size_t OFF_YRAW  = 302 * MiB;
constexpr size_t OFF_RS    = 366 * MiB;
constexpr size_t OFF_KS    = 398 * MiB;
constexpr size_t OFF_VS    = 430 * MiB;
constexpr size_t OFF_BB    = 462 * MiB;
constexpr size_t OFF_EU    = 430 * MiB;
constexpr size_t OFF_EV    = 494 * MiB;
constexpr size_t OFF_X2B   = 148 * MiB;
constexpr size_t OFF_QP    = 238 * MiB;
constexpr size_t OFF_IDX   = 20 * MiB;
constexpr size_t OFF_GATE  = 28 * MiB;
constexpr size_t OFF_WGT   = 44 * MiB;
constexpr size_t OFF_PART  = 238 * MiB;
constexpr int NSL = 8;
constexpr float SV8 = 16.f;
constexpr float SUI = 677.f;
constexpr float SXI = 127.f / 6.f;
constexpr size_t OFF_X2Q   = 366 * MiB;
constexpr size_t DO_Q = 0, DO_K = (size_t)T * 768 * 2, DO_AA = (size_t)T * 768 * 4;

struct Params {
  const float* x; const int* pos;
  const float *g_mix, *w_in, *rwkv_mu, *g_cq, *g_ckv, *w_uq, *w_uk, *w_uv, *g_qnorm, *g_knorm, *g_attn_out;
  const float *w0, *w2, *a0, *a2, *g2, *k_k, *k_a, *r_k, *ln_x_w, *ln_x_b, *w_o, *g_ffn, *w_pq, *sub_keys, *expert_u, *expert_v;
  float* out; char* ws;
};

DI u16 f2bf(float x) { unsigned u = __float_as_uint(x); u += 0x7fffu + ((u >> 16) & 1u); return (u16)(u >> 16); }
DI float bf2f(u16 h) { return __uint_as_float(((unsigned)h) << 16); }
DI unsigned pack2(float a, float b) { return (unsigned)f2bf(a) | ((unsigned)f2bf(b) << 16); }
DI float bflo(unsigned u) { return __uint_as_float(u << 16); }
DI float bfhi(unsigned u) { return __uint_as_float(u & 0xffff0000u); }
DI float wave_sum_u(float v);
DI float wave_allsum(float v) { return wave_sum_u(v); }
DI int tid_() { int t = threadIdx.x; asm volatile("" : "+v"(t)); return t; }
constexpr float SS2_SCALE = 1048576.f;
DI float ss2_get(const unsigned long long* ss2, int row) { return (float)ss2[row] * (1.f / SS2_SCALE); }
DI float sigmoidf_(float x) { return 1.f / (1.f + __expf(-x)); }

template <int N> DI float dpp_ror(float v) {
  return __builtin_bit_cast(float, __builtin_amdgcn_update_dpp(0, __builtin_bit_cast(int, v), 0x120 + N, 0xF, 0xF, false));
}
template <int CTRL> DI float dpp_mov(float v) {
  return __builtin_bit_cast(float, __builtin_amdgcn_update_dpp(0, __builtin_bit_cast(int, v), CTRL, 0xF, 0xF, false));
}
#define RS8_STEP(arr, n, bit, CTRL) _Pragma("unroll") for (int _j = 0; _j < (n); ++_j) { \
    const bool _hi = (k8 & (bit)) != 0; const float _keep = _hi ? arr[_j + (n)] : arr[_j], _send = _hi ? arr[_j] : arr[_j + (n)]; \
    arr[_j] = _keep + dpp_mov<CTRL>(_send); }
DI void row16_allsum2(float& a, float& b) {
  asm volatile(
      "s_nop 1\n\t"
      "v_add_f32_dpp %0, %0, %0 row_ror:8 row_mask:0xf bank_mask:0xf bound_ctrl:1\n\t"
      "v_add_f32_dpp %1, %1, %1 row_ror:8 row_mask:0xf bank_mask:0xf bound_ctrl:1\n\t"
      "s_nop 0\n\t"
      "v_add_f32_dpp %0, %0, %0 row_ror:4 row_mask:0xf bank_mask:0xf bound_ctrl:1\n\t"
      "v_add_f32_dpp %1, %1, %1 row_ror:4 row_mask:0xf bank_mask:0xf bound_ctrl:1\n\t"
      "s_nop 0\n\t"
      "v_add_f32_dpp %0, %0, %0 row_ror:2 row_mask:0xf bank_mask:0xf bound_ctrl:1\n\t"
      "v_add_f32_dpp %1, %1, %1 row_ror:2 row_mask:0xf bank_mask:0xf bound_ctrl:1\n\t"
      "s_nop 0\n\t"
      "v_add_f32_dpp %0, %0, %0 row_ror:1 row_mask:0xf bank_mask:0xf bound_ctrl:1\n\t"
      "v_add_f32_dpp %1, %1, %1 row_ror:1 row_mask:0xf bank_mask:0xf bound_ctrl:1\n\t"
      "s_nop 1"
      : "+v"(a), "+v"(b));
}
DI float row16_allsum(float v);
DI float wave_sum_u(float v) {
  v = row16_allsum(v);
  const int vi = __float_as_int(v);
  return __int_as_float(__builtin_amdgcn_readlane(vi, 0)) + __int_as_float(__builtin_amdgcn_readlane(vi, 16)) +
         __int_as_float(__builtin_amdgcn_readlane(vi, 32)) + __int_as_float(__builtin_amdgcn_readlane(vi, 48));
}
DI float row16_allsum(float v) {
  v += dpp_ror<8>(v); v += dpp_ror<4>(v); v += dpp_ror<2>(v); v += dpp_ror<1>(v);
  return v;
}
DI void row8_allsum2(float& a, float& b) {
  asm volatile(
      "s_nop 1\n\t"
      "v_add_f32_dpp %0, %0, %0 row_half_mirror row_mask:0xf bank_mask:0xf bound_ctrl:1\n\t"
      "v_add_f32_dpp %1, %1, %1 row_half_mirror row_mask:0xf bank_mask:0xf bound_ctrl:1\n\t"
      "s_nop 0\n\t"
      "v_add_f32_dpp %0, %0, %0 quad_perm:[2,3,0,1] row_mask:0xf bank_mask:0xf bound_ctrl:1\n\t"
      "v_add_f32_dpp %1, %1, %1 quad_perm:[2,3,0,1] row_mask:0xf bank_mask:0xf bound_ctrl:1\n\t"
      "s_nop 0\n\t"
      "v_add_f32_dpp %0, %0, %0 quad_perm:[1,0,3,2] row_mask:0xf bank_mask:0xf bound_ctrl:1\n\t"
      "v_add_f32_dpp %1, %1, %1 quad_perm:[1,0,3,2] row_mask:0xf bank_mask:0xf bound_ctrl:1\n\t"
      "s_nop 1"
      : "+v"(a), "+v"(b));
}
DI float row8_allsum(float v) {
  v += dpp_mov<0x141>(v); v += dpp_mov<0x4E>(v); v += dpp_mov<0xB1>(v);
  return v;
}


DI void tconv(const float* __restrict__ src, int K, int N, const float* __restrict__ scale, u16* __restrict__ dst,
              int ldd, int noff, int bid, int nblk, float* tile) {
  const int tid = tid_(), tx = tid & 31, ty = tid >> 5;
  const int nbn = N / 32, ntl = (K / 32) * nbn;
  for (int tl = bid; tl < ntl; tl += nblk) {
    const int kb = tl / nbn, nb = tl % nbn;
#pragma unroll
    for (int i = 0; i < 2; ++i) {
      const int k = kb * 32 + ty + 16 * i;
      float v = src[(size_t)k * N + nb * 32 + tx];
      if (scale) v *= scale[k];
      tile[(ty + 16 * i) * 33 + tx] = v;
    }
    __syncthreads();
#pragma unroll
    for (int i = 0; i < 2; ++i) {
      const int n = nb * 32 + ty + 16 * i;
      dst[(size_t)(noff + n) * ldd + kb * 32 + tx] = f2bf(tile[tx * 33 + ty + 16 * i]);
    }
    __syncthreads();
  }
}

DI void phase_prep(const Params& p, int bid, int nblk, char* smem) {
  float* tile = (float*)smem;
  char* ws = p.ws;
  const int tid = tid_();
  tconv(p.w_in, 1024, INC, p.g_mix, (u16*)(ws + OFF_WINT), 1024, 0, bid, nblk, tile);
  for (int i = bid * NTHR + tid; i < 96 * 1024; i += nblk * NTHR) ((u16*)(ws + OFF_WINT))[2464 * 1024 + i] = 0;
  tconv(p.w_uq, 384, 768, p.g_cq, (u16*)(ws + OFF_WUQT), 384, 0, bid, nblk, tile);
  tconv(p.w_uk, 256, 512, p.g_ckv, (u16*)(ws + OFF_WUKVT), 256, 0, bid, nblk, tile);
  tconv(p.w_uv, 256, 512, p.g_ckv, (u16*)(ws + OFF_WUKVT), 256, 512, bid, nblk, tile);
  for (int i = bid * NTHR + tid; i < 1536 * 256; i += nblk * NTHR) {
    const int n = i >> 8, k = i & 255;
    float v = 0.f;
    if (n < 512) { if (k < 64) v = p.w2[k * 512 + n]; }
    else if (n < 1024) { if (k >= 64 && k < 128) v = p.a2[(k - 64) * 512 + (n - 512)]; }
    else { if (k >= 128) v = p.g2[(k - 128) * 512 + (n - 1024)]; }
    ((u16*)(ws + OFF_WLT))[i] = f2bf(v);
  }
  tconv(p.w_o, 1024, 1024, nullptr, (u16*)(ws + OFF_WOT), 1024, 0, bid, nblk, tile);
  tconv(p.w_pq, 1024, 2048, p.g_ffn, (u16*)(ws + OFF_WPQT), 1024, 0, bid, nblk, tile);
  for (int i = bid * NTHR + tid; i < T; i += nblk * NTHR) ((unsigned long long*)(ws + OFF_SS2))[i] = 0ull;
  for (int i = bid * NTHR + tid; i < 16 * 128 * 128; i += nblk * NTHR) ((u16*)(ws + OFF_SUBK))[i] = f2bf(p.sub_keys[i]);
  for (int i = bid * NTHR + tid; i < T * 16; i += nblk * NTHR) {
    const int t = i >> 4, j = i & 15;
    const float inv = powf(10000.0f, -(float)j / 16.0f);
    const float ang = (float)p.pos[t] * inv;
    float s, c; sincosf(ang, &s, &c);
    float* rp = (float*)(ws + OFF_ROPE) + (size_t)t * 32;
    rp[j] = c; rp[16 + j] = s;
  }
  const int wid = tid >> 6, lane = tid & 63;
  for (int row = 2 * (bid * NW + wid); row < T; row += 2 * nblk * NW) {
    const float4* xr = (const float4*)(p.x + (size_t)row * DM);
    uint2* xb = (uint2*)(ws + OFF_XB + (size_t)row * DM * 2);
    float4 v[8];
#pragma unroll
    for (int i = 0; i < 8; ++i) v[i] = xr[lane + 64 * i];
    float ss0 = 0.f, ss1 = 0.f;
#pragma unroll
    for (int i = 0; i < 8; ++i) {
      const float s = v[i].x * v[i].x + v[i].y * v[i].y + v[i].z * v[i].z + v[i].w * v[i].w;
      if (i < 4) ss0 += s; else ss1 += s;
      xb[lane + 64 * i] = make_uint2(pack2(v[i].x, v[i].y), pack2(v[i].z, v[i].w));
    }
    ss0 = wave_sum_u(ss0); ss1 = wave_sum_u(ss1);
    if (lane == 0) {
      ((float*)(ws + OFF_RSTD1))[row] = rsqrtf(ss0 * (1.f / DM) + EPS);
      ((float*)(ws + OFF_RSTD1))[row + 1] = rsqrtf(ss1 * (1.f / DM) + EPS);
    }
  }
}

namespace pg8 {
#define PG8_LAS __attribute__((address_space(3)))
typedef unsigned short bf16_t;
typedef short bf16x8 __attribute__((ext_vector_type(8)));
typedef float f32x4 __attribute__((ext_vector_type(4)));
typedef unsigned u32x4 __attribute__((ext_vector_type(4)));
constexpr int BM = 256, BK = 64, HALF = 128, HTB = HALF * BK * 2  , STAGE_BYTES = 8 * HTB, NXCD = 8, WGM = 8;

__host__ __device__ __forceinline__ int lds_byte(int r, int c) { const int st = (r >> 4) * 2 + (c >> 5), rr = r & 15, cc = c & 31, ob = rr * 64 + cc * 2; return st * 1024 + (ob ^ (((ob >> 9) & 1) << 5)); }
__host__ __device__ __forceinline__ void stage_rc(int b, int& R, int& C) { const int st = b / 1024, sb = b % 1024, swz = sb ^ (((sb >> 9) & 1) << 5); R = (st >> 1) * 16 + swz / 64; C = (st & 1) * 32 + (swz % 64) / 2; }
__host__ __device__ __forceinline__ int perm32(int rho) { const int n = rho >> 4, i = rho & 15; return 8 * (i >> 2) + 4 * n + (i & 3); }

struct Unit { int pm, pn; };
struct Gemm { const bf16_t* A; const bf16_t* Bt; int M, N, K, lda, ldb; };

struct StaticOrder {
    int nM, nN, nwg, G, c;
    __host__ __device__ void init(int M, int N, int G_, int c_) { nM = M / BM; nN = N / BM; nwg = nM * nN; G = G_; c = c_; }
    __host__ __device__ bool next(int i, Unit& u) const {
        const long L = (long)i * G + c; if (L >= nwg) return false;
        int wgid = (int)L; { const int q = nwg / NXCD, r = nwg % NXCD, xcd = wgid % NXCD, off = wgid / NXCD; wgid = (xcd < r ? xcd * (q + 1) : r * (q + 1) + (xcd - r) * q) + off; }
        const int nig = WGM * nN, gid = wgid / nig, fm = gid * WGM, gsz = (nM - fm) < WGM ? (nM - fm) : WGM;
        u.pm = fm + ((wgid % nig) % gsz); u.pn = (wgid % nig) / gsz; return true;
    }
    __device__ __forceinline__ void a_ready(const Unit&) const {}
    __device__ __forceinline__ void done(const Unit&) const {}
};
__device__ __forceinline__ unsigned cvt_pk_bf16(float lo, float hi) { unsigned r; asm volatile("v_cvt_pk_bf16_f32 %0, %1, %2" : "=v"(r) : "v"(lo), "v"(hi)); return r; }
template <class Epi, class Sched, bool STAMP = false>
__device__ __forceinline__ void gemm_phase(PG8_LAS unsigned char* lds, const Gemm g, const Sched& S, const Epi& E, unsigned long long* stamps) {
    const int tid = tid_(), wid = __builtin_amdgcn_readfirstlane(tid >> 6), lane = tid & 63, wr = wid >> 2, wc = wid & 3, fr = lane & 15, fq = lane >> 4;
    const int K = g.K, nt = K / BK;
    int ts_lo = 0, ts_hi = 0, nts = 0; const unsigned long long rt_entry = STAMP ? (unsigned long long)wall_clock64() : 0ull;
#define PG8_STAMP() do { if (STAMP && wid == 0 && nts < 64) { const unsigned long long _c = (unsigned long long)clock64(); \
        ts_lo = (lane == nts) ? (int)(unsigned)_c : ts_lo; ts_hi = (lane == nts) ? (int)(unsigned)(_c >> 32) : ts_hi; ++nts; } } while (0)
    PG8_STAMP();
    unsigned voffA[2], voffB[2];
#pragma unroll
    for (int i = 0; i < 2; ++i) { int R, C; stage_rc(tid * 16 + i * 8192, R, C); const int Rb = Epi::PERM ? ((R & ~31) + perm32(R & 31)) : R;
        voffA[i] = (unsigned)(R * g.lda + C) * 2u; voffB[i] = (unsigned)(Rb * g.ldb + C) * 2u; }
    const size_t kstep = (size_t)(BK * 2);
    const size_t hstepA = (size_t)HALF * g.lda * 2, hstepB = (size_t)HALF * g.ldb * 2;
    const size_t tstepA = 2 * hstepA, tstepB = 2 * hstepB;
    const unsigned ldsw = (unsigned)wid * 1024u;
    const int aoff = lds_byte(wr * 64 + fr, fq * 8), boff = lds_byte(wc * 32 + fr, fq * 8);
#define PG8_SA(b, h) (((b) * 2 + (h)) * HTB)
#define PG8_SB(b, h) ((4 + (b) * 2 + (h)) * HTB)
#define PG8_STAGE(bufoff, gbase, voff) do { _Pragma("unroll") for (int _i = 0; _i < 2; ++_i) \
        __builtin_amdgcn_global_load_lds((const unsigned*)((const char*)(gbase) + (voff)[_i]), (PG8_LAS unsigned*)(lds + (bufoff) + ldsw + _i * 8192), 16, 0, 0); } while (0)
#define PG8_LDA(dst, b, h) do { _Pragma("unroll") for (int m = 0; m < 4; ++m) _Pragma("unroll") for (int k = 0; k < 2; ++k) dst[m][k] = *(const PG8_LAS bf16x8*)(lds + PG8_SA(b, h) + aoff + m * 2048 + k * 1024); } while (0)
#define PG8_LDB(dst, b, h) do { _Pragma("unroll") for (int n = 0; n < 2; ++n) _Pragma("unroll") for (int k = 0; k < 2; ++k) dst[n][k] = *(const PG8_LAS bf16x8*)(lds + PG8_SB(b, h) + boff + n * 2048 + k * 1024); } while (0)
#define PG8_MMA(ai, bj, At, Bt) do { __builtin_amdgcn_s_setprio(1); _Pragma("unroll") for (int m = 0; m < 4; ++m) _Pragma("unroll") for (int n = 0; n < 2; ++n) _Pragma("unroll") for (int k = 0; k < 2; ++k) \
        acc[ai][bj][m][n] = __builtin_amdgcn_mfma_f32_16x16x32_bf16(Bt[n][k], At[m][k], acc[ai][bj][m][n], 0, 0, 0); __builtin_amdgcn_s_setprio(0); } while (0)
#define PG8_WAIT_V(n) asm volatile("s_waitcnt vmcnt(" #n ")" ::: "memory")
#define PG8_WAIT_L(n) asm volatile("s_waitcnt lgkmcnt(" #n ")" ::: "memory")
#define PG8_BAR __builtin_amdgcn_s_barrier()
#define PG8_SCHED __builtin_amdgcn_sched_barrier(0)
    Unit cur, nxt; int ui = 0;
    if (!S.next(0, cur)) return;
    f32x4 acc[2][2][4][2];
#pragma unroll
    for (int a = 0; a < 2; ++a)
#pragma unroll
        for (int b = 0; b < 2; ++b)
#pragma unroll
            for (int m = 0; m < 4; ++m)
#pragma unroll
                for (int n = 0; n < 2; ++n) acc[a][b][m][n] = (f32x4){0.f, 0.f, 0.f, 0.f};
    bf16x8 At[4][2], B0[2][2], B1[2][2];
    const char* cA = (const char*)g.A + (size_t)cur.pm * tstepA; const char* cB = (const char*)g.Bt + (size_t)cur.pn * tstepB;
    S.a_ready(cur);
    PG8_STAGE(PG8_SB(0, 0), cB, voffB); PG8_STAGE(PG8_SA(0, 0), cA, voffA); PG8_STAGE(PG8_SB(0, 1), cB + hstepB, voffB); PG8_STAGE(PG8_SA(0, 1), cA + hstepA, voffA);
    if (wr == 1) PG8_BAR;
    PG8_WAIT_V(4); PG8_BAR;
    PG8_STAGE(PG8_SB(1, 0), cB + kstep, voffB); PG8_STAGE(PG8_SA(1, 0), cA + kstep, voffA); PG8_STAGE(PG8_SB(1, 1), cB + hstepB + kstep, voffB);
    PG8_WAIT_V(6); PG8_BAR;
    PG8_STAMP();
    for (;;) {
        const bool has_next = S.next(ui + 1, nxt);
        const char* nA = has_next ? (const char*)g.A + (size_t)nxt.pm * tstepA : cA; const char* nB = has_next ? (const char*)g.Bt + (size_t)nxt.pn * tstepB : cB;
        for (int t = 0; t < nt; t += 2) {
            const bool last = (t == nt - 2);
            const char* a1 = cA + (size_t)(t + 1) * kstep;
            const char* a2 = last ? nA : cA + (size_t)(t + 2) * kstep; const char* b2 = last ? nB : cB + (size_t)(t + 2) * kstep;
            const char* a3 = a2 + kstep; const char* b3 = b2 + kstep;
            if (last && has_next) S.a_ready(nxt);
            PG8_LDB(B0, 0, 0); PG8_SCHED; PG8_LDA(At, 0, 0); PG8_STAGE(PG8_SA(1, 1), a1 + hstepA, voffA);
            PG8_WAIT_L(8); PG8_BAR; PG8_WAIT_L(0); PG8_MMA(0, 0, At, B0); PG8_BAR; PG8_SCHED;
            PG8_LDB(B1, 0, 1); PG8_STAGE(PG8_SB(0, 0), b2, voffB);
            PG8_BAR; PG8_WAIT_L(0); PG8_MMA(0, 1, At, B1); PG8_BAR;
            PG8_LDA(At, 0, 1); PG8_STAGE(PG8_SA(0, 0), a2, voffA);
            PG8_BAR; PG8_WAIT_L(0); PG8_MMA(1, 0, At, B0); PG8_BAR; PG8_SCHED;
            PG8_STAGE(PG8_SB(0, 1), b2 + hstepB, voffB);
            PG8_WAIT_V(6); PG8_BAR; PG8_MMA(1, 1, At, B1); PG8_BAR;
            PG8_LDB(B0, 1, 0); PG8_SCHED; PG8_LDA(At, 1, 0); PG8_STAGE(PG8_SA(0, 1), a2 + hstepA, voffA);
            PG8_WAIT_L(8); PG8_BAR; PG8_WAIT_L(0); PG8_MMA(0, 0, At, B0); PG8_BAR; PG8_SCHED;
            PG8_LDB(B1, 1, 1); PG8_STAGE(PG8_SB(1, 0), b3, voffB);
            PG8_BAR; PG8_WAIT_L(0); PG8_MMA(0, 1, At, B1); PG8_BAR;
            PG8_LDA(At, 1, 1); PG8_STAGE(PG8_SA(1, 0), a3, voffA);
            PG8_BAR; PG8_WAIT_L(0); PG8_MMA(1, 0, At, B0); PG8_BAR; PG8_SCHED;
            PG8_STAGE(PG8_SB(1, 1), b3 + hstepB, voffB);
            PG8_WAIT_V(6); PG8_BAR; PG8_MMA(1, 1, At, B1); PG8_BAR;
        }
        PG8_STAMP();
        if constexpr (!Epi::AFTER_DRAIN) { E(acc, cur, wr, wc, fr, fq); S.done(cur); }
        PG8_STAMP();
        if (!has_next) break;
#pragma unroll
        for (int a = 0; a < 2; ++a)
#pragma unroll
            for (int b = 0; b < 2; ++b)
#pragma unroll
                for (int m = 0; m < 4; ++m)
#pragma unroll
                    for (int n = 0; n < 2; ++n) acc[a][b][m][n] = (f32x4){0.f, 0.f, 0.f, 0.f};
        cur = nxt; cA = nA; cB = nB; ++ui;
    }
    PG8_WAIT_V(0);
    if (wr == 0) PG8_BAR;
    PG8_BAR;
    if constexpr (Epi::AFTER_DRAIN) { E.fused(acc, cur, wr, wc, fr, fq, lds, wid, lane); S.done(cur); }
    PG8_STAMP();
    if (STAMP && wid == 0) { stamps[lane] = lane < nts ? (((unsigned long long)(unsigned)ts_hi << 32) | (unsigned)ts_lo) : 0ull;
        if (lane == 62) stamps[62] = rt_entry; if (lane == 63) stamps[63] = (unsigned long long)wall_clock64(); }
#undef PG8_STAMP
#undef PG8_SA
#undef PG8_SB
#undef PG8_STAGE
#undef PG8_LDA
#undef PG8_LDB
#undef PG8_MMA
#undef PG8_WAIT_V
#undef PG8_WAIT_L
#undef PG8_BAR
#undef PG8_SCHED
}
}

using pg8::cvt_pk_bf16;
struct EpiP {
  static constexpr bool PERM = true, AFTER_DRAIN = false;
  u16* PM; u16* PR; const float* rstd;
  DI void operator()(const pg8::f32x4 (&acc)[2][2][4][2], const pg8::Unit& u, int wr, int wc, int fr, int fq) const {
    const int row0 = u.pm * 256 + wr * 64 + fr, col0 = u.pn * 256 + wc * 32 + 8 * fq;
#pragma unroll
    for (int ai = 0; ai < 2; ++ai)
#pragma unroll
      for (int m = 0; m < 4; ++m) {
        const int r = row0 + ai * 128 + m * 16;
        const float rs = rstd[r];
#pragma unroll
        for (int bj = 0; bj < 2; ++bj) {
          const int c = col0 + bj * 128;
          const pg8::f32x4 v0 = acc[ai][bj][m][0] * rs, v1 = acc[ai][bj][m][1] * rs;
          const uint4 w = make_uint4(cvt_pk_bf16(v0[0], v0[1]), cvt_pk_bf16(v0[2], v0[3]), cvt_pk_bf16(v1[0], v1[1]), cvt_pk_bf16(v1[2], v1[3]));
          if (c < MLAC) *(uint4*)(PM + (size_t)r * MLAC + c) = w;
          else if (c < INC) *(uint4*)(PR + (size_t)r * RWC + (c - MLAC)) = w;
        }
      }
  }
};
template <bool FROM_SS>
struct EpiRowScaleT {
  static constexpr bool PERM = true, AFTER_DRAIN = false;
  u16* O; int ldc; const float* rstd;
  DI void operator()(const pg8::f32x4 (&acc)[2][2][4][2], const pg8::Unit& u, int wr, int wc, int fr, int fq) const {
    const int row0 = u.pm * 256 + wr * 64 + fr, col0 = u.pn * 256 + wc * 32 + 8 * fq;
#pragma unroll
    for (int ai = 0; ai < 2; ++ai)
#pragma unroll
      for (int m = 0; m < 4; ++m) {
        const int r = row0 + ai * 128 + m * 16;
        const float rs = FROM_SS ? rsqrtf(ss2_get((const unsigned long long*)rstd, r) * (1.f / DM) + EPS) : rstd[r];
#pragma unroll
        for (int bj = 0; bj < 2; ++bj) {
          const pg8::f32x4 v0 = acc[ai][bj][m][0] * rs, v1 = acc[ai][bj][m][1] * rs;
          *(uint4*)(O + (size_t)r * ldc + col0 + bj * 128) =
              make_uint4(cvt_pk_bf16(v0[0], v0[1]), cvt_pk_bf16(v0[2], v0[3]), cvt_pk_bf16(v1[0], v1[1]), cvt_pk_bf16(v1[2], v1[3]));
        }
      }
  }
};
DI unsigned pack2h(float a, float b) {
  return (unsigned)__builtin_bit_cast(unsigned short, (_Float16)a) | ((unsigned)__builtin_bit_cast(unsigned short, (_Float16)b) << 16);
}
DI float h2f_lo(unsigned u) { return (float)__builtin_bit_cast(_Float16, (unsigned short)(u & 0xffffu)); }
DI float h2f_hi(unsigned u) { return (float)__builtin_bit_cast(_Float16, (unsigned short)(u >> 16)); }
using EpiRowScale = EpiRowScaleT<false>;
struct EpiLora {
  static constexpr bool PERM = true, AFTER_DRAIN = false;
  u16* U; u16* AA; u16* G; const float* w0; const float* a0;
  template <int KIND>
  DI void body(const pg8::f32x4 (&acc)[2][2][4][2], const pg8::Unit& u, int wr, int wc, int fr, int fq) const {
    const int row0 = u.pm * 256 + wr * 64 + fr, col0 = u.pn * 256 + wc * 32 + 8 * fq;
    u16* O = KIND == 0 ? U : KIND == 1 ? AA : G;
#pragma unroll
    for (int bj = 0; bj < 2; ++bj) {
      const int c = (col0 + bj * 128) & 511;
      pg8::f32x4 b0 = {0.f, 0.f, 0.f, 0.f}, b1 = {0.f, 0.f, 0.f, 0.f};
      if (KIND == 0) { b0 = *(const pg8::f32x4*)(w0 + c); b1 = *(const pg8::f32x4*)(w0 + c + 4); }
      if (KIND == 1) { b0 = *(const pg8::f32x4*)(a0 + c); b1 = *(const pg8::f32x4*)(a0 + c + 4); }
#pragma unroll
      for (int ai = 0; ai < 2; ++ai)
#pragma unroll
        for (int m = 0; m < 4; ++m) {
          const int r = row0 + ai * 128 + m * 16;
          const pg8::f32x4 v0 = acc[ai][bj][m][0] + b0, v1 = acc[ai][bj][m][1] + b1;
          uint4 w;
          if (KIND == 0) w = make_uint4(pack2h(v0[0], v0[1]), pack2h(v0[2], v0[3]), pack2h(v1[0], v1[1]), pack2h(v1[2], v1[3]));
          else w = make_uint4(cvt_pk_bf16(v0[0], v0[1]), cvt_pk_bf16(v0[2], v0[3]), cvt_pk_bf16(v1[0], v1[1]), cvt_pk_bf16(v1[2], v1[3]));
          *(uint4*)(O + (size_t)r * 512 + c) = w;
        }
    }
  }
  DI void operator()(const pg8::f32x4 (&acc)[2][2][4][2], const pg8::Unit& u, int wr, int wc, int fr, int fq) const {
    const int kind = u.pn >> 1;
    if (kind == 0) body<0>(acc, u, wr, wc, fr, fq);
    else if (kind == 1) body<1>(acc, u, wr, wc, fr, fq);
    else body<2>(acc, u, wr, wc, fr, fq);
  }
};
struct EpiWo {
  static constexpr bool PERM = false, AFTER_DRAIN = false;
  float* out; const float* x; u16* x2b; unsigned long long* ss2;
  DI void operator()(const pg8::f32x4 (&acc)[2][2][4][2], const pg8::Unit& u, int wr, int wc, int fr, int fq) const {
    const int row0 = u.pm * 256 + wr * 64 + fr, col0 = u.pn * 256 + wc * 32 + 4 * fq;
#pragma unroll
    for (int ai = 0; ai < 2; ++ai)
#pragma unroll
      for (int m = 0; m < 4; ++m) {
        const int r = row0 + ai * 128 + m * 16;
        const size_t ro = (size_t)r * DM + col0;
        float ss = 0.f;
#pragma unroll
        for (int bj = 0; bj < 2; ++bj)
#pragma unroll
          for (int n = 0; n < 2; ++n) {
            const pg8::f32x4 xv = *(const pg8::f32x4*)(x + ro + bj * 128 + n * 16);
            const pg8::f32x4 o = xv + acc[ai][bj][m][n];
            *(uint2*)(x2b + ro + bj * 128 + n * 16) = make_uint2(cvt_pk_bf16(o[0], o[1]), cvt_pk_bf16(o[2], o[3]));
            ss += o[0] * o[0] + o[1] * o[1] + o[2] * o[2] + o[3] * o[3];
          }
        ss += __shfl_xor(ss, 16); ss += __shfl_xor(ss, 32);
        if (fq == 0) atomicAdd(ss2 + r, (unsigned long long)(ss * SS2_SCALE + 0.5f));
      }
  }
};
template <class Epi>
DI void run_gemm(const u16* A, int lda, const u16* Bt, int ldb, int M, int N, int K, const Epi& E, int bid, int nblk, char* smem) {
  pg8::Gemm g; g.A = A; g.Bt = Bt; g.M = M; g.N = N; g.K = K; g.lda = lda; g.ldb = ldb;
  pg8::StaticOrder S; S.init(M, N, nblk, bid);
  __syncthreads();
  pg8::gemm_phase<Epi, pg8::StaticOrder, false>((PG8_LAS unsigned char*)smem, g, S, E, nullptr);
  __syncthreads();
}

DI void phase_gemm1(const Params& p, int bid, int nblk, char* smem) {
  char* ws = p.ws;
  EpiP E; E.PM = (u16*)(ws + OFF_PM); E.PR = (u16*)(ws + OFF_PR); E.rstd = (const float*)(ws + OFF_RSTD1);
  run_gemm((const u16*)(ws + OFF_XB), 1024, (const u16*)(ws + OFF_WINT), 1024, T, 2560, 1024, E, bid, nblk, smem);
}

DI void unpack8(const uint4& r, float (&v)[8]) {
  v[0] = bflo(r.x); v[1] = bfhi(r.x); v[2] = bflo(r.y); v[3] = bfhi(r.y); v[4] = bflo(r.z); v[5] = bfhi(r.z); v[6] = bflo(r.w); v[7] = bfhi(r.w);
}
DI uint4 pack8(const float (&v)[8]) { return make_uint4(pack2(v[0], v[1]), pack2(v[2], v[3]), pack2(v[4], v[5]), pack2(v[6], v[7])); }
DI float sumsq8(const uint4& r) { float v[8]; unpack8(r, v); float s = 0.f;
#pragma unroll
  for (int i = 0; i < 8; ++i) s += v[i] * v[i];
  return s; }
DI void phase_2a(const Params& p, int bid, int nblk, char* smem) {
  char* ws = p.ws;
  const u16* PM = (const u16*)(ws + OFF_PM);
  const u16* PR = (const u16*)(ws + OFF_PR);
  u16* LI = (u16*)(ws + OFF_LORAIN);
  const int tid = tid_(), wid = tid >> 6, lane = tid & 63;
  float mu[8];
#pragma unroll
  for (int j = 0; j < 8; ++j) mu[j] = lane < 32 ? p.rwkv_mu[1536 + 8 * lane + j] : 0.f;
  const uint4 zero4 = make_uint4(0u, 0u, 0u, 0u);
#define LD_PR(t_, r3) do { r3 = zero4; if (lane < 32) r3 = *(const uint4*)(PR + (size_t)(t_) * RWC + 1536 + 8 * lane); } while (0)
#define LD_PM(t_, a_, b_) do { a_ = *(const uint4*)(PM + (size_t)(t_) * MLAC + 8 * lane); \
    b_ = zero4; if (lane < 16) b_ = *(const uint4*)(PM + (size_t)(t_) * MLAC + 512 + 8 * lane); } while (0)
  for (int run = bid * NW + wid; run < T / 16; run += nblk * NW) {
    const int t0 = run * 16;
    uint4 p3 = zero4, c3, n3 = zero4, pa, pb, pan = zero4, pbn = zero4;
    if ((t0 % SEQ) != 0) LD_PR(t0 - 1, p3);
    LD_PR(t0, c3); LD_PM(t0, pa, pb);
    for (int tt = 0; tt < 16; ++tt) {
      const int t = t0 + tt;
      if (tt < 15) { LD_PR(t + 1, n3); LD_PM(t + 1, pan, pbn); }
      {
        const float sa = sumsq8(pa);
        float sq = lane < 48 ? sa : 0.f, skv = lane < 48 ? 0.f : sa;
        skv += sumsq8(pb);
        sq = wave_sum_u(sq); skv = wave_sum_u(skv);
        if (lane == 0) {
          ((float*)(ws + OFF_RSTDQ))[t] = rsqrtf(sq * (1.f / 384.f) + EPS);
          ((float*)(ws + OFF_RSTDKV))[t] = rsqrtf(skv * (1.f / 256.f) + EPS);
        }
      }
      if (lane < 32) {
        float cv[8], pv[8], o[8];
        unpack8(c3, cv); unpack8(p3, pv);
#pragma unroll
        for (int j = 0; j < 8; ++j) o[j] = cv[j] + (pv[j] - cv[j]) * mu[j];
        if (lane < 8) {
#pragma unroll
          for (int j = 0; j < 8; ++j) o[j] = tanhf(o[j]);
        } else if (lane >= 16) {
#pragma unroll
          for (int j = 0; j < 8; ++j) o[j] = sigmoidf_(o[j]);
        }
        *(uint4*)(LI + (size_t)t * 256 + 8 * lane) = pack8(o);
      }
      p3 = c3; c3 = n3; pa = pan; pb = pbn;
    }
  }
#undef LD_PR
#undef LD_PM
}

DI void phase_2b(const Params& p, int bid, int nblk, char* smem) {
  char* ws = p.ws;
  const u16* PM = (const u16*)(ws + OFF_PM);
  { EpiRowScale E; E.O = (u16*)(ws + OFF_QRAW); E.ldc = 768; E.rstd = (const float*)(ws + OFF_RSTDQ);
    run_gemm(PM, MLAC, (const u16*)(ws + OFF_WUQT), 384, T, 768, 384, E, bid, nblk, smem); }
  { EpiRowScale E; E.O = (u16*)(ws + OFF_KVRAW); E.ldc = 1024; E.rstd = (const float*)(ws + OFF_RSTDKV);
    run_gemm(PM + 384, MLAC, (const u16*)(ws + OFF_WUKVT), 256, T, 1024, 256, E, (bid + 128) % nblk, nblk, smem); }
  { EpiLora E; E.U = (u16*)(ws + OFF_U); E.AA = (u16*)((char*)p.out + DO_AA); E.G = (u16*)(ws + OFF_G); E.w0 = p.w0; E.a0 = p.a0;
    run_gemm((const u16*)(ws + OFF_LORAIN), 256, (const u16*)(ws + OFF_WLT), 256, T, 1536, 256, E, bid, nblk, smem); }
}

DI void mla_finalize_head(const Params& p, int b, int h) {
  char* ws = p.ws;
  const u16* PM = (const u16*)(ws + OFF_PM);
  const u16* QRAW = (const u16*)(ws + OFF_QRAW);
  const u16* KVRAW = (const u16*)(ws + OFF_KVRAW);
  u16* Q = (u16*)((char*)p.out + DO_Q); u16* Kd = (u16*)((char*)p.out + DO_K);
  const float* rope = (const float*)(ws + OFF_ROPE);
  const int tid = tid_(), wid = tid >> 6, lane = tid & 63;
  const float QSCALE = 0.10206207261596575f * 1.4426950408889634f;
  const int grp = lane >> 4, k16 = lane & 15, e2 = 2 * k16;
  const bool second = k16 >= 8;
  float gq[6], gk[6];
#pragma unroll
  for (int i = 0; i < 3; ++i) {
    gq[2 * i] = p.g_qnorm[32 * i + e2] * QSCALE; gq[2 * i + 1] = p.g_qnorm[32 * i + e2 + 1] * QSCALE;
    gk[2 * i] = p.g_knorm[32 * i + e2]; gk[2 * i + 1] = p.g_knorm[32 * i + e2 + 1];
  }
  const int ir = e2 & 15;
  unsigned qa[3], ka[3], qan[3] = {0u, 0u, 0u}, kan[3] = {0u, 0u, 0u};
  float cs0, cs1, sn0, sn1, cs0n = 0.f, cs1n = 0.f, sn0n = 0.f, sn1n = 0.f;
#define LD_TOK(t_, qa_, ka_, c0_, c1_, s0_, s1_) do { \
    _Pragma("unroll") for (int i = 0; i < 3; ++i) qa_[i] = *(const unsigned*)(QRAW + (size_t)(t_) * 768 + h * 96 + 32 * i + e2); \
    _Pragma("unroll") for (int i = 0; i < 2; ++i) ka_[i] = *(const unsigned*)(KVRAW + (size_t)(t_) * 1024 + h * 64 + 32 * i + e2); \
    ka_[2] = *(const unsigned*)(PM + (size_t)(t_) * MLAC + 640 + e2); \
    c0_ = rope[(size_t)(t_) * 32 + ir]; c1_ = rope[(size_t)(t_) * 32 + ir + 1]; s0_ = rope[(size_t)(t_) * 32 + 16 + ir]; s1_ = rope[(size_t)(t_) * 32 + 16 + ir + 1]; } while (0)
  const int tbase = b * SEQ + 4 * wid + grp;
  LD_TOK(tbase, qa, ka, cs0, cs1, sn0, sn1);
  for (int it = 0; it < SEQ / 32; ++it) {
    const int t = tbase + 32 * it;
    if (it + 1 < SEQ / 32) LD_TOK(t + 32, qan, kan, cs0n, cs1n, sn0n, sn1n);
#pragma unroll
    for (int ps = 0; ps < 2; ++ps) {
      const bool isq = ps == 0;
      const unsigned r0 = isq ? qa[0] : ka[0], r1 = isq ? qa[1] : ka[1], r2 = isq ? qa[2] : ka[2];
      float v[6] = {bflo(r0), bfhi(r0), bflo(r1), bfhi(r1), bflo(r2), bfhi(r2)};
      float ss = 0.f;
#pragma unroll
      for (int i = 0; i < 6; ++i) ss += v[i] * v[i];
      ss = row16_allsum(ss);
      const float rs = rsqrtf(ss * (1.f / 96.f) + EPS);
#pragma unroll
      for (int i = 0; i < 6; ++i) v[i] *= rs * (isq ? gq[i] : gk[i]);
      const float o0 = dpp_ror<8>(v[4]), o1 = dpp_ror<8>(v[5]);
      if (!second) { v[4] = v[4] * cs0 - o0 * sn0; v[5] = v[5] * cs1 - o1 * sn1; }
      else { v[4] = o0 * sn0 + v[4] * cs0; v[5] = o1 * sn1 + v[5] * cs1; }
      u16* dst = (isq ? Q : Kd) + (size_t)t * 768 + h * 96 + e2;
      *(unsigned*)(dst) = pack2(v[0], v[1]); *(unsigned*)(dst + 32) = pack2(v[2], v[3]); *(unsigned*)(dst + 64) = pack2(v[4], v[5]);
    }
#pragma unroll
    for (int i = 0; i < 3; ++i) { qa[i] = qan[i]; ka[i] = kan[i]; }
    cs0 = cs0n; cs1 = cs1n; sn0 = sn0n; sn1 = sn1n;
  }
#undef LD_TOK
}

DI s16x4 tr_read(unsigned lds_addr) {
  s16x4 r;
  asm volatile("ds_read_b64_tr_b16 %0, %1\n\ts_waitcnt lgkmcnt(0)" : "=&v"(r) : "v"(lds_addr) : "memory");
  return r;
}
#define MFMA32(a, b, c) __builtin_amdgcn_mfma_f32_32x32x16_bf16((a), (b), (c), 0, 0, 0)

constexpr int KLD = 208, VLD = 192;
constexpr int ATT_KOFF = 0, ATT_VOFF = 64 * KLD;
DI void phase_attn(const Params& p, int bid, int nblk, char* smem) {
  char* ws = p.ws;
  const u16* Q = (const u16*)((char*)p.out + DO_Q);
  const u16* Kd = (const u16*)((char*)p.out + DO_K);
  const u16* KVRAW = (const u16*)(ws + OFF_KVRAW);
  u16* Y = (u16*)(ws + OFF_Y);
  const int tid = tid_(), w = tid >> 6, lane = tid & 63, r = lane & 31, hh = lane >> 5;
  const unsigned lds_base = (unsigned)(size_t)smem;
  for (int it = bid; it < 128 * nblk; it += nblk) {
    const int m = 7 - ((it / nblk) & 7), bh = (it / nblk / 8) * nblk + bid;
    if (bh >= 128) break;
    const int b = bh >> 3, h = bh & 7;
    if (m == 7) {
      mla_finalize_head(p, b, h);
      asm volatile("s_waitcnt vmcnt(0)" ::: "memory");
      __syncthreads();
    }
    const int t0 = b * SEQ + 256 * m;
    const int cw = 4 * m + (w >> 1);
    const int tq = t0 + 32 * w + r;
    bf16x8 qf[6];
#pragma unroll
    for (int ks = 0; ks < 6; ++ks) qf[ks] = *reinterpret_cast<const bf16x8*>(Q + (size_t)tq * 768 + h * 96 + 16 * ks + 8 * hh);
    f32x16 O0, O1;
#pragma unroll
    for (int i = 0; i < 16; ++i) { O0[i] = 0.f; O1[i] = 0.f; }
    float mrun = -1e30f, lrun = 0.f;
    const int nkt = 4 * m + 4;
    uint4 kreg0, kreg1, vreg;
    const int krow0 = tid / 12, kcc0 = tid % 12, krow1 = (tid + 512) / 12, kcc1 = (tid + 512) % 12, vrow = tid >> 3, vcc = tid & 7;
    auto gload_kv = [&](int kt) {
      const int tk0 = b * SEQ + 64 * kt;
      kreg0 = *(const uint4*)(Kd + (size_t)(tk0 + krow0) * 768 + h * 96 + kcc0 * 8);
      if (tid < 256) kreg1 = *(const uint4*)(Kd + (size_t)(tk0 + krow1) * 768 + h * 96 + kcc1 * 8);
      vreg = *(const uint4*)(KVRAW + (size_t)(tk0 + vrow) * 1024 + 512 + h * 64 + vcc * 8);
    };
    gload_kv(0);
    for (int kt = 0; kt < nkt; ++kt) {
      __syncthreads();
      *(uint4*)(smem + ATT_KOFF + krow0 * KLD + kcc0 * 16) = kreg0;
      if (tid < 256) *(uint4*)(smem + ATT_KOFF + krow1 * KLD + kcc1 * 16) = kreg1;
      *(uint4*)(smem + ATT_VOFF + vrow * VLD + vcc * 16) = vreg;
      __syncthreads();
      if (kt + 1 < nkt) gload_kv(kt + 1);
      if (kt <= cw) {
        f32x16 X[2];
#pragma unroll
        for (int sub = 0; sub < 2; ++sub) {
#pragma unroll
          for (int i = 0; i < 16; ++i) X[sub][i] = 0.f;
#pragma unroll
          for (int ks = 0; ks < 6; ++ks) {
            const bf16x8 a = *reinterpret_cast<const bf16x8*>(smem + ATT_KOFF + (32 * sub + r) * KLD + (16 * ks + 8 * hh) * 2);
            X[sub] = MFMA32(a, qf[ks], X[sub]);
          }
        }
        float mx = X[0][0];
#pragma unroll
        for (int i = 0; i < 16; ++i) { mx = fmaxf(mx, X[0][i]); mx = fmaxf(mx, X[1][i]); }
        mx = fmaxf(mx, __shfl_xor(mx, 32));
        const float mnew = fmaxf(mrun, mx);
        const float alpha = __builtin_amdgcn_exp2f(mrun - mnew);
        mrun = mnew;
        float rsum = 0.f;
#pragma unroll
        for (int sub = 0; sub < 2; ++sub)
#pragma unroll
          for (int i = 0; i < 16; ++i) { const float e = __builtin_amdgcn_exp2f(X[sub][i] - mnew); X[sub][i] = e; rsum += e; }
        lrun = lrun * alpha + rsum;
        if (__any(alpha != 1.f)) {
#pragma unroll
          for (int i = 0; i < 16; ++i) { O0[i] *= alpha; O1[i] *= alpha; }
        }
        const int i16 = lane & 15, q4 = i16 >> 2, p4 = i16 & 3, blk = (lane >> 4) & 1;
        const unsigned vb = lds_base + ATT_VOFF + (4 * hh + q4) * VLD + (16 * blk) * 2 + 8 * p4;
        s16x4 vf[16];
        asm volatile(
            "ds_read_b64_tr_b16 %0, %16 offset:0\n\tds_read_b64_tr_b16 %1, %16 offset:1536\n\t"
            "ds_read_b64_tr_b16 %2, %16 offset:64\n\tds_read_b64_tr_b16 %3, %16 offset:1600\n\t"
            "ds_read_b64_tr_b16 %4, %16 offset:3072\n\tds_read_b64_tr_b16 %5, %16 offset:4608\n\t"
            "ds_read_b64_tr_b16 %6, %16 offset:3136\n\tds_read_b64_tr_b16 %7, %16 offset:4672\n\t"
            "ds_read_b64_tr_b16 %8, %16 offset:6144\n\tds_read_b64_tr_b16 %9, %16 offset:7680\n\t"
            "ds_read_b64_tr_b16 %10, %16 offset:6208\n\tds_read_b64_tr_b16 %11, %16 offset:7744\n\t"
            "ds_read_b64_tr_b16 %12, %16 offset:9216\n\tds_read_b64_tr_b16 %13, %16 offset:10752\n\t"
            "ds_read_b64_tr_b16 %14, %16 offset:9280\n\tds_read_b64_tr_b16 %15, %16 offset:10816\n\t"
            "s_waitcnt lgkmcnt(0)"
            : "=&v"(vf[0]), "=&v"(vf[1]), "=&v"(vf[2]), "=&v"(vf[3]), "=&v"(vf[4]), "=&v"(vf[5]), "=&v"(vf[6]), "=&v"(vf[7]),
              "=&v"(vf[8]), "=&v"(vf[9]), "=&v"(vf[10]), "=&v"(vf[11]), "=&v"(vf[12]), "=&v"(vf[13]), "=&v"(vf[14]), "=&v"(vf[15])
            : "v"(vb)
            : "memory");
#pragma unroll
        for (int sub = 0; sub < 2; ++sub) {
#pragma unroll
          for (int s = 0; s < 2; ++s) {
            const uint4 pbu = make_uint4(cvt_pk_bf16(X[sub][8 * s], X[sub][8 * s + 1]), cvt_pk_bf16(X[sub][8 * s + 2], X[sub][8 * s + 3]),
                                         cvt_pk_bf16(X[sub][8 * s + 4], X[sub][8 * s + 5]), cvt_pk_bf16(X[sub][8 * s + 6], X[sub][8 * s + 7]));
            const bf16x8 pb = __builtin_bit_cast(bf16x8, pbu);
#pragma unroll
            for (int dt = 0; dt < 2; ++dt) {
              const int vi = ((sub * 2 + s) * 2 + dt) * 2;
              const bf16x8 a = __builtin_shufflevector(vf[vi], vf[vi + 1], 0, 1, 2, 3, 4, 5, 6, 7);
              if (dt == 0) O0 = MFMA32(a, pb, O0); else O1 = MFMA32(a, pb, O1);
            }
          }
        }
      }
    }
    const float ltot = lrun + __shfl_xor(lrun, 32);
    const float inv = 1.f / ltot;
    float ss = 0.f;
#pragma unroll
    for (int i = 0; i < 16; ++i) { O0[i] *= inv; O1[i] *= inv; ss += O0[i] * O0[i] + O1[i] * O1[i]; }
    ss += __shfl_xor(ss, 32);
    const float rs = rsqrtf(ss * (1.f / 64.f) + EPS);
#pragma unroll
    for (int dt = 0; dt < 2; ++dt)
#pragma unroll
      for (int gq = 0; gq < 4; ++gq) {
        const int d = 32 * dt + 8 * gq + 4 * hh;
        const float* gp = p.g_attn_out + h * 64 + d;
        float o[4];
#pragma unroll
        for (int j = 0; j < 4; ++j) o[j] = (dt == 0 ? O0[4 * gq + j] : O1[4 * gq + j]) * rs * gp[j];
        *(uint2*)(Y + (size_t)tq * 1024 + h * 64 + d) = make_uint2(pack2(o[0], o[1]), pack2(o[2], o[3]));
      }
  }
}

constexpr int SC_CH = 32, SC_VOFF = 5 * SC_CH * 64, SC_BUFB = (SC_VOFF + SC_CH * 64) * 4;
constexpr int SC_YOFF = 2 * SC_BUFB;
typedef float f2v __attribute__((ext_vector_type(2)));
DI void phase_scan(const Params& p, int bid, int nblk, char* smem) {
  char* ws = p.ws;
  const u16* U = (const u16*)(ws + OFF_U); const u16* AA = (const u16*)((char*)p.out + DO_AA);
  const u16* PR = (const u16*)(ws + OFF_PR);
  const u16* G = (const u16*)(ws + OFF_G);
  u16* Y = (u16*)(ws + OFF_Y);
  const int tid = tid_(), w = tid >> 6, lane = tid & 63;
  const int g8 = lane >> 3, j8 = lane & 7;
  const int lt = tid & 255, st = lt >> 3, q8 = lt & 7;
  float* Ylb = (float*)(smem + SC_YOFF);
  for (int bh = bid; bh < 128; bh += nblk) {
    const int b = bh >> 3, h = bh & 7;
    const size_t tb = (size_t)b * SEQ;
    const int cj = h * 64 + 8 * q8;
    uint4 la, lu, lk, lr, lv, pk, pr, pv;
    const float* kkw = p.k_k + cj; const float* kaw = p.k_a + cj;
    const float* mur = p.rwkv_mu + cj; const float* muk = p.rwkv_mu + 512 + cj; const float* muv = p.rwkv_mu + 1024 + cj;
    auto gload = [&](int s0) {
      const size_t tok = tb + s0 + st;
      const size_t o = tok * 512 + cj;
      la = *(const uint4*)(AA + o); lu = *(const uint4*)(U + o);
      const u16* cur = PR + tok * RWC + cj;
      lr = *(const uint4*)(cur); lk = *(const uint4*)(cur + 512); lv = *(const uint4*)(cur + 1024);
      if (s0 + st > 0) { pr = *(const uint4*)(cur - RWC); pk = *(const uint4*)(cur - RWC + 512); pv = *(const uint4*)(cur - RWC + 1024); }
      else { pr = make_uint4(0u, 0u, 0u, 0u); pk = pr; pv = pr; }
    };
    auto shift8 = [&](const uint4& c, const uint4& pz, const float* mu, float (&o)[8]) {
      float cv[8], pvv[8]; unpack8(c, cv); unpack8(pz, pvv);
#pragma unroll
      for (int i = 0; i < 8; ++i) o[i] = cv[i] + (pvv[i] - cv[i]) * mu[i];
    };
    auto st8f = [&](float* dst, const float (&v)[8]) {
      *(float4*)dst = make_float4(v[0], v[1], v[2], v[3]); *(float4*)(dst + 4) = make_float4(v[4], v[5], v[6], v[7]);
    };
    auto st8 = [&](float* dst, const uint4& r) {
      float v[8]; unpack8(r, v);
      *(float4*)dst = make_float4(v[0], v[1], v[2], v[3]); *(float4*)(dst + 4) = make_float4(v[4], v[5], v[6], v[7]);
    };
    auto lstore = [&](int buf) {
      float* base = (float*)(smem + buf * SC_BUFB);
      const int o = st * 64 + 8 * q8;
      float kv[8], av[8], kkv[8], bb[8], k2[8], rsv[8], vsv[8];
      shift8(lk, pk, muk, kv); shift8(lr, pr, mur, rsv); shift8(lv, pv, muv, vsv); unpack8(la, av);
      float ss = 0.f;
#pragma unroll
      for (int i = 0; i < 8; ++i) { av[i] = sigmoidf_(av[i]); kkv[i] = kv[i] * kkw[i]; ss += kkv[i] * kkv[i]; }
      ss = row8_allsum(ss);
      const float inv = 1.f / fmaxf(sqrtf(ss), 1e-12f);
#pragma unroll
      for (int i = 0; i < 8; ++i) { kkv[i] *= inv; bb[i] = kkv[i] * av[i]; k2[i] = kv[i] * (1.f + (av[i] - 1.f) * kaw[i]); }
      st8f(base + o, kkv);
      {
        const unsigned uw[4] = {lu.x, lu.y, lu.z, lu.w};
        float d[8];
#pragma unroll
        for (int i = 0; i < 4; ++i) {
          d[2 * i] = __expf(-0.6065306597126334f * sigmoidf_(h2f_lo(uw[i])));
          d[2 * i + 1] = __expf(-0.6065306597126334f * sigmoidf_(h2f_hi(uw[i])));
        }
        st8f(base + SC_CH * 64 + o, d);
      }
      st8f(base + 2 * SC_CH * 64 + o, bb);
      st8f(base + 3 * SC_CH * 64 + o, k2);
      st8f(base + 4 * SC_CH * 64 + o, rsv);
      st8f(base + SC_VOFF + o, vsv);
    };
    float lnw[8], lnb[8], rk[8];
#pragma unroll
    for (int i = 0; i < 8; ++i) { lnw[i] = p.ln_x_w[cj + i]; lnb[i] = p.ln_x_b[cj + i]; rk[i] = p.r_k[cj + i]; }
    auto epilogue = [&](int c) {
      const float* base = (const float*)(smem + (c & 1) * SC_BUFB);
      const float* Yl = Ylb + (c & 1) * SC_CH * 64;
      const size_t tok = tb + c * SC_CH + st;
      const uint4 graw = *(const uint4*)(G + tok * 512 + cj);
      float y[8], r8[8], k8v[8], v8[8], gv[8];
      { const float4 a = *(const float4*)(Yl + st * 64 + 8 * q8), bq = *(const float4*)(Yl + st * 64 + 8 * q8 + 4);
        y[0] = a.x; y[1] = a.y; y[2] = a.z; y[3] = a.w; y[4] = bq.x; y[5] = bq.y; y[6] = bq.z; y[7] = bq.w; }
      { const float4 a = *(const float4*)(base + 4 * SC_CH * 64 + st * 64 + 8 * q8), bq = *(const float4*)(base + 4 * SC_CH * 64 + st * 64 + 8 * q8 + 4);
        r8[0] = a.x; r8[1] = a.y; r8[2] = a.z; r8[3] = a.w; r8[4] = bq.x; r8[5] = bq.y; r8[6] = bq.z; r8[7] = bq.w; }
      { const float4 a = *(const float4*)(base + 3 * SC_CH * 64 + st * 64 + 8 * q8), bq = *(const float4*)(base + 3 * SC_CH * 64 + st * 64 + 8 * q8 + 4);
        k8v[0] = a.x; k8v[1] = a.y; k8v[2] = a.z; k8v[3] = a.w; k8v[4] = bq.x; k8v[5] = bq.y; k8v[6] = bq.z; k8v[7] = bq.w; }
      { const float4 a = *(const float4*)(base + SC_VOFF + st * 64 + 8 * q8), bq = *(const float4*)(base + SC_VOFF + st * 64 + 8 * q8 + 4);
        v8[0] = a.x; v8[1] = a.y; v8[2] = a.z; v8[3] = a.w; v8[4] = bq.x; v8[5] = bq.y; v8[6] = bq.z; v8[7] = bq.w; }
      unpack8(graw, gv);
      float sm = 0.f, bsum = 0.f;
#pragma unroll
      for (int i = 0; i < 8; ++i) { sm += y[i]; bsum += r8[i] * k8v[i] * rk[i]; }
      const float mu = row8_allsum(sm) * (1.f / 64.f);
      const float bonus = row8_allsum(bsum);
      float var = 0.f;
#pragma unroll
      for (int i = 0; i < 8; ++i) { y[i] -= mu; var += y[i] * y[i]; }
      const float rs = rsqrtf(row8_allsum(var) * (1.f / 64.f) + 64e-5f);
      float o[8];
#pragma unroll
      for (int i = 0; i < 8; ++i) o[i] = (y[i] * rs * lnw[i] + lnb[i] + bonus * v8[i]) * gv[i];
      *(uint4*)(Y + tok * 1024 + 512 + cj) = pack8(o);
    };
    __syncthreads();
    if (w >= 4) { gload(0); lstore(0); }
    __syncthreads();
    f2v P[8];
#pragma unroll
    for (int m = 0; m < 8; ++m) P[m] = (f2v){0.f, 0.f};
    const int rp = 16 * w + 2 * g8;
    for (int c = 0; c < SEQ / SC_CH; ++c) {
      if (w < 4) {
        const float* base = (const float*)(smem + (c & 1) * SC_BUFB);
        float* Yl = Ylb + (c & 1) * SC_CH * 64;
        for (int sb = 0; sb < SC_CH; sb += 8) {
          float ypx[8], ypy[8];
          float4 kkA, kkB, wA, wB, bA, bB, kA, kB, rA, rB; f2v v2;
          auto lds_step = [&](int s, float4& kkA_, float4& kkB_, float4& wA_, float4& wB_, float4& bA_, float4& bB_, float4& kA_, float4& kB_,
                              float4& rA_, float4& rB_, f2v& v2_) {
            const float* q = base + s * 64 + 8 * j8;
            kkA_ = *(const float4*)q; kkB_ = *(const float4*)(q + 4);
            wA_ = *(const float4*)(q + SC_CH * 64); wB_ = *(const float4*)(q + SC_CH * 64 + 4);
            bA_ = *(const float4*)(q + 2 * SC_CH * 64); bB_ = *(const float4*)(q + 2 * SC_CH * 64 + 4);
            kA_ = *(const float4*)(q + 3 * SC_CH * 64); kB_ = *(const float4*)(q + 3 * SC_CH * 64 + 4);
            rA_ = *(const float4*)(q + 4 * SC_CH * 64); rB_ = *(const float4*)(q + 4 * SC_CH * 64 + 4);
            v2_ = *(const f2v*)(base + SC_VOFF + s * 64 + rp);
          };
          lds_step(sb, kkA, kkB, wA, wB, bA, bB, kA, kB, rA, rB, v2);
#pragma unroll
          for (int s8 = 0; s8 < 8; ++s8) {
            float4 kkAn, kkBn, wAn, wBn, bAn, bBn, kAn, kBn, rAn, rBn; f2v v2n;
            if (s8 < 7) lds_step(sb + s8 + 1, kkAn, kkBn, wAn, wBn, bAn, bBn, kAn, kBn, rAn, rBn, v2n);
            __builtin_amdgcn_sched_barrier(0);
            f2v ska = P[0] * kkA.x + P[1] * kkA.y + P[2] * kkA.z + P[3] * kkA.w;
            f2v skb = P[4] * kkB.x + P[5] * kkB.y + P[6] * kkB.z + P[7] * kkB.w;
            f2v sk = ska + skb;
            { float sx = sk.x, sy = sk.y; row8_allsum2(sx, sy); sk.x = sx; sk.y = sy; }
            P[0] = P[0] * wA.x - sk * bA.x + v2 * kA.x; P[1] = P[1] * wA.y - sk * bA.y + v2 * kA.y;
            P[2] = P[2] * wA.z - sk * bA.z + v2 * kA.z; P[3] = P[3] * wA.w - sk * bA.w + v2 * kA.w;
            P[4] = P[4] * wB.x - sk * bB.x + v2 * kB.x; P[5] = P[5] * wB.y - sk * bB.y + v2 * kB.y;
            P[6] = P[6] * wB.z - sk * bB.z + v2 * kB.z; P[7] = P[7] * wB.w - sk * bB.w + v2 * kB.w;
            const f2v ya = P[0] * rA.x + P[1] * rA.y + P[2] * rA.z + P[3] * rA.w;
            const f2v yb = P[4] * rB.x + P[5] * rB.y + P[6] * rB.z + P[7] * rB.w;
            const f2v y = ya + yb;
            ypx[s8] = y.x; ypy[s8] = y.y;
            if (s8 < 7) { kkA = kkAn; kkB = kkBn; wA = wAn; wB = wBn; bA = bAn; bB = bBn; kA = kAn; kB = kBn; rA = rAn; rB = rBn; v2 = v2n; }
          }
          { const int k8 = j8;
            RS8_STEP(ypx, 4, 4, 0x141) RS8_STEP(ypy, 4, 4, 0x141)
            RS8_STEP(ypx, 2, 2, 0x4E)  RS8_STEP(ypy, 2, 2, 0x4E)
            RS8_STEP(ypx, 1, 1, 0xB1)  RS8_STEP(ypy, 1, 1, 0xB1) }
          *(f2v*)(Yl + (sb + j8) * 64 + rp) = (f2v){ypx[0], ypy[0]};
        }
      } else {
        const bool more = c + 1 < SEQ / SC_CH;
        if (more) gload((c + 1) * SC_CH);
        if (c >= 1) epilogue(c - 1);
        if (more) lstore((c + 1) & 1);
      }
      __syncthreads();
    }
    if (w >= 4) epilogue(SEQ / SC_CH - 1);
  }
}

DI void expert_convert(const Params& p, int bid, int nblk);
DI void phase_mix(const Params& p, int bid, int nblk, char* smem) {
  const int half = nblk / 2;
  if (bid < half) phase_scan(p, bid, half, smem);
  else { phase_attn(p, bid - half, nblk - half, smem); expert_convert(p, bid - half, nblk - half); }
}

DI void expert_convert(const Params& p, int bid, int nblk) {
  char* ws = p.ws;
  const int tid = tid_();
  {
    unsigned* EU = (unsigned*)(ws + OFF_EU); unsigned* EV = (unsigned*)(ws + OFF_EV);
    const float4* su = (const float4*)p.expert_u; const float4* sv = (const float4*)p.expert_v;
    const float4* gf = (const float4*)p.g_ffn;
    for (size_t i = (size_t)bid * NTHR + tid; i < (size_t)16384 * 256; i += (size_t)nblk * NTHR) {
      const float4 g = gf[i & 255];
      const float4 a = su[i], b = sv[i];
      int pu = 0, pv = 0;
      {
        const int q0 = (int)fminf(fmaxf(rintf(a.x * g.x * SUI), -127.f), 127.f), q1 = (int)fminf(fmaxf(rintf(a.y * g.y * SUI), -127.f), 127.f);
        const int q2 = (int)fminf(fmaxf(rintf(a.z * g.z * SUI), -127.f), 127.f), q3 = (int)fminf(fmaxf(rintf(a.w * g.w * SUI), -127.f), 127.f);
        pu = (q0 & 255) | ((q1 & 255) << 8) | ((q2 & 255) << 16) | ((q3 & 255) << 24);
      }
      pv = __builtin_amdgcn_cvt_pk_fp8_f32(b.x * SV8, b.y * SV8, pv, false);
      pv = __builtin_amdgcn_cvt_pk_fp8_f32(b.z * SV8, b.w * SV8, pv, true);
      EU[i] = (unsigned)pu; EV[i] = (unsigned)pv;
    }
  }
}

DI void phase_wo(const Params& p, int bid, int nblk, char* smem) {
  char* ws = p.ws;
  const int tid = tid_();
  EpiWo E; E.out = p.out; E.x = p.x; E.x2b = (u16*)(ws + OFF_X2B); E.ss2 = (unsigned long long*)(ws + OFF_SS2);
  run_gemm((const u16*)(ws + OFF_Y), 1024, (const u16*)(ws + OFF_WOT), 1024, T, 1024, 1024, E, bid, nblk, smem);
}

DI void phase_5(const Params& p, int bid, int nblk, char* smem) {
  char* ws = p.ws;
  const int tid = tid_(), wid = tid >> 6, lane = tid & 63;
  for (int row = bid * NW + wid; row < T; row += nblk * NW) {
    const float4* xr = (const float4*)(p.out + (size_t)row * DM);
    uint2* xb = (uint2*)(ws + OFF_X2B + (size_t)row * DM * 2);
    float ss = 0.f;
#pragma unroll
    for (int i = 0; i < 4; ++i) {
      const float4 v = xr[lane + 64 * i];
      ss += v.x * v.x + v.y * v.y + v.z * v.z + v.w * v.w;
      xb[lane + 64 * i] = make_uint2(pack2(v.x, v.y), pack2(v.z, v.w));
    }
    ss = wave_allsum(ss);
    if (lane == 0) ((float*)(ws + OFF_RSTD2))[row] = rsqrtf(ss * (1.f / DM) + EPS);
  }
}

DI void phase_6(const Params& p, int bid, int nblk, char* smem) {
  char* ws = p.ws;
  EpiRowScaleT<true> E; E.O = (u16*)(ws + OFF_QP); E.ldc = 2048; E.rstd = (const float*)(ws + OFF_SS2);
  run_gemm((const u16*)(ws + OFF_X2B), 1024, (const u16*)(ws + OFF_WPQT), 1024, T, 2048, 1024, E, bid, nblk, smem);
}

DI void ins16(float (&top)[16], float x) {
#pragma unroll
  for (int i = 0; i < 16; ++i) { const float hi = fmaxf(top[i], x); x = fminf(top[i], x); top[i] = hi; }
}
#define CEX(a, b) do { const float _h = fmaxf(a, b), _l = fminf(a, b); a = _h; b = _l; } while (0)
DI void sort16(float (&v)[16]) {
  CEX(v[0], v[1]);
  CEX(v[2], v[3]);
  CEX(v[0], v[2]);
  CEX(v[1], v[3]);
  CEX(v[1], v[2]);
  CEX(v[4], v[5]);
  CEX(v[6], v[7]);
  CEX(v[4], v[6]);
  CEX(v[5], v[7]);
  CEX(v[5], v[6]);
  CEX(v[0], v[4]);
  CEX(v[2], v[6]);
  CEX(v[2], v[4]);
  CEX(v[1], v[5]);
  CEX(v[3], v[7]);
  CEX(v[3], v[5]);
  CEX(v[1], v[2]);
  CEX(v[3], v[4]);
  CEX(v[5], v[6]);
  CEX(v[8], v[9]);
  CEX(v[10], v[11]);
  CEX(v[8], v[10]);
  CEX(v[9], v[11]);
  CEX(v[9], v[10]);
  CEX(v[12], v[13]);
  CEX(v[14], v[15]);
  CEX(v[12], v[14]);
  CEX(v[13], v[15]);
  CEX(v[13], v[14]);
  CEX(v[8], v[12]);
  CEX(v[10], v[14]);
  CEX(v[10], v[12]);
  CEX(v[9], v[13]);
  CEX(v[11], v[15]);
  CEX(v[11], v[13]);
  CEX(v[9], v[10]);
  CEX(v[11], v[12]);
  CEX(v[13], v[14]);
  CEX(v[0], v[8]);
  CEX(v[4], v[12]);
  CEX(v[4], v[8]);
  CEX(v[2], v[10]);
  CEX(v[6], v[14]);
  CEX(v[6], v[10]);
  CEX(v[2], v[4]);
  CEX(v[6], v[8]);
  CEX(v[10], v[12]);
  CEX(v[1], v[9]);
  CEX(v[5], v[13]);
  CEX(v[5], v[9]);
  CEX(v[3], v[11]);
  CEX(v[7], v[15]);
  CEX(v[7], v[11]);
  CEX(v[3], v[5]);
  CEX(v[7], v[9]);
  CEX(v[11], v[13]);
  CEX(v[1], v[2]);
  CEX(v[3], v[4]);
  CEX(v[5], v[6]);
  CEX(v[7], v[8]);
  CEX(v[9], v[10]);
  CEX(v[11], v[12]);
  CEX(v[13], v[14]);
}
DI void merge16(float (&A)[16], const float (&B)[16]) {
#pragma unroll
  for (int i = 0; i < 16; ++i) A[i] = fmaxf(A[i], B[15 - i]);
#pragma unroll
  for (int d = 8; d >= 1; d >>= 1)
#pragma unroll
    for (int i = 0; i < 16; ++i)
      if ((i & d) == 0) CEX(A[i], A[i + d]);
}
constexpr int TK_SKLD = 272;
constexpr int TK_L1 = 2 * 128 * TK_SKLD;
constexpr int TK_L2 = TK_L1 + 128 * 2 * 16 * 4;
DI void phase_7(const Params& p, int bid, int nblk, char* smem) {
  char* ws = p.ws;
  const u16* QP = (const u16*)(ws + OFF_QP);
  const u16* SUBK = (const u16*)(ws + OFF_SUBK);
  u16* IDX = (u16*)(ws + OFF_IDX); float* GATE = (float*)(ws + OFF_GATE);
  float* lists = (float*)(smem + TK_L1);
  float* lists2 = (float*)(smem + TK_L2);
  const int tid = tid_(), w = tid >> 6, lane = tid & 63, r = lane & 31, hh = lane >> 5;
  const int th = w & 3, pp = w >> 2;
  {
    const unsigned long long* ss2 = (const unsigned long long*)(ws + OFF_SS2);
    const uint2* xb = (const uint2*)(ws + OFF_X2B);
    unsigned* xq = (unsigned*)(ws + OFF_X2Q);
    for (size_t i = (size_t)bid * NTHR + tid; i < (size_t)T * 256; i += (size_t)nblk * NTHR) {
      const float sc = rsqrtf(ss2_get(ss2, (int)(i >> 8)) * (1.f / DM) + EPS) * SXI;
      const uint2 v = xb[i];
      const int q0 = (int)fminf(fmaxf(rintf(bflo(v.x) * sc), -127.f), 127.f), q1 = (int)fminf(fmaxf(rintf(bfhi(v.x) * sc), -127.f), 127.f);
      const int q2 = (int)fminf(fmaxf(rintf(bflo(v.y) * sc), -127.f), 127.f), q3 = (int)fminf(fmaxf(rintf(bfhi(v.y) * sc), -127.f), 127.f);
      xq[i] = (unsigned)((q0 & 255) | ((q1 & 255) << 8) | ((q2 & 255) << 16) | ((q3 & 255) << 24));
    }
  }
  int hcur = -1;
  for (int it = bid; it < 256 * 8; it += nblk) {
    const int tt = it >> 3, h = it & 7;
    if (h != hcur) {
      __syncthreads();
      for (int c = tid; c < 2 * 128 * 16; c += NTHR) {
        const int row = c >> 4, cc = c & 15;
        *(uint4*)(smem + row * TK_SKLD + cc * 16) = *(const uint4*)(SUBK + ((size_t)h * 256 + row) * 128 + cc * 8);
      }
      hcur = h;
      __syncthreads();
    }
    const int t = tt * 128 + 32 * th + r;
    bf16x8 qf[8];
#pragma unroll
    for (int ks = 0; ks < 8; ++ks) qf[ks] = *reinterpret_cast<const bf16x8*>(QP + (size_t)t * 2048 + h * 256 + pp * 128 + 16 * ks + 8 * hh);
    float top[16];
#pragma unroll
    for (int kt = 0; kt < 4; ++kt) {
      f32x16 acc;
#pragma unroll
      for (int i = 0; i < 16; ++i) acc[i] = 0.f;
#pragma unroll
      for (int ks = 0; ks < 8; ++ks) {
        const bf16x8 a = *reinterpret_cast<const bf16x8*>(smem + (pp * 128 + 32 * kt + r) * TK_SKLD + (16 * ks + 8 * hh) * 2);
        acc = MFMA32(a, qf[ks], acc);
      }
      float g[16];
#pragma unroll
      for (int i = 0; i < 16; ++i) {
        const unsigned key = 32 * kt + (i & 3) + 8 * (i >> 2) + 4 * hh;
        g[i] = __uint_as_float((__float_as_uint(acc[i]) & ~127u) | key);
      }
      sort16(g);
      if (kt == 0) {
#pragma unroll
        for (int i = 0; i < 16; ++i) top[i] = g[i];
      } else merge16(top, g);
    }
    {
      float oth[16];
#pragma unroll
      for (int i = 0; i < 16; ++i) oth[i] = __shfl_xor(top[i], 32);
      merge16(top, oth);
    }
    __syncthreads();
    if (hh == 0) {
      float* dst = lists + ((32 * th + r) * 2 + pp) * 16;
#pragma unroll
      for (int i = 0; i < 16; i += 4) *(float4*)(dst + i) = make_float4(top[i], top[i + 1], top[i + 2], top[i + 3]);
    }
    __syncthreads();
    {
      const int tl = tid & 127, q = tid >> 7;
      const float* l1 = lists + (tl * 2 + 0) * 16;
      const float* l2 = lists + (tl * 2 + 1) * 16;
      float ts[16];
#pragma unroll
      for (int i = 0; i < 16; ++i) ts[i] = -INFINITY;
#define CAND(a, b) do { const float _s = __uint_as_float(__float_as_uint(l1[a]) & ~127u) + __uint_as_float(__float_as_uint(l2[b]) & ~127u); \
        ins16(ts, __uint_as_float((__float_as_uint(_s) & ~255u) | (unsigned)((a) * 16 + (b)))); } while (0)
      switch (q) {
      case 0:
        CAND(0, 0);
        CAND(0, 4);
        CAND(0, 8);
        CAND(0, 12);
        CAND(1, 0);
        CAND(1, 4);
        CAND(2, 0);
        CAND(2, 4);
        CAND(3, 3);
        CAND(5, 0);
        CAND(7, 0);
        CAND(10, 0);
        CAND(14, 0);
        break;
      case 1:
        CAND(0, 1);
        CAND(0, 5);
        CAND(0, 9);
        CAND(0, 13);
        CAND(1, 1);
        CAND(1, 5);
        CAND(2, 1);
        CAND(3, 0);
        CAND(4, 0);
        CAND(5, 1);
        CAND(7, 1);
        CAND(11, 0);
        CAND(15, 0);
        break;
      case 2:
        CAND(0, 2);
        CAND(0, 6);
        CAND(0, 10);
        CAND(0, 14);
        CAND(1, 2);
        CAND(1, 6);
        CAND(2, 2);
        CAND(3, 1);
        CAND(4, 1);
        CAND(6, 0);
        CAND(8, 0);
        CAND(12, 0);
        break;
      case 3:
        CAND(0, 3);
        CAND(0, 7);
        CAND(0, 11);
        CAND(0, 15);
        CAND(1, 3);
        CAND(1, 7);
        CAND(2, 3);
        CAND(3, 2);
        CAND(4, 2);
        CAND(6, 1);
        CAND(9, 0);
        CAND(13, 0);
        break;
      }
#undef CAND
      float* dst = lists2 + (tl * 4 + q) * 16;
#pragma unroll
      for (int i = 0; i < 16; i += 4) *(float4*)(dst + i) = make_float4(ts[i], ts[i + 1], ts[i + 2], ts[i + 3]);
    }
    __syncthreads();
    if (tid < 128) {
      const float* l1 = lists + (tid * 2 + 0) * 16;
      const float* l2 = lists + (tid * 2 + 1) * 16;
      float ts[16], tb[16];
#pragma unroll
      for (int i = 0; i < 16; ++i) { ts[i] = lists2[(tid * 4 + 0) * 16 + i]; tb[i] = lists2[(tid * 4 + 1) * 16 + i]; }
      merge16(ts, tb);
      float tc[16];
#pragma unroll
      for (int i = 0; i < 16; ++i) { tc[i] = lists2[(tid * 4 + 2) * 16 + i]; tb[i] = lists2[(tid * 4 + 3) * 16 + i]; }
      merge16(tc, tb);
      merge16(ts, tc);
      const size_t ob = ((size_t)(tt * 128 + tid) * 8 + h) * 16;
      float e[16], esum = 0.f;
      const float mx = __uint_as_float(__float_as_uint(ts[0]) & ~255u);
#pragma unroll
      for (int i = 0; i < 16; ++i) {
        const unsigned bits = __float_as_uint(ts[i]);
        const unsigned cid = bits & 255u;
        const float val = __uint_as_float(bits & ~255u);
        e[i] = __expf(val - mx); esum += e[i];
        const unsigned i1 = __float_as_uint(l1[cid >> 4]) & 127u, i2 = __float_as_uint(l2[cid & 15]) & 127u;
        IDX[ob + i] = (u16)(i1 * 128 + i2);
      }
      const float inv = 1.f / esum;
#pragma unroll
      for (int i = 0; i < 16; ++i) GATE[ob + i] = e[i] * inv;
    }
  }
}

typedef __bf16 bf2_t __attribute__((ext_vector_type(2)));
DI float dot2bf(unsigned a, unsigned b, float c) {
  return __builtin_amdgcn_fdot2_f32_bf16(__builtin_bit_cast(bf2_t, a), __builtin_bit_cast(bf2_t, b), c, false);
}
DI unsigned xcc_id_() { return (unsigned)__builtin_amdgcn_s_getreg((3 << 11) | 20) & 0xFu; }
DI unsigned idx_get(const uint4& a, const uint4& b, int j) {
  const unsigned w = j < 8 ? (j < 2 ? a.x : j < 4 ? a.y : j < 6 ? a.z : a.w) : (j < 10 ? b.x : j < 12 ? b.y : j < 14 ? b.z : b.w);
  return (j & 1) ? (w >> 16) : (w & 0xffffu);
}

typedef float f32x2_t __attribute__((ext_vector_type(2)));
DI void fp8x16_to_f32(const uint4& r, float (&v)[16]) {
  const unsigned w[4] = {r.x, r.y, r.z, r.w};
#pragma unroll
  for (int q = 0; q < 4; ++q) {
    const f32x2_t lo = __builtin_amdgcn_cvt_pk_f32_fp8((int)w[q], false);
    const f32x2_t hi = __builtin_amdgcn_cvt_pk_f32_fp8((int)w[q], true);
    v[4 * q] = lo.x; v[4 * q + 1] = lo.y; v[4 * q + 2] = hi.x; v[4 * q + 3] = hi.y;
  }
}
DI void pin4(uint4& r) { asm volatile("" : "+v"(r.x), "+v"(r.y), "+v"(r.z), "+v"(r.w)); }
DI void pin16(float (&a)[16]) {
  asm volatile("" : "+v"(a[0]), "+v"(a[1]), "+v"(a[2]), "+v"(a[3]), "+v"(a[4]), "+v"(a[5]), "+v"(a[6]), "+v"(a[7]),
                    "+v"(a[8]), "+v"(a[9]), "+v"(a[10]), "+v"(a[11]), "+v"(a[12]), "+v"(a[13]), "+v"(a[14]), "+v"(a[15]));
}
template <int CTRL> DI int dpp_movi(int v) { return __builtin_amdgcn_update_dpp(0, v, CTRL, 0xF, 0xF, false); }
#define RS8I_STEP(arr, n, bit, CTRL) _Pragma("unroll") for (int _j = 0; _j < (n); ++_j) { \
    const bool _hi = (k8 & (bit)) != 0; const int _keep = _hi ? arr[_j + (n)] : arr[_j], _send = _hi ? arr[_j] : arr[_j + (n)]; \
    arr[_j] = _keep + dpp_movi<CTRL>(_send); }
DI void peer_u_item(const Params& p, int s, int tw) {
  char* ws = p.ws;
  const unsigned char* X2Q = (const unsigned char*)(ws + OFF_X2Q);
  const unsigned char* EU = (const unsigned char*)(ws + OFF_EU);
  const u16* IDX = (const u16*)(ws + OFF_IDX);
  float* PART = (float*)(ws + OFF_PART) + (size_t)s * T * 128;
  const int lane = tid_() & 63, g8 = lane >> 3, c = lane & 7;
  const size_t coff = 128 * s + 16 * c;
  const unsigned char* EUs = EU + 128 * s; const unsigned lo16 = 16u * c;
  uint4 i0 = *(const uint4*)(IDX + (size_t)tw * 128 + 16 * g8);
  uint4 i1 = *(const uint4*)(IDX + (size_t)tw * 128 + 16 * g8 + 8);
  for (int tt = 0; tt < 16; ++tt) {
    const int t = tw + tt;
    const uint4 xa = *(const uint4*)(X2Q + (size_t)t * DM + coff);
    uint4 rows[16];
#pragma unroll
    for (int j = 0; j < 16; ++j) rows[j] = *(const uint4*)(EUs + (idx_get(i0, i1, j) * 1024u + lo16));
    if (tt < 15) {
      i0 = *(const uint4*)(IDX + (size_t)(t + 1) * 128 + 16 * g8);
      i1 = *(const uint4*)(IDX + (size_t)(t + 1) * 128 + 16 * g8 + 8);
    }
    int r[16];
#pragma unroll
    for (int j = 0; j < 16; ++j) {
      int d = __builtin_amdgcn_sdot4((int)xa.x, (int)rows[j].x, 0, false);
      d = __builtin_amdgcn_sdot4((int)xa.y, (int)rows[j].y, d, false);
      d = __builtin_amdgcn_sdot4((int)xa.z, (int)rows[j].z, d, false);
      d = __builtin_amdgcn_sdot4((int)xa.w, (int)rows[j].w, d, false);
      r[j] = d;
    }
    { const int k8 = c;
      RS8I_STEP(r, 8, 4, 0x141) RS8I_STEP(r, 4, 2, 0x4E) RS8I_STEP(r, 2, 1, 0xB1) }
    *(float2*)(PART + (size_t)t * 128 + 2 * lane) = make_float2((float)r[0], (float)r[1]);
  }
}

DI void peer_v_item(const Params& p, int s, int tw) {
  char* ws = p.ws;
  const unsigned char* EV = (const unsigned char*)(ws + OFF_EV);
  const u16* IDX = (const u16*)(ws + OFF_IDX);
  const float* WGT = (const float*)(ws + OFF_WGT);
  const u16* X2B = (const u16*)(ws + OFF_X2B);
  const int lane = tid_() & 63, g8 = lane >> 3, c = lane & 7;
  const size_t coff = 128 * s + 16 * c;
  const unsigned char* EVs = EV + 128 * s; const unsigned lo16 = 16u * c;
  uint4 i0 = *(const uint4*)(IDX + (size_t)tw * 128 + 16 * g8);
  uint4 i1 = *(const uint4*)(IDX + (size_t)tw * 128 + 16 * g8 + 8);
  for (int tt = 0; tt < 16; ++tt) {
    const int t = tw + tt;
    unsigned wg[16];
    {
      const uint4* wp = (const uint4*)(WGT + (size_t)t * 128 + 16 * g8);
#pragma unroll
      for (int q = 0; q < 4; ++q) { const uint4 v = wp[q]; wg[4 * q] = v.x; wg[4 * q + 1] = v.y; wg[4 * q + 2] = v.z; wg[4 * q + 3] = v.w; }
    }
    uint4 rows[16];
#pragma unroll
    for (int j = 0; j < 16; ++j) rows[j] = *(const uint4*)(EVs + (idx_get(i0, i1, j) * 1024u + lo16));
    if (tt < 15) {
      i0 = *(const uint4*)(IDX + (size_t)(t + 1) * 128 + 16 * g8);
      i1 = *(const uint4*)(IDX + (size_t)(t + 1) * 128 + 16 * g8 + 8);
    }
    typedef _Float16 h2v __attribute__((ext_vector_type(2)));
    h2v ah[8];
#pragma unroll
    for (int i = 0; i < 8; ++i) ah[i] = (h2v){(_Float16)0.f, (_Float16)0.f};
#pragma unroll
    for (int j = 0; j < 16; ++j) {
      const unsigned rw[4] = {rows[j].x, rows[j].y, rows[j].z, rows[j].w};
      const h2v w2 = __builtin_bit_cast(h2v, wg[j]);
#pragma unroll
      for (int q = 0; q < 4; ++q) {
        ah[2 * q] = __builtin_elementwise_fma(__builtin_bit_cast(h2v, __builtin_amdgcn_cvt_scalef32_pk_f16_fp8(rw[q], 1.0f, false)), w2, ah[2 * q]);
        ah[2 * q + 1] = __builtin_elementwise_fma(__builtin_bit_cast(h2v, __builtin_amdgcn_cvt_scalef32_pk_f16_fp8(rw[q], 1.0f, true)), w2, ah[2 * q + 1]);
      }
    }
    float a[16];
#pragma unroll
    for (int i = 0; i < 8; ++i) { a[2 * i] = (float)ah[i].x * (1.f / SV8); a[2 * i + 1] = (float)ah[i].y * (1.f / SV8); }
    typedef unsigned u32x2_t __attribute__((ext_vector_type(2)));
#pragma unroll
    for (int i = 0; i < 8; ++i) {
      const u32x2_t sw = __builtin_amdgcn_permlane32_swap(__float_as_uint(a[i]), __float_as_uint(a[i + 8]), false, false);
      a[i] = __uint_as_float(sw.x) + __uint_as_float(sw.y);
    }
#pragma unroll
    for (int i = 0; i < 4; ++i) {
      const u32x2_t sw = __builtin_amdgcn_permlane16_swap(__float_as_uint(a[i]), __float_as_uint(a[i + 4]), false, false);
      a[i] = __uint_as_float(sw.x) + __uint_as_float(sw.y);
    }
#pragma unroll
    for (int i = 0; i < 2; ++i) { const bool hi = g8 & 1; const float keep = hi ? a[i + 2] : a[i], send = hi ? a[i] : a[i + 2]; a[i] = keep + dpp_ror<8>(send); }
    const unsigned x2p = *(const unsigned*)(X2B + (size_t)t * DM + coff + 2 * g8);
    *(float2*)(p.out + (size_t)t * DM + coff + 2 * g8) = make_float2(bflo(x2p) + a[0], bfhi(x2p) + a[1]);
  }
}

template <int WHICH>
DI void phase_peer_queue(const Params& p, int bid, int nblk, char* smem) {
  unsigned* ctr = (unsigned*)(p.ws + OFF_QCTR) + WHICH * NSL * 64;
  const unsigned x = xcc_id_() & 7u;
  const int lane = tid_() & 63;
  for (int rr = 0; rr < NSL; ++rr) {
    const int s = (int)((x + (unsigned)rr) & 7u);
    for (;;) {
      int item = 0;
      if (lane == 0) item = (int)atomicAdd(&ctr[s * 64], 1u);
      item = __builtin_amdgcn_readfirstlane(item);
      if (item >= T / 16) break;
      if (WHICH == 0 || WHICH == 2) peer_u_item(p, s, item * 16); else peer_v_item(p, s, item * 16);
    }
  }
}

DI void phase_peer_w(const Params& p, int bid, int nblk, char* smem) {
  char* ws = p.ws;
  const float* PART = (const float*)(ws + OFF_PART);
  const float* GATE = (const float*)(ws + OFF_GATE);
  float* WGT = (float*)(ws + OFF_WGT);
  for (size_t i = (size_t)bid * NTHR + threadIdx.x; i < (size_t)T * 128; i += (size_t)nblk * NTHR) {
    float sum = 0.f;
#pragma unroll
    for (int s = 0; s < NSL; ++s) sum += PART[(size_t)s * T * 128 + i];
    const float d = sum * (1.f / (SUI * SXI));
    { const float wv_ = GATE[i] * 0.5f * d * (1.f + erff(d * 0.70710678118654752f)); ((unsigned*)WGT)[i] = pack2h(wv_, wv_); }
  }
}

#define XB_TMO      128
#define XB_XCNT(j)  (256  + 64 * (j))
#define XB_XSUB(j)  (1280 + 64 * (j))
#define XB_XGEN(j)  (2304 + 64 * (j))
#define XB_TOP      3328
#define XB_TOPGEN   3392
#define XCD_BAR_WORDS 3456
#define XB_SPIN_CAP (1u << 20)
#define LAS __attribute__((address_space(3)))
DI unsigned xb_ld(unsigned* p) { return __hip_atomic_load(p, __ATOMIC_RELAXED, __HIP_MEMORY_SCOPE_AGENT); }
DI unsigned xb_add(unsigned* p, unsigned v) { return __hip_atomic_fetch_add(p, v, __ATOMIC_RELAXED, __HIP_MEMORY_SCOPE_AGENT); }
DI unsigned xb_xcc_id() { return (unsigned)__builtin_amdgcn_s_getreg((3 << 11) | 20) & 0xFu; }
#define XB_SPIN(cond, bar) do { unsigned _sp = 0; while (cond) { __builtin_amdgcn_s_sleep(1); \
    if ((++_sp & 255u) == 0u) { if (xb_ld(&(bar)[XB_TMO])) break; if (_sp > XB_SPIN_CAP) { atomicAdd(&(bar)[XB_TMO], 1u); break; } } } } while (0)
struct XcdBarrier { unsigned* bar; unsigned x; volatile LAS unsigned* st; };
DI XcdBarrier xcd_barrier_post(unsigned* bar, volatile LAS unsigned* st) {
  XcdBarrier b; b.bar = bar; b.x = xb_xcc_id(); b.st = st;
  if (threadIdx.x == 0) (void)xb_add(&bar[XB_XCNT(b.x)], 1u);
  return b;
}
DI void xcd_barrier_complete(unsigned* bar, unsigned x, unsigned& nloc, unsigned& nx) {
  const unsigned G = gridDim.x * gridDim.y * gridDim.z;
  unsigned sum, cnt, mine, sp = 0u;
  for (;;) {
    sum = 0u; cnt = 0u; mine = 0u;
#pragma unroll
    for (unsigned j = 0; j < 16; ++j) { const unsigned c = xb_ld(&bar[XB_XCNT(j)]); sum += c; cnt += (c > 0u) ? 1u : 0u; mine = (j == x) ? c : mine; }
    if (sum == G) break;
    __builtin_amdgcn_s_sleep(1);
    if ((++sp & 255u) == 0u) { if (xb_ld(&bar[XB_TMO])) break; if (sp > XB_SPIN_CAP) { atomicAdd(&bar[XB_TMO], 1u); break; } }
  }
  nloc = mine > 0u ? mine : 1u; nx = cnt > 0u ? cnt : 1u;
}
DI void xcd_barrier(const XcdBarrier& b) {
  asm volatile("s_waitcnt vmcnt(0)" ::: "memory");
  __syncthreads();
  if (threadIdx.x == 0) {
    unsigned* bar = b.bar;
    __builtin_amdgcn_s_waitcnt(0);
    unsigned nloc = b.st[0], nx = b.st[1];
    if (nloc == 0u) { xcd_barrier_complete(bar, b.x, nloc, nx); b.st[0] = nloc; b.st[1] = nx; }
    const unsigned old = xb_add(&bar[XB_XSUB(b.x)], 1u);
    const unsigned gen = old / nloc;
    if (old + 1u == (gen + 1u) * nloc) {
      __builtin_amdgcn_fence(__ATOMIC_RELEASE, "agent");
      asm volatile("s_waitcnt vmcnt(0)" ::: "memory");
      const unsigned og = xb_add(&bar[XB_TOP], 1u);
      const unsigned tg = og / nx;
      if (og + 1u == (tg + 1u) * nx) xb_add(&bar[XB_TOPGEN], 1u);
      else XB_SPIN(xb_ld(&bar[XB_TOPGEN]) == tg, bar);
      __builtin_amdgcn_fence(__ATOMIC_ACQUIRE, "agent");
      xb_add(&bar[XB_XGEN(b.x)], 1u);
      asm volatile("s_waitcnt vmcnt(0)" ::: "memory");
    } else {
      XB_SPIN(xb_ld(&bar[XB_XGEN(b.x)]) == gen, bar);
      __builtin_amdgcn_fence(__ATOMIC_ACQUIRE, "agent");
      asm volatile("s_waitcnt vmcnt(0)" ::: "memory");
    }
  }
  __syncthreads();
}

constexpr int NPHASE = 12;
template <int PH>
DI void run_phase(const Params& p, int bid, int nblk, char* smem) {
  if constexpr (PH == 0) phase_prep(p, bid, nblk, smem);
  else if constexpr (PH == 1) phase_gemm1(p, bid, nblk, smem);
  else if constexpr (PH == 2) phase_2a(p, bid, nblk, smem);
  else if constexpr (PH == 3) phase_2b(p, bid, nblk, smem);
  else if constexpr (PH == 4) { }
  else if constexpr (PH == 5) phase_mix(p, bid, nblk, smem);
  else if constexpr (PH == 6) { }
  else if constexpr (PH == 7) { }
  else if constexpr (PH == 8) phase_wo(p, bid, nblk, smem);
  else if constexpr (PH == 9) { }
  else if constexpr (PH == 10) phase_6(p, bid, nblk, smem);
  else if constexpr (PH == 11) { phase_7(p, bid, nblk, smem); }
  else if constexpr (PH == 12) phase_peer_queue<0>(p, bid, nblk, smem);
  else if constexpr (PH == 13) phase_peer_w(p, bid, nblk, smem);
  else phase_peer_queue<1>(p, bid, nblk, smem);
}

constexpr int SMEM_BYTES = 131072;

#if MEGA
__global__ void __launch_bounds__(NTHR, 2) mega_kernel(Params p) {
  extern __shared__ __attribute__((aligned(16))) char smem[];
  __shared__ uint4 xb_words;
  cg::grid_group grid = cg::this_grid();
  const int bid = blockIdx.x, nblk = gridDim.x;
  if (threadIdx.x == 0) xb_words = make_uint4(0u, 0u, 0u, 0u);
  __syncthreads();
  XcdBarrier xb = xcd_barrier_post((unsigned*)(p.ws + OFF_BAR), (volatile LAS unsigned*)&xb_words);
  run_phase<0>(p, bid, nblk, smem); xcd_barrier(xb);
  run_phase<1>(p, bid, nblk, smem); xcd_barrier(xb);
  run_phase<2>(p, bid, nblk, smem); xcd_barrier(xb);
  run_phase<3>(p, bid, nblk, smem); xcd_barrier(xb);
  run_phase<5>(p, bid, nblk, smem); xcd_barrier(xb);
  run_phase<8>(p, bid, nblk, smem); xcd_barrier(xb);
  run_phase<10>(p, bid, nblk, smem); xcd_barrier(xb);
  run_phase<11>(p, bid, nblk, smem); xcd_barrier(xb);
  run_phase<12>(p, bid, nblk, smem); xcd_barrier(xb);
  run_phase<13>(p, bid, nblk, smem); xcd_barrier(xb);
  run_phase<14>(p, bid, nblk, smem);
}
#else
template <int PH>
__global__ void __launch_bounds__(NTHR, 2) phase_kernel(Params p) {
  extern __shared__ __attribute__((aligned(16))) char smem[];
  run_phase<PH>(p, blockIdx.x, gridDim.x, smem);
}
template <int PH> static void launch_phase(const Params& p, hipStream_t stream) {
  (void)hipFuncSetAttribute((const void*)phase_kernel<PH>, hipFuncAttributeMaxDynamicSharedMemorySize, SMEM_BYTES);
  phase_kernel<PH><<<256, NTHR, SMEM_BYTES, stream>>>(p);
}
#endif

extern "C" void kernel_launch(void* const* d_in, const int* in_sizes, int n_in, void* d_out, int out_size, void* d_ws,
                              size_t ws_size, hipStream_t stream) {
  Params p{};
  p.x = (const float*)d_in[0]; p.pos = (const int*)d_in[1];
  p.g_mix = (const float*)d_in[2]; p.w_in = (const float*)d_in[3]; p.rwkv_mu = (const float*)d_in[4];
  p.g_cq = (const float*)d_in[5]; p.g_ckv = (const float*)d_in[6]; p.w_uq = (const float*)d_in[7];
  p.w_uk = (const float*)d_in[8]; p.w_uv = (const float*)d_in[9]; p.g_qnorm = (const float*)d_in[10];
  p.g_knorm = (const float*)d_in[11]; p.g_attn_out = (const float*)d_in[12]; p.w0 = (const float*)d_in[13];
  p.w2 = (const float*)d_in[14]; p.a0 = (const float*)d_in[15]; p.a2 = (const float*)d_in[16];
  p.g2 = (const float*)d_in[17]; p.k_k = (const float*)d_in[18]; p.k_a = (const float*)d_in[19];
  p.r_k = (const float*)d_in[20]; p.ln_x_w = (const float*)d_in[21]; p.ln_x_b = (const float*)d_in[22];
  p.w_o = (const float*)d_in[23]; p.g_ffn = (const float*)d_in[24]; p.w_pq = (const float*)d_in[25];
  p.sub_keys = (const float*)d_in[26]; p.expert_u = (const float*)d_in[27]; p.expert_v = (const float*)d_in[28];
  p.out = (float*)d_out; p.ws = (char*)d_ws;
#if MEGA
  static int grid_blocks = 0;
  if (!grid_blocks) {
    int dev = 0, cus = 0, per_cu = 0;
    (void)hipGetDevice(&dev);
    (void)hipDeviceGetAttribute(&cus, hipDeviceAttributeMultiprocessorCount, dev);
    (void)hipFuncSetAttribute((const void*)mega_kernel, hipFuncAttributeMaxDynamicSharedMemorySize, SMEM_BYTES);
    (void)hipOccupancyMaxActiveBlocksPerMultiprocessor(&per_cu, mega_kernel, NTHR, SMEM_BYTES);
    if (per_cu > 1) per_cu = 1;
    grid_blocks = cus * per_cu;
  }
  (void)hipMemsetAsync((char*)d_ws + OFF_BAR, 0, 32768, stream);
  void* args[] = {&p};
  hipError_t e = hipLaunchCooperativeKernel((void*)mega_kernel, dim3(grid_blocks), dim3(NTHR), args, SMEM_BYTES, stream);
  if (e != hipSuccess) fprintf(stderr, "cooperative launch failed: %s (grid %d)\n", hipGetErrorString(e), grid_blocks);
#else
  (void)hipMemsetAsync((char*)d_ws + OFF_BAR, 0, 32768, stream);
  launch_phase<0>(p, stream); launch_phase<1>(p, stream); launch_phase<2>(p, stream); launch_phase<3>(p, stream);
  launch_phase<5>(p, stream);
  launch_phase<8>(p, stream); launch_phase<10>(p, stream); launch_phase<11>(p, stream);
  launch_phase<12>(p, stream); launch_phase<13>(p, stream); launch_phase<14>(p, stream);
#endif
}
```

```cpp
#include <hip/hip_runtime.h>
#include <hip/hip_cooperative_groups.h>
#include <cstdio>
#include <cstdint>
namespace cg = cooperative_groups;

#ifndef MEGA
#define MEGA 1
#endif

typedef unsigned short u16;
using bf16x8 = __attribute__((ext_vector_type(8))) short;
using s16x4  = __attribute__((ext_vector_type(4))) short;
using f32x4  = __attribute__((ext_vector_type(4))) float;
using f32x16 = __attribute__((ext_vector_type(16))) float;
#define DI __device__ __forceinline__

constexpr int T = 32768, SEQ = 2048, DM = 1024;
constexpr int INC = 2464, MLAC = 672, RWC = 1792;
constexpr int NTHR = 512, NW = NTHR / 64;
constexpr float EPS = 1e-6f;

constexpr size_t MiB = 1048576;
constexpr size_t OFF_WINT  = 0;
constexpr size_t OFF_WUQT  = OFF_WINT  + 2560 * 1024 * 2;
constexpr size_t OFF_WUKVT = OFF_WUQT  + 768 * 384 * 2;
constexpr size_t OFF_WLT   = OFF_WUKVT + 1024 * 256 * 2;
constexpr size_t OFF_WOT   = OFF_WLT   + 1536 * 256 * 2;
constexpr size_t OFF_WPQT  = OFF_WOT   + 1024 * 1024 * 2;
constexpr size_t OFF_SUBK  = OFF_WPQT  + 2048 * 1024 * 2;
constexpr size_t OFF_ROPE  = OFF_SUBK  + 16 * 128 * 128 * 2;
constexpr size_t OFF_RSTD1 = OFF_ROPE  + (size_t)T * 32 * 4;
constexpr size_t OFF_RSTDQ = OFF_RSTD1 + (size_t)T * 4;
constexpr size_t OFF_RSTDKV= OFF_RSTDQ + (size_t)T * 4;
constexpr size_t OFF_RSTD2 = OFF_RSTDKV+ (size_t)T * 4;
constexpr size_t OFF_SS2   = OFF_RSTD2 + (size_t)T * 4;
constexpr size_t OFF_A_END = OFF_SS2 + (size_t)T * 8;
static_assert(OFF_A_END <= 19 * MiB, "region A");
constexpr size_t OFF_BAR   = 19 * MiB;
constexpr size_t OFF_QCTR  = OFF_BAR + 16384;
constexpr size_t OFF_XB    = 20 * MiB;
constexpr size_t OFF_Y     = OFF_XB;
constexpr size_t OFF_PM    = 84 * MiB;
constexpr size_t OFF_PR    = 126 * MiB;
constexpr size_t OFF_U     = 366 * MiB;
constexpr size_t OFF_G     = 398 * MiB;
constexpr size_t OFF_KK    = OFF_PR + 64 * MiB;
constexpr size_t OFF_KVRAW = 238 * MiB;
constexpr size_t OFF_QRAW  = 302 * MiB;
constexpr size_t OFF_LORAIN= 350 * MiB;
constexpr size_t OFF_YRAW  = 302 * MiB;
constexpr size_t OFF_RS    = 366 * MiB;
constexpr size_t OFF_KS    = 398 * MiB;
constexpr size_t OFF_VS    = 430 * MiB;
constexpr size_t OFF_BB    = 462 * MiB;
constexpr size_t OFF_EU    = 430 * MiB;
constexpr size_t OFF_EV    = 494 * MiB;
constexpr size_t OFF_X2B   = 148 * MiB;
constexpr size_t OFF_QP    = 238 * MiB;
constexpr size_t OFF_IDX   = 20 * MiB;
constexpr size_t OFF_GATE  = 28 * MiB;
constexpr size_t OFF_WGT   = 44 * MiB;
constexpr size_t OFF_PART  = 238 * MiB;
constexpr int NSL = 8;
constexpr float SV8 = 16.f;
constexpr float SUI = 677.f;
constexpr float SXI = 127.f / 6.f;
constexpr size_t OFF_X2Q   = 366 * MiB;
constexpr size_t DO_Q = 0, DO_K = (size_t)T * 768 * 2, DO_AA = (size_t)T * 768 * 4;

struct Params {
  const float* x; const int* pos;
  const float *g_mix, *w_in, *rwkv_mu, *g_cq, *g_ckv, *w_uq, *w_uk, *w_uv, *g_qnorm, *g_knorm, *g_attn_out;
  const float *w0, *w2, *a0, *a2, *g2, *k_k, *k_a, *r_k, *ln_x_w, *ln_x_b, *w_o, *g_ffn, *w_pq, *sub_keys, *expert_u, *expert_v;
  float* out; char* ws;
};

DI u16 f2bf(float x) { unsigned u = __float_as_uint(x); u += 0x7fffu + ((u >> 16) & 1u); return (u16)(u >> 16); }
DI float bf2f(u16 h) { return __uint_as_float(((unsigned)h) << 16); }
DI unsigned pack2(float a, float b) { return (unsigned)f2bf(a) | ((unsigned)f2bf(b) << 16); }
DI float bflo(unsigned u) { return __uint_as_float(u << 16); }
DI float bfhi(unsigned u) { return __uint_as_float(u & 0xffff0000u); }
DI float wave_sum_u(float v);
DI float wave_allsum(float v) { return wave_sum_u(v); }
DI int tid_() { int t = threadIdx.x; asm volatile("" : "+v"(t)); return t; }
constexpr float SS2_SCALE = 1048576.f;
DI float ss2_get(const unsigned long long* ss2, int row) { return (float)ss2[row] * (1.f / SS2_SCALE); }
DI float sigmoidf_(float x) { return 1.f / (1.f + __expf(-x)); }

template <int N> DI float dpp_ror(float v) {
  return __builtin_bit_cast(float, __builtin_amdgcn_update_dpp(0, __builtin_bit_cast(int, v), 0x120 + N, 0xF, 0xF, false));
}
template <int CTRL> DI float dpp_mov(float v) {
  return __builtin_bit_cast(float, __builtin_amdgcn_update_dpp(0, __builtin_bit_cast(int, v), CTRL, 0xF, 0xF, false));
}
#define RS8_STEP(arr, n, bit, CTRL) _Pragma("unroll") for (int _j = 0; _j < (n); ++_j) { \
    const bool _hi = (k8 & (bit)) != 0; const float _keep = _hi ? arr[_j + (n)] : arr[_j], _send = _hi ? arr[_j] : arr[_j + (n)]; \
    arr[_j] = _keep + dpp_mov<CTRL>(_send); }
DI void row16_allsum2(float& a, float& b) {
  asm volatile(
      "s_nop 1\n\t"
      "v_add_f32_dpp %0, %0, %0 row_ror:8 row_mask:0xf bank_mask:0xf bound_ctrl:1\n\t"
      "v_add_f32_dpp %1, %1, %1 row_ror:8 row_mask:0xf bank_mask:0xf bound_ctrl:1\n\t"
      "s_nop 0\n\t"
      "v_add_f32_dpp %0, %0, %0 row_ror:4 row_mask:0xf bank_mask:0xf bound_ctrl:1\n\t"
      "v_add_f32_dpp %1, %1, %1 row_ror:4 row_mask:0xf bank_mask:0xf bound_ctrl:1\n\t"
      "s_nop 0\n\t"
      "v_add_f32_dpp %0, %0, %0 row_ror:2 row_mask:0xf bank_mask:0xf bound_ctrl:1\n\t"
      "v_add_f32_dpp %1, %1, %1 row_ror:2 row_mask:0xf bank_mask:0xf bound_ctrl:1\n\t"
      "s_nop 0\n\t"
      "v_add_f32_dpp %0, %0, %0 row_ror:1 row_mask:0xf bank_mask:0xf bound_ctrl:1\n\t"
      "v_add_f32_dpp %1, %1, %1 row_ror:1 row_mask:0xf bank_mask:0xf bound_ctrl:1\n\t"
      "s_nop 1"
      : "+v"(a), "+v"(b));
}
DI float row16_allsum(float v);
DI float wave_sum_u(float v) {
  v = row16_allsum(v);
  const int vi = __float_as_int(v);
  return __int_as_float(__builtin_amdgcn_readlane(vi, 0)) + __int_as_float(__builtin_amdgcn_readlane(vi, 16)) +
         __int_as_float(__builtin_amdgcn_readlane(vi, 32)) + __int_as_float(__builtin_amdgcn_readlane(vi, 48));
}
DI float row16_allsum(float v) {
  v += dpp_ror<8>(v); v += dpp_ror<4>(v); v += dpp_ror<2>(v); v += dpp_ror<1>(v);
  return v;
}
DI void row8_allsum2(float& a, float& b) {
  asm volatile(
      "s_nop 1\n\t"
      "v_add_f32_dpp %0, %0, %0 row_half_mirror row_mask:0xf bank_mask:0xf bound_ctrl:1\n\t"
      "v_add_f32_dpp %1, %1, %1 row_half_mirror row_mask:0xf bank_mask:0xf bound_ctrl:1\n\t"
      "s_nop 0\n\t"
      "v_add_f32_dpp %0, %0, %0 quad_perm:[2,3,0,1] row_mask:0xf bank_mask:0xf bound_ctrl:1\n\t"
      "v_add_f32_dpp %1, %1, %1 quad_perm:[2,3,0,1] row_mask:0xf bank_mask:0xf bound_ctrl:1\n\t"
      "s_nop 0\n\t"
      "v_add_f32_dpp %0, %0, %0 quad_perm:[1,0,3,2] row_mask:0xf bank_mask:0xf bound_ctrl:1\n\t"
      "v_add_f32_dpp %1, %1, %1 quad_perm:[1,0,3,2] row_mask:0xf bank_mask:0xf bound_ctrl:1\n\t"
      "s_nop 1"
      : "+v"(a), "+v"(b));
}
DI float row8_allsum(float v) {
  v += dpp_mov<0x141>(v); v += dpp_mov<0x4E>(v); v += dpp_mov<0xB1>(v);
  return v;
}


DI void tconv(const float* __restrict__ src, int K, int N, const float* __restrict__ scale, u16* __restrict__ dst,
              int ldd, int noff, int bid, int nblk, float* tile) {
  const int tid = tid_(), tx = tid & 31, ty = tid >> 5;
  const int nbn = N / 32, ntl = (K / 32) * nbn;
  for (int tl = bid; tl < ntl; tl += nblk) {
    const int kb = tl / nbn, nb = tl % nbn;
#pragma unroll
    for (int i = 0; i < 2; ++i) {
      const int k = kb * 32 + ty + 16 * i;
      float v = src[(size_t)k * N + nb * 32 + tx];
      if (scale) v *= scale[k];
      tile[(ty + 16 * i) * 33 + tx] = v;
    }
    __syncthreads();
#pragma unroll
    for (int i = 0; i < 2; ++i) {
      const int n = nb * 32 + ty + 16 * i;
      dst[(size_t)(noff + n) * ldd + kb * 32 + tx] = f2bf(tile[tx * 33 + ty + 16 * i]);
    }
    __syncthreads();
  }
}

DI void phase_prep(const Params& p, int bid, int nblk, char* smem) {
  float* tile = (float*)smem;
  char* ws = p.ws;
  const int tid = tid_();
  tconv(p.w_in, 1024, INC, p.g_mix, (u16*)(ws + OFF_WINT), 1024, 0, bid, nblk, tile);
  for (int i = bid * NTHR + tid; i < 96 * 1024; i += nblk * NTHR) ((u16*)(ws + OFF_WINT))[2464 * 1024 + i] = 0;
  tconv(p.w_uq, 384, 768, p.g_cq, (u16*)(ws + OFF_WUQT), 384, 0, bid, nblk, tile);
  tconv(p.w_uk, 256, 512, p.g_ckv, (u16*)(ws + OFF_WUKVT), 256, 0, bid, nblk, tile);
  tconv(p.w_uv, 256, 512, p.g_ckv, (u16*)(ws + OFF_WUKVT), 256, 512, bid, nblk, tile);
  for (int i = bid * NTHR + tid; i < 1536 * 256; i += nblk * NTHR) {
    const int n = i >> 8, k = i & 255;
    float v = 0.f;
    if (n < 512) { if (k < 64) v = p.w2[k * 512 + n]; }
    else if (n < 1024) { if (k >= 64 && k < 128) v = p.a2[(k - 64) * 512 + (n - 512)]; }
    else { if (k >= 128) v = p.g2[(k - 128) * 512 + (n - 1024)]; }
    ((u16*)(ws + OFF_WLT))[i] = f2bf(v);
  }
  for (int i = bid * NTHR + tid; i < T; i += nblk * NTHR) ((unsigned long long*)(ws + OFF_SS2))[i] = 0ull;
  for (int i = bid * NTHR + tid; i < T * 16; i += nblk * NTHR) {
    const int t = i >> 4, j = i & 15;
    const float inv = powf(10000.0f, -(float)j / 16.0f);
    const float ang = (float)p.pos[t] * inv;
    float s, c; sincosf(ang, &s, &c);
    float* rp = (float*)(ws + OFF_ROPE) + (size_t)t * 32;
    rp[j] = c; rp[16 + j] = s;
  }
  const int wid = tid >> 6, lane = tid & 63;
  for (int row = 2 * (bid * NW + wid); row < T; row += 2 * nblk * NW) {
    const float4* xr = (const float4*)(p.x + (size_t)row * DM);
    uint2* xb = (uint2*)(ws + OFF_XB + (size_t)row * DM * 2);
    float4 v[8];
#pragma unroll
    for (int i = 0; i < 8; ++i) v[i] = xr[lane + 64 * i];
    float ss0 = 0.f, ss1 = 0.f;
#pragma unroll
    for (int i = 0; i < 8; ++i) {
      const float s = v[i].x * v[i].x + v[i].y * v[i].y + v[i].z * v[i].z + v[i].w * v[i].w;
      if (i < 4) ss0 += s; else ss1 += s;
      xb[lane + 64 * i] = make_uint2(pack2(v[i].x, v[i].y), pack2(v[i].z, v[i].w));
    }
    ss0 = wave_sum_u(ss0); ss1 = wave_sum_u(ss1);
    if (lane == 0) {
      ((float*)(ws + OFF_RSTD1))[row] = rsqrtf(ss0 * (1.f / DM) + EPS);
      ((float*)(ws + OFF_RSTD1))[row + 1] = rsqrtf(ss1 * (1.f / DM) + EPS);
    }
  }
}

namespace pg8 {
#define PG8_LAS __attribute__((address_space(3)))
typedef unsigned short bf16_t;
typedef short bf16x8 __attribute__((ext_vector_type(8)));
typedef float f32x4 __attribute__((ext_vector_type(4)));
typedef unsigned u32x4 __attribute__((ext_vector_type(4)));
constexpr int BM = 256, BK = 64, HALF = 128, HTB = HALF * BK * 2  , STAGE_BYTES = 8 * HTB, NXCD = 8, WGM = 8;

__host__ __device__ __forceinline__ int lds_byte(int r, int c) { const int st = (r >> 4) * 2 + (c >> 5), rr = r & 15, cc = c & 31, ob = rr * 64 + cc * 2; return st * 1024 + (ob ^ (((ob >> 9) & 1) << 5)); }
__host__ __device__ __forceinline__ void stage_rc(int b, int& R, int& C) { const int st = b / 1024, sb = b % 1024, swz = sb ^ (((sb >> 9) & 1) << 5); R = (st >> 1) * 16 + swz / 64; C = (st & 1) * 32 + (swz % 64) / 2; }
__host__ __device__ __forceinline__ int perm32(int rho) { const int n = rho >> 4, i = rho & 15; return 8 * (i >> 2) + 4 * n + (i & 3); }

struct Unit { int pm, pn; };
struct Gemm { const bf16_t* A; const bf16_t* Bt; int M, N, K, lda, ldb; };

struct StaticOrder {
    int nM, nN, nwg, G, c;
    __host__ __device__ void init(int M, int N, int G_, int c_) { nM = M / BM; nN = N / BM; nwg = nM * nN; G = G_; c = c_; }
    __host__ __device__ bool next(int i, Unit& u) const {
        const long L = (long)i * G + c; if (L >= nwg) return false;
        int wgid = (int)L; { const int q = nwg / NXCD, r = nwg % NXCD, xcd = wgid % NXCD, off = wgid / NXCD; wgid = (xcd < r ? xcd * (q + 1) : r * (q + 1) + (xcd - r) * q) + off; }
        const int nig = WGM * nN, gid = wgid / nig, fm = gid * WGM, gsz = (nM - fm) < WGM ? (nM - fm) : WGM;
        u.pm = fm + ((wgid % nig) % gsz); u.pn = (wgid % nig) / gsz; return true;
    }
    __device__ __forceinline__ void a_ready(const Unit&) const {}
    __device__ __forceinline__ void done(const Unit&) const {}
};
__device__ __forceinline__ unsigned cvt_pk_bf16(float lo, float hi) { unsigned r; asm volatile("v_cvt_pk_bf16_f32 %0, %1, %2" : "=v"(r) : "v"(lo), "v"(hi)); return r; }
template <class Epi, class Sched, bool STAMP = false>
__device__ __forceinline__ void gemm_phase(PG8_LAS unsigned char* lds, const Gemm g, const Sched& S, const Epi& E, unsigned long long* stamps) {
    const int tid = tid_(), wid = __builtin_amdgcn_readfirstlane(tid >> 6), lane = tid & 63, wr = wid >> 2, wc = wid & 3, fr = lane & 15, fq = lane >> 4;
    const int K = g.K, nt = K / BK;
    int ts_lo = 0, ts_hi = 0, nts = 0; const unsigned long long rt_entry = STAMP ? (unsigned long long)wall_clock64() : 0ull;
#define PG8_STAMP() do { if (STAMP && wid == 0 && nts < 64) { const unsigned long long _c = (unsigned long long)clock64(); \
        ts_lo = (lane == nts) ? (int)(unsigned)_c : ts_lo; ts_hi = (lane == nts) ? (int)(unsigned)(_c >> 32) : ts_hi; ++nts; } } while (0)
    PG8_STAMP();
    unsigned voffA[2], voffB[2];
#pragma unroll
    for (int i = 0; i < 2; ++i) { int R, C; stage_rc(tid * 16 + i * 8192, R, C); const int Rb = Epi::PERM ? ((R & ~31) + perm32(R & 31)) : R;
        voffA[i] = (unsigned)(R * g.lda + C) * 2u; voffB[i] = (unsigned)(Rb * g.ldb + C) * 2u; }
    const size_t kstep = (size_t)(BK * 2);
    const size_t hstepA = (size_t)HALF * g.lda * 2, hstepB = (size_t)HALF * g.ldb * 2;
    const size_t tstepA = 2 * hstepA, tstepB = 2 * hstepB;
    const unsigned ldsw = (unsigned)wid * 1024u;
    const int aoff = lds_byte(wr * 64 + fr, fq * 8), boff = lds_byte(wc * 32 + fr, fq * 8);
#define PG8_SA(b, h) (((b) * 2 + (h)) * HTB)
#define PG8_SB(b, h) ((4 + (b) * 2 + (h)) * HTB)
#define PG8_STAGE(bufoff, gbase, voff) do { _Pragma("unroll") for (int _i = 0; _i < 2; ++_i) \
        __builtin_amdgcn_global_load_lds((const unsigned*)((const char*)(gbase) + (voff)[_i]), (PG8_LAS unsigned*)(lds + (bufoff) + ldsw + _i * 8192), 16, 0, 0); } while (0)
#define PG8_LDA(dst, b, h) do { _Pragma("unroll") for (int m = 0; m < 4; ++m) _Pragma("unroll") for (int k = 0; k < 2; ++k) dst[m][k] = *(const PG8_LAS bf16x8*)(lds + PG8_SA(b, h) + aoff + m * 2048 + k * 1024); } while (0)
#define PG8_LDB(dst, b, h) do { _Pragma("unroll") for (int n = 0; n < 2; ++n) _Pragma("unroll") for (int k = 0; k < 2; ++k) dst[n][k] = *(const PG8_LAS bf16x8*)(lds + PG8_SB(b, h) + boff + n * 2048 + k * 1024); } while (0)
#define PG8_MMA(ai, bj, At, Bt) do { __builtin_amdgcn_s_setprio(1); _Pragma("unroll") for (int m = 0; m < 4; ++m) _Pragma("unroll") for (int n = 0; n < 2; ++n) _Pragma("unroll") for (int k = 0; k < 2; ++k) \
        acc[ai][bj][m][n] = __builtin_amdgcn_mfma_f32_16x16x32_bf16(Bt[n][k], At[m][k], acc[ai][bj][m][n], 0, 0, 0); __builtin_amdgcn_s_setprio(0); } while (0)
#define PG8_WAIT_V(n) asm volatile("s_waitcnt vmcnt(" #n ")" ::: "memory")
#define PG8_WAIT_L(n) asm volatile("s_waitcnt lgkmcnt(" #n ")" ::: "memory")
#define PG8_BAR __builtin_amdgcn_s_barrier()
#define PG8_SCHED __builtin_amdgcn_sched_barrier(0)
    Unit cur, nxt; int ui = 0;
    if (!S.next(0, cur)) return;
    f32x4 acc[2][2][4][2];
#pragma unroll
    for (int a = 0; a < 2; ++a)
#pragma unroll
        for (int b = 0; b < 2; ++b)
#pragma unroll
            for (int m = 0; m < 4; ++m)
#pragma unroll
                for (int n = 0; n < 2; ++n) acc[a][b][m][n] = (f32x4){0.f, 0.f, 0.f, 0.f};
    bf16x8 At[4][2], B0[2][2], B1[2][2];
    const char* cA = (const char*)g.A + (size_t)cur.pm * tstepA; const char* cB = (const char*)g.Bt + (size_t)cur.pn * tstepB;
    S.a_ready(cur);
    PG8_STAGE(PG8_SB(0, 0), cB, voffB); PG8_STAGE(PG8_SA(0, 0), cA, voffA); PG8_STAGE(PG8_SB(0, 1), cB + hstepB, voffB); PG8_STAGE(PG8_SA(0, 1), cA + hstepA, voffA);
    if (wr == 1) PG8_BAR;
    PG8_WAIT_V(4); PG8_BAR;
    PG8_STAGE(PG8_SB(1, 0), cB + kstep, voffB); PG8_STAGE(PG8_SA(1, 0), cA + kstep, voffA); PG8_STAGE(PG8_SB(1, 1), cB + hstepB + kstep, voffB);
    PG8_WAIT_V(6); PG8_BAR;
    PG8_STAMP();
    for (;;) {
        const bool has_next = S.next(ui + 1, nxt);
        const char* nA = has_next ? (const char*)g.A + (size_t)nxt.pm * tstepA : cA; const char* nB = has_next ? (const char*)g.Bt + (size_t)nxt.pn * tstepB : cB;
        for (int t = 0; t < nt; t += 2) {
            const bool last = (t == nt - 2);
            const char* a1 = cA + (size_t)(t + 1) * kstep;
            const char* a2 = last ? nA : cA + (size_t)(t + 2) * kstep; const char* b2 = last ? nB : cB + (size_t)(t + 2) * kstep;
            const char* a3 = a2 + kstep; const char* b3 = b2 + kstep;
            if (last && has_next) S.a_ready(nxt);
            PG8_LDB(B0, 0, 0); PG8_SCHED; PG8_LDA(At, 0, 0); PG8_STAGE(PG8_SA(1, 1), a1 + hstepA, voffA);
            PG8_WAIT_L(8); PG8_BAR; PG8_WAIT_L(0); PG8_MMA(0, 0, At, B0); PG8_BAR; PG8_SCHED;
            PG8_LDB(B1, 0, 1); PG8_STAGE(PG8_SB(0, 0), b2, voffB);
            PG8_BAR; PG8_WAIT_L(0); PG8_MMA(0, 1, At, B1); PG8_BAR;
            PG8_LDA(At, 0, 1); PG8_STAGE(PG8_SA(0, 0), a2, voffA);
            PG8_BAR; PG8_WAIT_L(0); PG8_MMA(1, 0, At, B0); PG8_BAR; PG8_SCHED;
            PG8_STAGE(PG8_SB(0, 1), b2 + hstepB, voffB);
            PG8_WAIT_V(6); PG8_BAR; PG8_MMA(1, 1, At, B1); PG8_BAR;
            PG8_LDB(B0, 1, 0); PG8_SCHED; PG8_LDA(At, 1, 0); PG8_STAGE(PG8_SA(0, 1), a2 + hstepA, voffA);
            PG8_WAIT_L(8); PG8_BAR; PG8_WAIT_L(0); PG8_MMA(0, 0, At, B0); PG8_BAR; PG8_SCHED;
            PG8_LDB(B1, 1, 1); PG8_STAGE(PG8_SB(1, 0), b3, voffB);
            PG8_BAR; PG8_WAIT_L(0); PG8_MMA(0, 1, At, B1); PG8_BAR;
            PG8_LDA(At, 1, 1); PG8_STAGE(PG8_SA(1, 0), a3, voffA);
            PG8_BAR; PG8_WAIT_L(0); PG8_MMA(1, 0, At, B0); PG8_BAR; PG8_SCHED;
            PG8_STAGE(PG8_SB(1, 1), b3 + hstepB, voffB);
            PG8_WAIT_V(6); PG8_BAR; PG8_MMA(1, 1, At, B1); PG8_BAR;
        }
        PG8_STAMP();
        if constexpr (!Epi::AFTER_DRAIN) { E(acc, cur, wr, wc, fr, fq); S.done(cur); }
        PG8_STAMP();
        if (!has_next) break;
#pragma unroll
        for (int a = 0; a < 2; ++a)
#pragma unroll
            for (int b = 0; b < 2; ++b)
#pragma unroll
                for (int m = 0; m < 4; ++m)
#pragma unroll
                    for (int n = 0; n < 2; ++n) acc[a][b][m][n] = (f32x4){0.f, 0.f, 0.f, 0.f};
        cur = nxt; cA = nA; cB = nB; ++ui;
    }
    PG8_WAIT_V(0);
    if (wr == 0) PG8_BAR;
    PG8_BAR;
    if constexpr (Epi::AFTER_DRAIN) { E.fused(acc, cur, wr, wc, fr, fq, lds, wid, lane); S.done(cur); }
    PG8_STAMP();
    if (STAMP && wid == 0) { stamps[lane] = lane < nts ? (((unsigned long long)(unsigned)ts_hi << 32) | (unsigned)ts_lo) : 0ull;
        if (lane == 62) stamps[62] = rt_entry; if (lane == 63) stamps[63] = (unsigned long long)wall_clock64(); }
#undef PG8_STAMP
#undef PG8_SA
#undef PG8_SB
#undef PG8_STAGE
#undef PG8_LDA
#undef PG8_LDB
#undef PG8_MMA
#undef PG8_WAIT_V
#undef PG8_WAIT_L
#undef PG8_BAR
#undef PG8_SCHED
}
}

using pg8::cvt_pk_bf16;
struct EpiP {
  static constexpr bool PERM = true, AFTER_DRAIN = false;
  u16* PM; u16* PR; const float* rstd;
  DI void operator()(const pg8::f32x4 (&acc)[2][2][4][2], const pg8::Unit& u, int wr, int wc, int fr, int fq) const {
    const int row0 = u.pm * 256 + wr * 64 + fr, col0 = u.pn * 256 + wc * 32 + 8 * fq;
#pragma unroll
    for (int ai = 0; ai < 2; ++ai)
#pragma unroll
      for (int m = 0; m < 4; ++m) {
        const int r = row0 + ai * 128 + m * 16;
        const float rs = rstd[r];
#pragma unroll
        for (int bj = 0; bj < 2; ++bj) {
          const int c = col0 + bj * 128;
          const pg8::f32x4 v0 = acc[ai][bj][m][0] * rs, v1 = acc[ai][bj][m][1] * rs;
          const uint4 w = make_uint4(cvt_pk_bf16(v0[0], v0[1]), cvt_pk_bf16(v0[2], v0[3]), cvt_pk_bf16(v1[0], v1[1]), cvt_pk_bf16(v1[2], v1[3]));
          if (c < MLAC) *(uint4*)(PM + (size_t)r * MLAC + c) = w;
          else if (c < INC) *(uint4*)(PR + (size_t)r * RWC + (c - MLAC)) = w;
        }
      }
  }
};
template <bool FROM_SS>
struct EpiRowScaleT {
  static constexpr bool PERM = true, AFTER_DRAIN = false;
  u16* O; int ldc; const float* rstd;
  DI void operator()(const pg8::f32x4 (&acc)[2][2][4][2], const pg8::Unit& u, int wr, int wc, int fr, int fq) const {
    const int row0 = u.pm * 256 + wr * 64 + fr, col0 = u.pn * 256 + wc * 32 + 8 * fq;
#pragma unroll
    for (int ai = 0; ai < 2; ++ai)
#pragma unroll
      for (int m = 0; m < 4; ++m) {
        const int r = row0 + ai * 128 + m * 16;
        const float rs = FROM_SS ? rsqrtf(ss2_get((const unsigned long long*)rstd, r) * (1.f / DM) + EPS) : rstd[r];
#pragma unroll
        for (int bj = 0; bj < 2; ++bj) {
          const pg8::f32x4 v0 = acc[ai][bj][m][0] * rs, v1 = acc[ai][bj][m][1] * rs;
          *(uint4*)(O + (size_t)r * ldc + col0 + bj * 128) =
              make_uint4(cvt_pk_bf16(v0[0], v0[1]), cvt_pk_bf16(v0[2], v0[3]), cvt_pk_bf16(v1[0], v1[1]), cvt_pk_bf16(v1[2], v1[3]));
        }
      }
  }
};
DI unsigned pack2h(float a, float b) {
  return (unsigned)__builtin_bit_cast(unsigned short, (_Float16)a) | ((unsigned)__builtin_bit_cast(unsigned short, (_Float16)b) << 16);
}
DI float h2f_lo(unsigned u) { return (float)__builtin_bit_cast(_Float16, (unsigned short)(u & 0xffffu)); }
DI float h2f_hi(unsigned u) { return (float)__builtin_bit_cast(_Float16, (unsigned short)(u >> 16)); }
using EpiRowScale = EpiRowScaleT<false>;
struct EpiLora {
  static constexpr bool PERM = true, AFTER_DRAIN = false;
  u16* U; u16* AA; u16* G; const float* w0; const float* a0;
  template <int KIND>
  DI void body(const pg8::f32x4 (&acc)[2][2][4][2], const pg8::Unit& u, int wr, int wc, int fr, int fq) const {
    const int row0 = u.pm * 256 + wr * 64 + fr, col0 = u.pn * 256 + wc * 32 + 8 * fq;
    u16* O = KIND == 0 ? U : KIND == 1 ? AA : G;
#pragma unroll
    for (int bj = 0; bj < 2; ++bj) {
      const int c = (col0 + bj * 128) & 511;
      pg8::f32x4 b0 = {0.f, 0.f, 0.f, 0.f}, b1 = {0.f, 0.f, 0.f, 0.f};
      if (KIND == 0) { b0 = *(const pg8::f32x4*)(w0 + c); b1 = *(const pg8::f32x4*)(w0 + c + 4); }
      if (KIND == 1) { b0 = *(const pg8::f32x4*)(a0 + c); b1 = *(const pg8::f32x4*)(a0 + c + 4); }
#pragma unroll
      for (int ai = 0; ai < 2; ++ai)
#pragma unroll
        for (int m = 0; m < 4; ++m) {
          const int r = row0 + ai * 128 + m * 16;
          const pg8::f32x4 v0 = acc[ai][bj][m][0] + b0, v1 = acc[ai][bj][m][1] + b1;
          uint4 w;
          if (KIND == 0) w = make_uint4(pack2h(v0[0], v0[1]), pack2h(v0[2], v0[3]), pack2h(v1[0], v1[1]), pack2h(v1[2], v1[3]));
          else w = make_uint4(cvt_pk_bf16(v0[0], v0[1]), cvt_pk_bf16(v0[2], v0[3]), cvt_pk_bf16(v1[0], v1[1]), cvt_pk_bf16(v1[2], v1[3]));
          *(uint4*)(O + (size_t)r * 512 + c) = w;
        }
    }
  }
  DI void operator()(const pg8::f32x4 (&acc)[2][2][4][2], const pg8::Unit& u, int wr, int wc, int fr, int fq) const {
    const int kind = u.pn >> 1;
    if (kind == 0) body<0>(acc, u, wr, wc, fr, fq);
    else if (kind == 1) body<1>(acc, u, wr, wc, fr, fq);
    else body<2>(acc, u, wr, wc, fr, fq);
  }
};
struct EpiWo {
  static constexpr bool PERM = false, AFTER_DRAIN = false;
  float* out; const float* x; u16* x2b; unsigned long long* ss2;
  DI void operator()(const pg8::f32x4 (&acc)[2][2][4][2], const pg8::Unit& u, int wr, int wc, int fr, int fq) const {
    const int row0 = u.pm * 256 + wr * 64 + fr, col0 = u.pn * 256 + wc * 32 + 4 * fq;
#pragma unroll
    for (int ai = 0; ai < 2; ++ai)
#pragma unroll
      for (int m = 0; m < 4; ++m) {
        const int r = row0 + ai * 128 + m * 16;
        const size_t ro = (size_t)r * DM + col0;
        float ss = 0.f;
#pragma unroll
        for (int bj = 0; bj < 2; ++bj)
#pragma unroll
          for (int n = 0; n < 2; ++n) {
            const pg8::f32x4 xv = *(const pg8::f32x4*)(x + ro + bj * 128 + n * 16);
            const pg8::f32x4 o = xv + acc[ai][bj][m][n];
            *(uint2*)(x2b + ro + bj * 128 + n * 16) = make_uint2(cvt_pk_bf16(o[0], o[1]), cvt_pk_bf16(o[2], o[3]));
            ss += o[0] * o[0] + o[1] * o[1] + o[2] * o[2] + o[3] * o[3];
          }
        ss += __shfl_xor(ss, 16); ss += __shfl_xor(ss, 32);
        if (fq == 0) atomicAdd(ss2 + r, (unsigned long long)(ss * SS2_SCALE + 0.5f));
      }
  }
};
template <class Epi>
DI void run_gemm(const u16* A, int lda, const u16* Bt, int ldb, int M, int N, int K, const Epi& E, int bid, int nblk, char* smem) {
  pg8::Gemm g; g.A = A; g.Bt = Bt; g.M = M; g.N = N; g.K = K; g.lda = lda; g.ldb = ldb;
  pg8::StaticOrder S; S.init(M, N, nblk, bid);
  __syncthreads();
  pg8::gemm_phase<Epi, pg8::StaticOrder, false>((PG8_LAS unsigned char*)smem, g, S, E, nullptr);
  __syncthreads();
}

DI void phase_gemm1(const Params& p, int bid, int nblk, char* smem) {
  char* ws = p.ws;
  EpiP E; E.PM = (u16*)(ws + OFF_PM); E.PR = (u16*)(ws + OFF_PR); E.rstd = (const float*)(ws + OFF_RSTD1);
  run_gemm((const u16*)(ws + OFF_XB), 1024, (const u16*)(ws + OFF_WINT), 1024, T, 2560, 1024, E, bid, nblk, smem);
}

DI void unpack8(const uint4& r, float (&v)[8]) {
  v[0] = bflo(r.x); v[1] = bfhi(r.x); v[2] = bflo(r.y); v[3] = bfhi(r.y); v[4] = bflo(r.z); v[5] = bfhi(r.z); v[6] = bflo(r.w); v[7] = bfhi(r.w);
}
DI uint4 pack8(const float (&v)[8]) { return make_uint4(pack2(v[0], v[1]), pack2(v[2], v[3]), pack2(v[4], v[5]), pack2(v[6], v[7])); }
DI float sumsq8(const uint4& r) { float v[8]; unpack8(r, v); float s = 0.f;
#pragma unroll
  for (int i = 0; i < 8; ++i) s += v[i] * v[i];
  return s; }
DI void phase_2a(const Params& p, int bid, int nblk, char* smem) {
  char* ws = p.ws;
  const u16* PM = (const u16*)(ws + OFF_PM);
  const u16* PR = (const u16*)(ws + OFF_PR);
  u16* LI = (u16*)(ws + OFF_LORAIN);
  const int tid = tid_(), wid = tid >> 6, lane = tid & 63;
  float mu[8];
#pragma unroll
  for (int j = 0; j < 8; ++j) mu[j] = lane < 32 ? p.rwkv_mu[1536 + 8 * lane + j] : 0.f;
  const uint4 zero4 = make_uint4(0u, 0u, 0u, 0u);
#define LD_PR(t_, r3) do { r3 = zero4; if (lane < 32) r3 = *(const uint4*)(PR + (size_t)(t_) * RWC + 1536 + 8 * lane); } while (0)
#define LD_PM(t_, a_, b_) do { a_ = *(const uint4*)(PM + (size_t)(t_) * MLAC + 8 * lane); \
    b_ = zero4; if (lane < 16) b_ = *(const uint4*)(PM + (size_t)(t_) * MLAC + 512 + 8 * lane); } while (0)
  for (int run = bid * NW + wid; run < T / 16; run += nblk * NW) {
    const int t0 = run * 16;
    uint4 p3 = zero4, c3, n3 = zero4, pa, pb, pan = zero4, pbn = zero4;
    if ((t0 % SEQ) != 0) LD_PR(t0 - 1, p3);
    LD_PR(t0, c3); LD_PM(t0, pa, pb);
    for (int tt = 0; tt < 16; ++tt) {
      const int t = t0 + tt;
      if (tt < 15) { LD_PR(t + 1, n3); LD_PM(t + 1, pan, pbn); }
      {
        const float sa = sumsq8(pa);
        float sq = lane < 48 ? sa : 0.f, skv = lane < 48 ? 0.f : sa;
        skv += sumsq8(pb);
        sq = wave_sum_u(sq); skv = wave_sum_u(skv);
        if (lane == 0) {
          ((float*)(ws + OFF_RSTDQ))[t] = rsqrtf(sq * (1.f / 384.f) + EPS);
          ((float*)(ws + OFF_RSTDKV))[t] = rsqrtf(skv * (1.f / 256.f) + EPS);
        }
      }
      if (lane < 32) {
        float cv[8], pv[8], o[8];
        unpack8(c3, cv); unpack8(p3, pv);
#pragma unroll
        for (int j = 0; j < 8; ++j) o[j] = cv[j] + (pv[j] - cv[j]) * mu[j];
        if (lane < 8) {
#pragma unroll
          for (int j = 0; j < 8; ++j) o[j] = tanhf(o[j]);
        } else if (lane >= 16) {
#pragma unroll
          for (int j = 0; j < 8; ++j) o[j] = sigmoidf_(o[j]);
        }
        *(uint4*)(LI + (size_t)t * 256 + 8 * lane) = pack8(o);
      }
      p3 = c3; c3 = n3; pa = pan; pb = pbn;
    }
  }
#undef LD_PR
#undef LD_PM
}

DI void phase_2b(const Params& p, int bid, int nblk, char* smem) {
  char* ws = p.ws;
  const u16* PM = (const u16*)(ws + OFF_PM);
  { EpiRowScale E; E.O = (u16*)(ws + OFF_QRAW); E.ldc = 768; E.rstd = (const float*)(ws + OFF_RSTDQ);
    run_gemm(PM, MLAC, (const u16*)(ws + OFF_WUQT), 384, T, 768, 384, E, bid, nblk, smem); }
  { EpiRowScale E; E.O = (u16*)(ws + OFF_KVRAW); E.ldc = 1024; E.rstd = (const float*)(ws + OFF_RSTDKV);
    run_gemm(PM + 384, MLAC, (const u16*)(ws + OFF_WUKVT), 256, T, 1024, 256, E, (bid + 128) % nblk, nblk, smem); }
  { EpiLora E; E.U = (u16*)(ws + OFF_U); E.AA = (u16*)((char*)p.out + DO_AA); E.G = (u16*)(ws + OFF_G); E.w0 = p.w0; E.a0 = p.a0;
    run_gemm((const u16*)(ws + OFF_LORAIN), 256, (const u16*)(ws + OFF_WLT), 256, T, 1536, 256, E, bid, nblk, smem); }
}

DI void mla_finalize_head(const Params& p, int b, int h) {
  char* ws = p.ws;
  const u16* PM = (const u16*)(ws + OFF_PM);
  const u16* QRAW = (const u16*)(ws + OFF_QRAW);
  const u16* KVRAW = (const u16*)(ws + OFF_KVRAW);
  u16* Q = (u16*)((char*)p.out + DO_Q); u16* Kd = (u16*)((char*)p.out + DO_K);
  const float* rope = (const float*)(ws + OFF_ROPE);
  const int tid = tid_(), wid = tid >> 6, lane = tid & 63;
  const float QSCALE = 0.10206207261596575f * 1.4426950408889634f;
  const int grp = lane >> 4, k16 = lane & 15, e2 = 2 * k16;
  const bool second = k16 >= 8;
  float gq[6], gk[6];
#pragma unroll
  for (int i = 0; i < 3; ++i) {
    gq[2 * i] = p.g_qnorm[32 * i + e2] * QSCALE; gq[2 * i + 1] = p.g_qnorm[32 * i + e2 + 1] * QSCALE;
    gk[2 * i] = p.g_knorm[32 * i + e2]; gk[2 * i + 1] = p.g_knorm[32 * i + e2 + 1];
  }
  const int ir = e2 & 15;
  unsigned qa[3], ka[3], qan[3] = {0u, 0u, 0u}, kan[3] = {0u, 0u, 0u};
  float cs0, cs1, sn0, sn1, cs0n = 0.f, cs1n = 0.f, sn0n = 0.f, sn1n = 0.f;
#define LD_TOK(t_, qa_, ka_, c0_, c1_, s0_, s1_) do { \
    _Pragma("unroll") for (int i = 0; i < 3; ++i) qa_[i] = *(const unsigned*)(QRAW + (size_t)(t_) * 768 + h * 96 + 32 * i + e2); \
    _Pragma("unroll") for (int i = 0; i < 2; ++i) ka_[i] = *(const unsigned*)(KVRAW + (size_t)(t_) * 1024 + h * 64 + 32 * i + e2); \
    ka_[2] = *(const unsigned*)(PM + (size_t)(t_) * MLAC + 640 + e2); \
    c0_ = rope[(size_t)(t_) * 32 + ir]; c1_ = rope[(size_t)(t_) * 32 + ir + 1]; s0_ = rope[(size_t)(t_) * 32 + 16 + ir]; s1_ = rope[(size_t)(t_) * 32 + 16 + ir + 1]; } while (0)
  const int tbase = b * SEQ + 4 * wid + grp;
  LD_TOK(tbase, qa, ka, cs0, cs1, sn0, sn1);
  for (int it = 0; it < SEQ / 32; ++it) {
    const int t = tbase + 32 * it;
    if (it + 1 < SEQ / 32) LD_TOK(t + 32, qan, kan, cs0n, cs1n, sn0n, sn1n);
#pragma unroll
    for (int ps = 0; ps < 2; ++ps) {
      const bool isq = ps == 0;
      const unsigned r0 = isq ? qa[0] : ka[0], r1 = isq ? qa[1] : ka[1], r2 = isq ? qa[2] : ka[2];
      float v[6] = {bflo(r0), bfhi(r0), bflo(r1), bfhi(r1), bflo(r2), bfhi(r2)};
      float ss = 0.f;
#pragma unroll
      for (int i = 0; i < 6; ++i) ss += v[i] * v[i];
      ss = row16_allsum(ss);
      const float rs = rsqrtf(ss * (1.f / 96.f) + EPS);
#pragma unroll
      for (int i = 0; i < 6; ++i) v[i] *= rs * (isq ? gq[i] : gk[i]);
      const float o0 = dpp_ror<8>(v[4]), o1 = dpp_ror<8>(v[5]);
      if (!second) { v[4] = v[4] * cs0 - o0 * sn0; v[5] = v[5] * cs1 - o1 * sn1; }
      else { v[4] = o0 * sn0 + v[4] * cs0; v[5] = o1 * sn1 + v[5] * cs1; }
      u16* dst = (isq ? Q : Kd) + (size_t)t * 768 + h * 96 + e2;
      *(unsigned*)(dst) = pack2(v[0], v[1]); *(unsigned*)(dst + 32) = pack2(v[2], v[3]); *(unsigned*)(dst + 64) = pack2(v[4], v[5]);
    }
#pragma unroll
    for (int i = 0; i < 3; ++i) { qa[i] = qan[i]; ka[i] = kan[i]; }
    cs0 = cs0n; cs1 = cs1n; sn0 = sn0n; sn1 = sn1n;
  }
#undef LD_TOK
}

DI s16x4 tr_read(unsigned lds_addr) {
  s16x4 r;
  asm volatile("ds_read_b64_tr_b16 %0, %1\n\ts_waitcnt lgkmcnt(0)" : "=&v"(r) : "v"(lds_addr) : "memory");
  return r;
}
#define MFMA32(a, b, c) __builtin_amdgcn_mfma_f32_32x32x16_bf16((a), (b), (c), 0, 0, 0)

constexpr int KLD = 208, VLD = 192;
constexpr int ATT_KOFF = 0, ATT_VOFF = 64 * KLD;
DI void phase_attn(const Params& p, int bid, int nblk, char* smem) {
  char* ws = p.ws;
  const u16* Q = (const u16*)((char*)p.out + DO_Q);
  const u16* Kd = (const u16*)((char*)p.out + DO_K);
  const u16* KVRAW = (const u16*)(ws + OFF_KVRAW);
  u16* Y = (u16*)(ws + OFF_Y);
  const int tid = tid_(), w = tid >> 6, lane = tid & 63, r = lane & 31, hh = lane >> 5;
  const unsigned lds_base = (unsigned)(size_t)smem;
  for (int it = bid; it < 128 * nblk; it += nblk) {
    const int m = 7 - ((it / nblk) & 7), bh = (it / nblk / 8) * nblk + bid;
    if (bh >= 128) break;
    const int b = bh >> 3, h = bh & 7;
    if (m == 7) {
      mla_finalize_head(p, b, h);
      asm volatile("s_waitcnt vmcnt(0)" ::: "memory");
      __syncthreads();
    }
    const int t0 = b * SEQ + 256 * m;
    const int cw = 4 * m + (w >> 1);
    const int tq = t0 + 32 * w + r;
    bf16x8 qf[6];
#pragma unroll
    for (int ks = 0; ks < 6; ++ks) qf[ks] = *reinterpret_cast<const bf16x8*>(Q + (size_t)tq * 768 + h * 96 + 16 * ks + 8 * hh);
    f32x16 O0, O1;
#pragma unroll
    for (int i = 0; i < 16; ++i) { O0[i] = 0.f; O1[i] = 0.f; }
    float mrun = -1e30f, lrun = 0.f;
    const int nkt = 4 * m + 4;
    uint4 kreg0, kreg1, vreg;
    const int krow0 = tid / 12, kcc0 = tid % 12, krow1 = (tid + 512) / 12, kcc1 = (tid + 512) % 12, vrow = tid >> 3, vcc = tid & 7;
    auto gload_kv = [&](int kt) {
      const int tk0 = b * SEQ + 64 * kt;
      kreg0 = *(const uint4*)(Kd + (size_t)(tk0 + krow0) * 768 + h * 96 + kcc0 * 8);
      if (tid < 256) kreg1 = *(const uint4*)(Kd + (size_t)(tk0 + krow1) * 768 + h * 96 + kcc1 * 8);
      vreg = *(const uint4*)(KVRAW + (size_t)(tk0 + vrow) * 1024 + 512 + h * 64 + vcc * 8);
    };
    gload_kv(0);
    for (int kt = 0; kt < nkt; ++kt) {
      __syncthreads();
      *(uint4*)(smem + ATT_KOFF + krow0 * KLD + kcc0 * 16) = kreg0;
      if (tid < 256) *(uint4*)(smem + ATT_KOFF + krow1 * KLD + kcc1 * 16) = kreg1;
      *(uint4*)(smem + ATT_VOFF + vrow * VLD + vcc * 16) = vreg;
      __syncthreads();
      if (kt + 1 < nkt) gload_kv(kt + 1);
      if (kt <= cw) {
        f32x16 X[2];
#pragma unroll
        for (int sub = 0; sub < 2; ++sub) {
#pragma unroll
          for (int i = 0; i < 16; ++i) X[sub][i] = 0.f;
#pragma unroll
          for (int ks = 0; ks < 6; ++ks) {
            const bf16x8 a = *reinterpret_cast<const bf16x8*>(smem + ATT_KOFF + (32 * sub + r) * KLD + (16 * ks + 8 * hh) * 2);
            X[sub] = MFMA32(a, qf[ks], X[sub]);
          }
        }
        float mx = X[0][0];
#pragma unroll
        for (int i = 0; i < 16; ++i) { mx = fmaxf(mx, X[0][i]); mx = fmaxf(mx, X[1][i]); }
        mx = fmaxf(mx, __shfl_xor(mx, 32));
        const float mnew = fmaxf(mrun, mx);
        const float alpha = __builtin_amdgcn_exp2f(mrun - mnew);
        mrun = mnew;
        float rsum = 0.f;
#pragma unroll
        for (int sub = 0; sub < 2; ++sub)
#pragma unroll
          for (int i = 0; i < 16; ++i) { const float e = __builtin_amdgcn_exp2f(X[sub][i] - mnew); X[sub][i] = e; rsum += e; }
        lrun = lrun * alpha + rsum;
        if (__any(alpha != 1.f)) {
#pragma unroll
          for (int i = 0; i < 16; ++i) { O0[i] *= alpha; O1[i] *= alpha; }
        }
        const int i16 = lane & 15, q4 = i16 >> 2, p4 = i16 & 3, blk = (lane >> 4) & 1;
        const unsigned vb = lds_base + ATT_VOFF + (4 * hh + q4) * VLD + (16 * blk) * 2 + 8 * p4;
        s16x4 vf[16];
        asm volatile(
            "ds_read_b64_tr_b16 %0, %16 offset:0\n\tds_read_b64_tr_b16 %1, %16 offset:1536\n\t"
            "ds_read_b64_tr_b16 %2, %16 offset:64\n\tds_read_b64_tr_b16 %3, %16 offset:1600\n\t"
            "ds_read_b64_tr_b16 %4, %16 offset:3072\n\tds_read_b64_tr_b16 %5, %16 offset:4608\n\t"
            "ds_read_b64_tr_b16 %6, %16 offset:3136\n\tds_read_b64_tr_b16 %7, %16 offset:4672\n\t"
            "ds_read_b64_tr_b16 %8, %16 offset:6144\n\tds_read_b64_tr_b16 %9, %16 offset:7680\n\t"
            "ds_read_b64_tr_b16 %10, %16 offset:6208\n\tds_read_b64_tr_b16 %11, %16 offset:7744\n\t"
            "ds_read_b64_tr_b16 %12, %16 offset:9216\n\tds_read_b64_tr_b16 %13, %16 offset:10752\n\t"
            "ds_read_b64_tr_b16 %14, %16 offset:9280\n\tds_read_b64_tr_b16 %15, %16 offset:10816\n\t"
            "s_waitcnt lgkmcnt(0)"
            : "=&v"(vf[0]), "=&v"(vf[1]), "=&v"(vf[2]), "=&v"(vf[3]), "=&v"(vf[4]), "=&v"(vf[5]), "=&v"(vf[6]), "=&v"(vf[7]),
              "=&v"(vf[8]), "=&v"(vf[9]), "=&v"(vf[10]), "=&v"(vf[11]), "=&v"(vf[12]), "=&v"(vf[13]), "=&v"(vf[14]), "=&v"(vf[15])
            : "v"(vb)
            : "memory");
#pragma unroll
        for (int sub = 0; sub < 2; ++sub) {
#pragma unroll
          for (int s = 0; s < 2; ++s) {
            const uint4 pbu = make_uint4(cvt_pk_bf16(X[sub][8 * s], X[sub][8 * s + 1]), cvt_pk_bf16(X[sub][8 * s + 2], X[sub][8 * s + 3]),
                                         cvt_pk_bf16(X[sub][8 * s + 4], X[sub][8 * s + 5]), cvt_pk_bf16(X[sub][8 * s + 6], X[sub][8 * s + 7]));
            const bf16x8 pb = __builtin_bit_cast(bf16x8, pbu);
#pragma unroll
            for (int dt = 0; dt < 2; ++dt) {
              const int vi = ((sub * 2 + s) * 2 + dt) * 2;
              const bf16x8 a = __builtin_shufflevector(vf[vi], vf[vi + 1], 0, 1, 2, 3, 4, 5, 6, 7);
              if (dt == 0) O0 = MFMA32(a, pb, O0); else O1 = MFMA32(a, pb, O1);
            }
          }
        }
      }
    }
    const float ltot = lrun + __shfl_xor(lrun, 32);
    const float inv = 1.f / ltot;
    float ss = 0.f;
#pragma unroll
    for (int i = 0; i < 16; ++i) { O0[i] *= inv; O1[i] *= inv; ss += O0[i] * O0[i] + O1[i] * O1[i]; }
    ss += __shfl_xor(ss, 32);
    const float rs = rsqrtf(ss * (1.f / 64.f) + EPS);
#pragma unroll
    for (int dt = 0; dt < 2; ++dt)
#pragma unroll
      for (int gq = 0; gq < 4; ++gq) {
        const int d = 32 * dt + 8 * gq + 4 * hh;
        const float* gp = p.g_attn_out + h * 64 + d;
        float o[4];
#pragma unroll
        for (int j = 0; j < 4; ++j) o[j] = (dt == 0 ? O0[4 * gq + j] : O1[4 * gq + j]) * rs * gp[j];
        *(uint2*)(Y + (size_t)tq * 1024 + h * 64 + d) = make_uint2(pack2(o[0], o[1]), pack2(o[2], o[3]));
      }
  }
}

constexpr int SC_CH = 32, SC_VOFF = 5 * SC_CH * 64, SC_BUFB = (SC_VOFF + SC_CH * 64) * 4;
constexpr int SC_YOFF = 2 * SC_BUFB;
typedef float f2v __attribute__((ext_vector_type(2)));
DI void phase_scan(const Params& p, int bid, int nblk, char* smem) {
  char* ws = p.ws;
  const u16* U = (const u16*)(ws + OFF_U); const u16* AA = (const u16*)((char*)p.out + DO_AA);
  const u16* PR = (const u16*)(ws + OFF_PR);
  const u16* G = (const u16*)(ws + OFF_G);
  u16* Y = (u16*)(ws + OFF_Y);
  const int tid = tid_(), w = tid >> 6, lane = tid & 63;
  const int g8 = lane >> 3, j8 = lane & 7;
  const int lt = tid & 255, st = lt >> 3, q8 = lt & 7;
  float* Ylb = (float*)(smem + SC_YOFF);
  for (int bh = bid; bh < 128; bh += nblk) {
    const int b = bh >> 3, h = bh & 7;
    const size_t tb = (size_t)b * SEQ;
    const int cj = h * 64 + 8 * q8;
    uint4 la, lu, lk, lr, lv, pk, pr, pv;
    const float* kkw = p.k_k + cj; const float* kaw = p.k_a + cj;
    const float* mur = p.rwkv_mu + cj; const float* muk = p.rwkv_mu + 512 + cj; const float* muv = p.rwkv_mu + 1024 + cj;
    auto gload = [&](int s0) {
      const size_t tok = tb + s0 + st;
      const size_t o = tok * 512 + cj;
      la = *(const uint4*)(AA + o); lu = *(const uint4*)(U + o);
      const u16* cur = PR + tok * RWC + cj;
      lr = *(const uint4*)(cur); lk = *(const uint4*)(cur + 512); lv = *(const uint4*)(cur + 1024);
      if (s0 + st > 0) { pr = *(const uint4*)(cur - RWC); pk = *(const uint4*)(cur - RWC + 512); pv = *(const uint4*)(cur - RWC + 1024); }
      else { pr = make_uint4(0u, 0u, 0u, 0u); pk = pr; pv = pr; }
    };
    auto shift8 = [&](const uint4& c, const uint4& pz, const float* mu, float (&o)[8]) {
      float cv[8], pvv[8]; unpack8(c, cv); unpack8(pz, pvv);
#pragma unroll
      for (int i = 0; i < 8; ++i) o[i] = cv[i] + (pvv[i] - cv[i]) * mu[i];
    };
    auto st8f = [&](float* dst, const float (&v)[8]) {
      *(float4*)dst = make_float4(v[0], v[1], v[2], v[3]); *(float4*)(dst + 4) = make_float4(v[4], v[5], v[6], v[7]);
    };
    auto st8 = [&](float* dst, const uint4& r) {
      float v[8]; unpack8(r, v);
      *(float4*)dst = make_float4(v[0], v[1], v[2], v[3]); *(float4*)(dst + 4) = make_float4(v[4], v[5], v[6], v[7]);
    };
    auto lstore = [&](int buf) {
      float* base = (float*)(smem + buf * SC_BUFB);
      const int o = st * 64 + 8 * q8;
      float kv[8], av[8], kkv[8], bb[8], k2[8], rsv[8], vsv[8];
      shift8(lk, pk, muk, kv); shift8(lr, pr, mur, rsv); shift8(lv, pv, muv, vsv); unpack8(la, av);
      float ss = 0.f;
#pragma unroll
      for (int i = 0; i < 8; ++i) { av[i] = sigmoidf_(av[i]); kkv[i] = kv[i] * kkw[i]; ss += kkv[i] * kkv[i]; }
      ss = row8_allsum(ss);
      const float inv = 1.f / fmaxf(sqrtf(ss), 1e-12f);
#pragma unroll
      for (int i = 0; i < 8; ++i) { kkv[i] *= inv; bb[i] = kkv[i] * av[i]; k2[i] = kv[i] * (1.f + (av[i] - 1.f) * kaw[i]); }
      st8f(base + o, kkv);
      {
        const unsigned uw[4] = {lu.x, lu.y, lu.z, lu.w};
        float d[8];
#pragma unroll
        for (int i = 0; i < 4; ++i) {
          d[2 * i] = __expf(-0.6065306597126334f * sigmoidf_(h2f_lo(uw[i])));
          d[2 * i + 1] = __expf(-0.6065306597126334f * sigmoidf_(h2f_hi(uw[i])));
        }
        st8f(base + SC_CH * 64 + o, d);
      }
      st8f(base + 2 * SC_CH * 64 + o, bb);
      st8f(base + 3 * SC_CH * 64 + o, k2);
      st8f(base + 4 * SC_CH * 64 + o, rsv);
      st8f(base + SC_VOFF + o, vsv);
    };
    float lnw[8], lnb[8], rk[8];
#pragma unroll
    for (int i = 0; i < 8; ++i) { lnw[i] = p.ln_x_w[cj + i]; lnb[i] = p.ln_x_b[cj + i]; rk[i] = p.r_k[cj + i]; }
    auto epilogue = [&](int c) {
      const float* base = (const float*)(smem + (c & 1) * SC_BUFB);
      const float* Yl = Ylb + (c & 1) * SC_CH * 64;
      const size_t tok = tb + c * SC_CH + st;
      const uint4 graw = *(const uint4*)(G + tok * 512 + cj);
      float y[8], r8[8], k8v[8], v8[8], gv[8];
      { const float4 a = *(const float4*)(Yl + st * 64 + 8 * q8), bq = *(const float4*)(Yl + st * 64 + 8 * q8 + 4);
        y[0] = a.x; y[1] = a.y; y[2] = a.z; y[3] = a.w; y[4] = bq.x; y[5] = bq.y; y[6] = bq.z; y[7] = bq.w; }
      { const float4 a = *(const float4*)(base + 4 * SC_CH * 64 + st * 64 + 8 * q8), bq = *(const float4*)(base + 4 * SC_CH * 64 + st * 64 + 8 * q8 + 4);
        r8[0] = a.x; r8[1] = a.y; r8[2] = a.z; r8[3] = a.w; r8[4] = bq.x; r8[5] = bq.y; r8[6] = bq.z; r8[7] = bq.w; }
      { const float4 a = *(const float4*)(base + 3 * SC_CH * 64 + st * 64 + 8 * q8), bq = *(const float4*)(base + 3 * SC_CH * 64 + st * 64 + 8 * q8 + 4);
        k8v[0] = a.x; k8v[1] = a.y; k8v[2] = a.z; k8v[3] = a.w; k8v[4] = bq.x; k8v[5] = bq.y; k8v[6] = bq.z; k8v[7] = bq.w; }
      { const float4 a = *(const float4*)(base + SC_VOFF + st * 64 + 8 * q8), bq = *(const float4*)(base + SC_VOFF + st * 64 + 8 * q8 + 4);
        v8[0] = a.x; v8[1] = a.y; v8[2] = a.z; v8[3] = a.w; v8[4] = bq.x; v8[5] = bq.y; v8[6] = bq.z; v8[7] = bq.w; }
      unpack8(graw, gv);
      float sm = 0.f, bsum = 0.f;
#pragma unroll
      for (int i = 0; i < 8; ++i) { sm += y[i]; bsum += r8[i] * k8v[i] * rk[i]; }
      const float mu = row8_allsum(sm) * (1.f / 64.f);
      const float bonus = row8_allsum(bsum);
      float var = 0.f;
#pragma unroll
      for (int i = 0; i < 8; ++i) { y[i] -= mu; var += y[i] * y[i]; }
      const float rs = rsqrtf(row8_allsum(var) * (1.f / 64.f) + 64e-5f);
      float o[8];
#pragma unroll
      for (int i = 0; i < 8; ++i) o[i] = (y[i] * rs * lnw[i] + lnb[i] + bonus * v8[i]) * gv[i];
      *(uint4*)(Y + tok * 1024 + 512 + cj) = pack8(o);
    };
    __syncthreads();
    if (w >= 4) { gload(0); lstore(0); }
    __syncthreads();
    f2v P[8];
#pragma unroll
    for (int m = 0; m < 8; ++m) P[m] = (f2v){0.f, 0.f};
    const int rp = 16 * w + 2 * g8;
    for (int c = 0; c < SEQ / SC_CH; ++c) {
      if (w < 4) {
        const float* base = (const float*)(smem + (c & 1) * SC_BUFB);
        float* Yl = Ylb + (c & 1) * SC_CH * 64;
        for (int sb = 0; sb < SC_CH; sb += 8) {
          float ypx[8], ypy[8];
          float4 kkA, kkB, wA, wB, bA, bB, kA, kB, rA, rB; f2v v2;
          auto lds_step = [&](int s, float4& kkA_, float4& kkB_, float4& wA_, float4& wB_, float4& bA_, float4& bB_, float4& kA_, float4& kB_,
                              float4& rA_, float4& rB_, f2v& v2_) {
            const float* q = base + s * 64 + 8 * j8;
            kkA_ = *(const float4*)q; kkB_ = *(const float4*)(q + 4);
            wA_ = *(const float4*)(q + SC_CH * 64); wB_ = *(const float4*)(q + SC_CH * 64 + 4);
            bA_ = *(const float4*)(q + 2 * SC_CH * 64); bB_ = *(const float4*)(q + 2 * SC_CH * 64 + 4);
            kA_ = *(const float4*)(q + 3 * SC_CH * 64); kB_ = *(const float4*)(q + 3 * SC_CH * 64 + 4);
            rA_ = *(const float4*)(q + 4 * SC_CH * 64); rB_ = *(const float4*)(q + 4 * SC_CH * 64 + 4);
            v2_ = *(const f2v*)(base + SC_VOFF + s * 64 + rp);
          };
          lds_step(sb, kkA, kkB, wA, wB, bA, bB, kA, kB, rA, rB, v2);
#pragma unroll
          for (int s8 = 0; s8 < 8; ++s8) {
            float4 kkAn, kkBn, wAn, wBn, bAn, bBn, kAn, kBn, rAn, rBn; f2v v2n;
            if (s8 < 7) lds_step(sb + s8 + 1, kkAn, kkBn, wAn, wBn, bAn, bBn, kAn, kBn, rAn, rBn, v2n);
            __builtin_amdgcn_sched_barrier(0);
            f2v ska = P[0] * kkA.x + P[1] * kkA.y + P[2] * kkA.z + P[3] * kkA.w;
            f2v skb = P[4] * kkB.x + P[5] * kkB.y + P[6] * kkB.z + P[7] * kkB.w;
            f2v sk = ska + skb;
            { float sx = sk.x, sy = sk.y; row8_allsum2(sx, sy); sk.x = sx; sk.y = sy; }
            P[0] = P[0] * wA.x - sk * bA.x + v2 * kA.x; P[1] = P[1] * wA.y - sk * bA.y + v2 * kA.y;
            P[2] = P[2] * wA.z - sk * bA.z + v2 * kA.z; P[3] = P[3] * wA.w - sk * bA.w + v2 * kA.w;
            P[4] = P[4] * wB.x - sk * bB.x + v2 * kB.x; P[5] = P[5] * wB.y - sk * bB.y + v2 * kB.y;
            P[6] = P[6] * wB.z - sk * bB.z + v2 * kB.z; P[7] = P[7] * wB.w - sk * bB.w + v2 * kB.w;
            const f2v ya = P[0] * rA.x + P[1] * rA.y + P[2] * rA.z + P[3] * rA.w;
            const f2v yb = P[4] * rB.x + P[5] * rB.y + P[6] * rB.z + P[7] * rB.w;
            const f2v y = ya + yb;
            ypx[s8] = y.x; ypy[s8] = y.y;
            if (s8 < 7) { kkA = kkAn; kkB = kkBn; wA = wAn; wB = wBn; bA = bAn; bB = bBn; kA = kAn; kB = kBn; rA = rAn; rB = rBn; v2 = v2n; }
          }
          { const int k8 = j8;
            RS8_STEP(ypx, 4, 4, 0x141) RS8_STEP(ypy, 4, 4, 0x141)
            RS8_STEP(ypx, 2, 2, 0x4E)  RS8_STEP(ypy, 2, 2, 0x4E)
            RS8_STEP(ypx, 1, 1, 0xB1)  RS8_STEP(ypy, 1, 1, 0xB1) }
          *(f2v*)(Yl + (sb + j8) * 64 + rp) = (f2v){ypx[0], ypy[0]};
        }
      } else {
        const bool more = c + 1 < SEQ / SC_CH;
        if (more) gload((c + 1) * SC_CH);
        if (c >= 1) epilogue(c - 1);
        if (more) lstore((c + 1) & 1);
      }
      __syncthreads();
    }
    if (w >= 4) epilogue(SEQ / SC_CH - 1);
  }
}

DI void expert_convert(const Params& p, int bid, int nblk, char* smem);
DI void phase_mix(const Params& p, int bid, int nblk, char* smem) {
  const int half = nblk / 2;
  if (bid < half) phase_scan(p, bid, half, smem);
  else { phase_attn(p, bid - half, nblk - half, smem); expert_convert(p, bid - half, nblk - half, smem); }
}

DI void expert_convert(const Params& p, int bid, int nblk, char* smem) {
  char* ws = p.ws;
  const int tid = tid_();
  __syncthreads();
  tconv(p.w_o, 1024, 1024, nullptr, (u16*)(ws + OFF_WOT), 1024, 0, bid, nblk, (float*)smem);
  tconv(p.w_pq, 1024, 2048, p.g_ffn, (u16*)(ws + OFF_WPQT), 1024, 0, bid, nblk, (float*)smem);
  for (int i = bid * NTHR + tid; i < 16 * 128 * 128; i += nblk * NTHR) ((u16*)(ws + OFF_SUBK))[i] = f2bf(p.sub_keys[i]);
  {
    unsigned* EU = (unsigned*)(ws + OFF_EU); unsigned* EV = (unsigned*)(ws + OFF_EV);
    const float4* su = (const float4*)p.expert_u; const float4* sv = (const float4*)p.expert_v;
    const float4* gf = (const float4*)p.g_ffn;
    for (size_t i = (size_t)bid * NTHR + tid; i < (size_t)16384 * 256; i += (size_t)nblk * NTHR) {
      const float4 g = gf[i & 255];
      const float4 a = su[i], b = sv[i];
      int pu = 0, pv = 0;
      {
        const int q0 = (int)fminf(fmaxf(rintf(a.x * g.x * SUI), -127.f), 127.f), q1 = (int)fminf(fmaxf(rintf(a.y * g.y * SUI), -127.f), 127.f);
        const int q2 = (int)fminf(fmaxf(rintf(a.z * g.z * SUI), -127.f), 127.f), q3 = (int)fminf(fmaxf(rintf(a.w * g.w * SUI), -127.f), 127.f);
        pu = (q0 & 255) | ((q1 & 255) << 8) | ((q2 & 255) << 16) | ((q3 & 255) << 24);
      }
      pv = __builtin_amdgcn_cvt_pk_fp8_f32(b.x * SV8, b.y * SV8, pv, false);
      pv = __builtin_amdgcn_cvt_pk_fp8_f32(b.z * SV8, b.w * SV8, pv, true);
      EU[i] = (unsigned)pu; EV[i] = (unsigned)pv;
    }
  }
}

DI void phase_wo(const Params& p, int bid, int nblk, char* smem) {
  char* ws = p.ws;
  const int tid = tid_();
  EpiWo E; E.out = p.out; E.x = p.x; E.x2b = (u16*)(ws + OFF_X2B); E.ss2 = (unsigned long long*)(ws + OFF_SS2);
  run_gemm((const u16*)(ws + OFF_Y), 1024, (const u16*)(ws + OFF_WOT), 1024, T, 1024, 1024, E, bid, nblk, smem);
}

DI void phase_5(const Params& p, int bid, int nblk, char* smem) {
  char* ws = p.ws;
  const int tid = tid_(), wid = tid >> 6, lane = tid & 63;
  for (int row = bid * NW + wid; row < T; row += nblk * NW) {
    const float4* xr = (const float4*)(p.out + (size_t)row * DM);
    uint2* xb = (uint2*)(ws + OFF_X2B + (size_t)row * DM * 2);
    float ss = 0.f;
#pragma unroll
    for (int i = 0; i < 4; ++i) {
      const float4 v = xr[lane + 64 * i];
      ss += v.x * v.x + v.y * v.y + v.z * v.z + v.w * v.w;
      xb[lane + 64 * i] = make_uint2(pack2(v.x, v.y), pack2(v.z, v.w));
    }
    ss = wave_allsum(ss);
    if (lane == 0) ((float*)(ws + OFF_RSTD2))[row] = rsqrtf(ss * (1.f / DM) + EPS);
  }
}

DI void phase_6(const Params& p, int bid, int nblk, char* smem) {
  char* ws = p.ws;
  EpiRowScaleT<true> E; E.O = (u16*)(ws + OFF_QP); E.ldc = 2048; E.rstd = (const float*)(ws + OFF_SS2);
  run_gemm((const u16*)(ws + OFF_X2B), 1024, (const u16*)(ws + OFF_WPQT), 1024, T, 2048, 1024, E, bid, nblk, smem);
}

DI void ins16(float (&top)[16], float x) {
#pragma unroll
  for (int i = 0; i < 16; ++i) { const float hi = fmaxf(top[i], x); x = fminf(top[i], x); top[i] = hi; }
}
#define CEX(a, b) do { const float _h = fmaxf(a, b), _l = fminf(a, b); a = _h; b = _l; } while (0)
DI void sort16(float (&v)[16]) {
  CEX(v[0], v[1]);
  CEX(v[2], v[3]);
  CEX(v[0], v[2]);
  CEX(v[1], v[3]);
  CEX(v[1], v[2]);
  CEX(v[4], v[5]);
  CEX(v[6], v[7]);
  CEX(v[4], v[6]);
  CEX(v[5], v[7]);
  CEX(v[5], v[6]);
  CEX(v[0], v[4]);
  CEX(v[2], v[6]);
  CEX(v[2], v[4]);
  CEX(v[1], v[5]);
  CEX(v[3], v[7]);
  CEX(v[3], v[5]);
  CEX(v[1], v[2]);
  CEX(v[3], v[4]);
  CEX(v[5], v[6]);
  CEX(v[8], v[9]);
  CEX(v[10], v[11]);
  CEX(v[8], v[10]);
  CEX(v[9], v[11]);
  CEX(v[9], v[10]);
  CEX(v[12], v[13]);
  CEX(v[14], v[15]);
  CEX(v[12], v[14]);
  CEX(v[13], v[15]);
  CEX(v[13], v[14]);
  CEX(v[8], v[12]);
  CEX(v[10], v[14]);
  CEX(v[10], v[12]);
  CEX(v[9], v[13]);
  CEX(v[11], v[15]);
  CEX(v[11], v[13]);
  CEX(v[9], v[10]);
  CEX(v[11], v[12]);
  CEX(v[13], v[14]);
  CEX(v[0], v[8]);
  CEX(v[4], v[12]);
  CEX(v[4], v[8]);
  CEX(v[2], v[10]);
  CEX(v[6], v[14]);
  CEX(v[6], v[10]);
  CEX(v[2], v[4]);
  CEX(v[6], v[8]);
  CEX(v[10], v[12]);
  CEX(v[1], v[9]);
  CEX(v[5], v[13]);
  CEX(v[5], v[9]);
  CEX(v[3], v[11]);
  CEX(v[7], v[15]);
  CEX(v[7], v[11]);
  CEX(v[3], v[5]);
  CEX(v[7], v[9]);
  CEX(v[11], v[13]);
  CEX(v[1], v[2]);
  CEX(v[3], v[4]);
  CEX(v[5], v[6]);
  CEX(v[7], v[8]);
  CEX(v[9], v[10]);
  CEX(v[11], v[12]);
  CEX(v[13], v[14]);
}
DI void merge16(float (&A)[16], const float (&B)[16]) {
#pragma unroll
  for (int i = 0; i < 16; ++i) A[i] = fmaxf(A[i], B[15 - i]);
#pragma unroll
  for (int d = 8; d >= 1; d >>= 1)
#pragma unroll
    for (int i = 0; i < 16; ++i)
      if ((i & d) == 0) CEX(A[i], A[i + d]);
}
constexpr int TK_SKLD = 272;
constexpr int TK_L1 = 2 * 128 * TK_SKLD;
constexpr int TK_L2 = TK_L1 + 128 * 2 * 16 * 4;
DI void phase_7(const Params& p, int bid, int nblk, char* smem) {
  char* ws = p.ws;
  const u16* QP = (const u16*)(ws + OFF_QP);
  const u16* SUBK = (const u16*)(ws + OFF_SUBK);
  u16* IDX = (u16*)(ws + OFF_IDX); float* GATE = (float*)(ws + OFF_GATE);
  float* lists = (float*)(smem + TK_L1);
  float* lists2 = (float*)(smem + TK_L2);
  const int tid = tid_(), w = tid >> 6, lane = tid & 63, r = lane & 31, hh = lane >> 5;
  const int th = w & 3, pp = w >> 2;
  {
    const unsigned long long* ss2 = (const unsigned long long*)(ws + OFF_SS2);
    const uint2* xb = (const uint2*)(ws + OFF_X2B);
    unsigned* xq = (unsigned*)(ws + OFF_X2Q);
    for (size_t i = (size_t)bid * NTHR + tid; i < (size_t)T * 256; i += (size_t)nblk * NTHR) {
      const float sc = rsqrtf(ss2_get(ss2, (int)(i >> 8)) * (1.f / DM) + EPS) * SXI;
      const uint2 v = xb[i];
      const int q0 = (int)fminf(fmaxf(rintf(bflo(v.x) * sc), -127.f), 127.f), q1 = (int)fminf(fmaxf(rintf(bfhi(v.x) * sc), -127.f), 127.f);
      const int q2 = (int)fminf(fmaxf(rintf(bflo(v.y) * sc), -127.f), 127.f), q3 = (int)fminf(fmaxf(rintf(bfhi(v.y) * sc), -127.f), 127.f);
      xq[i] = (unsigned)((q0 & 255) | ((q1 & 255) << 8) | ((q2 & 255) << 16) | ((q3 & 255) << 24));
    }
  }
  int hcur = -1;
  for (int it = bid; it < 256 * 8; it += nblk) {
    const int tt = it >> 3, h = it & 7;
    if (h != hcur) {
      __syncthreads();
      for (int c = tid; c < 2 * 128 * 16; c += NTHR) {
        const int row = c >> 4, cc = c & 15;
        *(uint4*)(smem + row * TK_SKLD + cc * 16) = *(const uint4*)(SUBK + ((size_t)h * 256 + row) * 128 + cc * 8);
      }
      hcur = h;
      __syncthreads();
    }
    const int t = tt * 128 + 32 * th + r;
    bf16x8 qf[8];
#pragma unroll
    for (int ks = 0; ks < 8; ++ks) qf[ks] = *reinterpret_cast<const bf16x8*>(QP + (size_t)t * 2048 + h * 256 + pp * 128 + 16 * ks + 8 * hh);
    float top[16];
#pragma unroll
    for (int kt = 0; kt < 4; ++kt) {
      f32x16 acc;
#pragma unroll
      for (int i = 0; i < 16; ++i) acc[i] = 0.f;
#pragma unroll
      for (int ks = 0; ks < 8; ++ks) {
        const bf16x8 a = *reinterpret_cast<const bf16x8*>(smem + (pp * 128 + 32 * kt + r) * TK_SKLD + (16 * ks + 8 * hh) * 2);
        acc = MFMA32(a, qf[ks], acc);
      }
      float g[16];
#pragma unroll
      for (int i = 0; i < 16; ++i) {
        const unsigned key = 32 * kt + (i & 3) + 8 * (i >> 2) + 4 * hh;
        g[i] = __uint_as_float((__float_as_uint(acc[i]) & ~127u) | key);
      }
      sort16(g);
      if (kt == 0) {
#pragma unroll
        for (int i = 0; i < 16; ++i) top[i] = g[i];
      } else merge16(top, g);
    }
    {
      float oth[16];
#pragma unroll
      for (int i = 0; i < 16; ++i) oth[i] = __shfl_xor(top[i], 32);
      merge16(top, oth);
    }
    __syncthreads();
    if (hh == 0) {
      float* dst = lists + ((32 * th + r) * 2 + pp) * 16;
#pragma unroll
      for (int i = 0; i < 16; i += 4) *(float4*)(dst + i) = make_float4(top[i], top[i + 1], top[i + 2], top[i + 3]);
    }
    __syncthreads();
    {
      const int tl = tid & 127, q = tid >> 7;
      const float* l1 = lists + (tl * 2 + 0) * 16;
      const float* l2 = lists + (tl * 2 + 1) * 16;
      float ts[16];
#pragma unroll
      for (int i = 0; i < 16; ++i) ts[i] = -INFINITY;
#define CANDV(a, b) __uint_as_float((__float_as_uint(__uint_as_float(__float_as_uint(l1[a]) & ~127u) + __uint_as_float(__float_as_uint(l2[b]) & ~127u)) & ~255u) | (unsigned)(255 - ((a) * 16 + (b))))
      switch (q) {
      case 0:
        ts[0] = CANDV(0, 0);
        ts[1] = CANDV(0, 1);
        ts[2] = CANDV(0, 2);
        ts[3] = CANDV(0, 3);
        ts[4] = CANDV(0, 4);
        ts[5] = CANDV(0, 5);
        ts[6] = CANDV(0, 6);
        ts[7] = CANDV(0, 7);
        ts[8] = CANDV(0, 8);
        ts[9] = CANDV(0, 9);
        ts[10] = CANDV(0, 10);
        ts[11] = CANDV(0, 11);
        ts[12] = CANDV(0, 12);
        ts[13] = CANDV(0, 13);
        ts[14] = CANDV(0, 14);
        ts[15] = CANDV(0, 15);
        ins16(ts, CANDV(4, 0));
        ins16(ts, CANDV(4, 1));
        ins16(ts, CANDV(4, 2));
        ins16(ts, CANDV(8, 0));
        ins16(ts, CANDV(12, 0));
        break;
      case 1:
        ts[0] = CANDV(1, 0);
        ts[1] = CANDV(1, 1);
        ts[2] = CANDV(1, 2);
        ts[3] = CANDV(1, 3);
        ts[4] = CANDV(1, 4);
        ts[5] = CANDV(1, 5);
        ts[6] = CANDV(1, 6);
        ts[7] = CANDV(1, 7);
        ins16(ts, CANDV(5, 0));
        ins16(ts, CANDV(5, 1));
        ins16(ts, CANDV(9, 0));
        ins16(ts, CANDV(13, 0));
        break;
      case 2:
        ts[0] = CANDV(2, 0);
        ts[1] = CANDV(2, 1);
        ts[2] = CANDV(2, 2);
        ts[3] = CANDV(2, 3);
        ts[4] = CANDV(2, 4);
        ins16(ts, CANDV(6, 0));
        ins16(ts, CANDV(6, 1));
        ins16(ts, CANDV(10, 0));
        ins16(ts, CANDV(14, 0));
        break;
      case 3:
        ts[0] = CANDV(3, 0);
        ts[1] = CANDV(3, 1);
        ts[2] = CANDV(3, 2);
        ts[3] = CANDV(3, 3);
        ins16(ts, CANDV(7, 0));
        ins16(ts, CANDV(7, 1));
        ins16(ts, CANDV(11, 0));
        ins16(ts, CANDV(15, 0));
        break;
      }
#undef CANDV
      float* dst = lists2 + (tl * 4 + q) * 16;
#pragma unroll
      for (int i = 0; i < 16; i += 4) *(float4*)(dst + i) = make_float4(ts[i], ts[i + 1], ts[i + 2], ts[i + 3]);
    }
    __syncthreads();
    if (tid < 128) {
      const float* l1 = lists + (tid * 2 + 0) * 16;
      const float* l2 = lists + (tid * 2 + 1) * 16;
      float ts[16], tb[16];
#pragma unroll
      for (int i = 0; i < 16; ++i) { ts[i] = lists2[(tid * 4 + 0) * 16 + i]; tb[i] = lists2[(tid * 4 + 1) * 16 + i]; }
      merge16(ts, tb);
      float tc[16];
#pragma unroll
      for (int i = 0; i < 16; ++i) { tc[i] = lists2[(tid * 4 + 2) * 16 + i]; tb[i] = lists2[(tid * 4 + 3) * 16 + i]; }
      merge16(tc, tb);
      merge16(ts, tc);
      const size_t ob = ((size_t)(tt * 128 + tid) * 8 + h) * 16;
      float e[16], esum = 0.f;
      const float mx = __uint_as_float(__float_as_uint(ts[0]) & ~255u);
#pragma unroll
      for (int i = 0; i < 16; ++i) {
        const unsigned bits = __float_as_uint(ts[i]);
        const unsigned cid = 255u - (bits & 255u);
        const float val = __uint_as_float(bits & ~255u);
        e[i] = __expf(val - mx); esum += e[i];
        const unsigned i1 = __float_as_uint(l1[cid >> 4]) & 127u, i2 = __float_as_uint(l2[cid & 15]) & 127u;
        IDX[ob + i] = (u16)(i1 * 128 + i2);
      }
      const float inv = 1.f / esum;
#pragma unroll
      for (int i = 0; i < 16; ++i) GATE[ob + i] = e[i] * inv;
    }
  }
}

typedef __bf16 bf2_t __attribute__((ext_vector_type(2)));
DI float dot2bf(unsigned a, unsigned b, float c) {
  return __builtin_amdgcn_fdot2_f32_bf16(__builtin_bit_cast(bf2_t, a), __builtin_bit_cast(bf2_t, b), c, false);
}
DI unsigned xcc_id_() { return (unsigned)__builtin_amdgcn_s_getreg((3 << 11) | 20) & 0xFu; }
DI unsigned idx_get(const uint4& a, const uint4& b, int j) {
  const unsigned w = j < 8 ? (j < 2 ? a.x : j < 4 ? a.y : j < 6 ? a.z : a.w) : (j < 10 ? b.x : j < 12 ? b.y : j < 14 ? b.z : b.w);
  return (j & 1) ? (w >> 16) : (w & 0xffffu);
}

typedef float f32x2_t __attribute__((ext_vector_type(2)));
DI void fp8x16_to_f32(const uint4& r, float (&v)[16]) {
  const unsigned w[4] = {r.x, r.y, r.z, r.w};
#pragma unroll
  for (int q = 0; q < 4; ++q) {
    const f32x2_t lo = __builtin_amdgcn_cvt_pk_f32_fp8((int)w[q], false);
    const f32x2_t hi = __builtin_amdgcn_cvt_pk_f32_fp8((int)w[q], true);
    v[4 * q] = lo.x; v[4 * q + 1] = lo.y; v[4 * q + 2] = hi.x; v[4 * q + 3] = hi.y;
  }
}
DI void pin4(uint4& r) { asm volatile("" : "+v"(r.x), "+v"(r.y), "+v"(r.z), "+v"(r.w)); }
DI void pin16(float (&a)[16]) {
  asm volatile("" : "+v"(a[0]), "+v"(a[1]), "+v"(a[2]), "+v"(a[3]), "+v"(a[4]), "+v"(a[5]), "+v"(a[6]), "+v"(a[7]),
                    "+v"(a[8]), "+v"(a[9]), "+v"(a[10]), "+v"(a[11]), "+v"(a[12]), "+v"(a[13]), "+v"(a[14]), "+v"(a[15]));
}
template <int CTRL> DI int dpp_movi(int v) { return __builtin_amdgcn_update_dpp(0, v, CTRL, 0xF, 0xF, false); }
#define RS8I_STEP(arr, n, bit, CTRL) _Pragma("unroll") for (int _j = 0; _j < (n); ++_j) { \
    const bool _hi = (k8 & (bit)) != 0; const int _keep = _hi ? arr[_j + (n)] : arr[_j], _send = _hi ? arr[_j] : arr[_j + (n)]; \
    arr[_j] = _keep + dpp_movi<CTRL>(_send); }
DI void peer_u_item(const Params& p, int s, int tw) {
  char* ws = p.ws;
  const unsigned char* X2Q = (const unsigned char*)(ws + OFF_X2Q);
  const unsigned char* EU = (const unsigned char*)(ws + OFF_EU);
  const u16* IDX = (const u16*)(ws + OFF_IDX);
  float* PART = (float*)(ws + OFF_PART) + (size_t)s * T * 128;
  const int lane = tid_() & 63, g8 = lane >> 3, c = lane & 7;
  const size_t coff = 128 * s + 16 * c;
  const unsigned char* EUs = EU + 128 * s; const unsigned lo16 = 16u * c;
  uint4 i0 = *(const uint4*)(IDX + (size_t)tw * 128 + 16 * g8);
  uint4 i1 = *(const uint4*)(IDX + (size_t)tw * 128 + 16 * g8 + 8);
  for (int tt = 0; tt < 16; ++tt) {
    const int t = tw + tt;
    const uint4 xa = *(const uint4*)(X2Q + (size_t)t * DM + coff);
    uint4 rows[16];
#pragma unroll
    for (int j = 0; j < 16; ++j) rows[j] = *(const uint4*)(EUs + (idx_get(i0, i1, j) * 1024u + lo16));
    if (tt < 15) {
      i0 = *(const uint4*)(IDX + (size_t)(t + 1) * 128 + 16 * g8);
      i1 = *(const uint4*)(IDX + (size_t)(t + 1) * 128 + 16 * g8 + 8);
    }
    int r[16];
#pragma unroll
    for (int j = 0; j < 16; ++j) {
      int d = __builtin_amdgcn_sdot4((int)xa.x, (int)rows[j].x, 0, false);
      d = __builtin_amdgcn_sdot4((int)xa.y, (int)rows[j].y, d, false);
      d = __builtin_amdgcn_sdot4((int)xa.z, (int)rows[j].z, d, false);
      d = __builtin_amdgcn_sdot4((int)xa.w, (int)rows[j].w, d, false);
      r[j] = d;
    }
    { const int k8 = c;
      RS8I_STEP(r, 8, 4, 0x141) RS8I_STEP(r, 4, 2, 0x4E) RS8I_STEP(r, 2, 1, 0xB1) }
    *(float2*)(PART + (size_t)t * 128 + 2 * lane) = make_float2((float)r[0], (float)r[1]);
  }
}

DI void peer_v_item(const Params& p, int s, int tw) {
  char* ws = p.ws;
  const unsigned char* EV = (const unsigned char*)(ws + OFF_EV);
  const u16* IDX = (const u16*)(ws + OFF_IDX);
  const float* WGT = (const float*)(ws + OFF_WGT);
  const u16* X2B = (const u16*)(ws + OFF_X2B);
  const int lane = tid_() & 63, g8 = lane >> 3, c = lane & 7;
  const size_t coff = 128 * s + 16 * c;
  const unsigned char* EVs = EV + 128 * s; const unsigned lo16 = 16u * c;
  uint4 i0 = *(const uint4*)(IDX + (size_t)tw * 128 + 16 * g8);
  uint4 i1 = *(const uint4*)(IDX + (size_t)tw * 128 + 16 * g8 + 8);
  for (int tt = 0; tt < 16; ++tt) {
    const int t = tw + tt;
    unsigned wg[16];
    {
      const uint4* wp = (const uint4*)(WGT + (size_t)t * 128 + 16 * g8);
#pragma unroll
      for (int q = 0; q < 4; ++q) { const uint4 v = wp[q]; wg[4 * q] = v.x; wg[4 * q + 1] = v.y; wg[4 * q + 2] = v.z; wg[4 * q + 3] = v.w; }
    }
    uint4 rows[16];
#pragma unroll
    for (int j = 0; j < 16; ++j) rows[j] = *(const uint4*)(EVs + (idx_get(i0, i1, j) * 1024u + lo16));
    if (tt < 15) {
      i0 = *(const uint4*)(IDX + (size_t)(t + 1) * 128 + 16 * g8);
      i1 = *(const uint4*)(IDX + (size_t)(t + 1) * 128 + 16 * g8 + 8);
    }
    typedef _Float16 h2v __attribute__((ext_vector_type(2)));
    h2v ah[8];
#pragma unroll
    for (int i = 0; i < 8; ++i) ah[i] = (h2v){(_Float16)0.f, (_Float16)0.f};
#pragma unroll
    for (int j = 0; j < 16; ++j) {
      const unsigned rw[4] = {rows[j].x, rows[j].y, rows[j].z, rows[j].w};
      const h2v w2 = __builtin_bit_cast(h2v, wg[j]);
#pragma unroll
      for (int q = 0; q < 4; ++q) {
        ah[2 * q] = __builtin_elementwise_fma(__builtin_bit_cast(h2v, __builtin_amdgcn_cvt_scalef32_pk_f16_fp8(rw[q], 1.0f, false)), w2, ah[2 * q]);
        ah[2 * q + 1] = __builtin_elementwise_fma(__builtin_bit_cast(h2v, __builtin_amdgcn_cvt_scalef32_pk_f16_fp8(rw[q], 1.0f, true)), w2, ah[2 * q + 1]);
      }
    }
    float a[16];
#pragma unroll
    for (int i = 0; i < 8; ++i) { a[2 * i] = (float)ah[i].x * (1.f / SV8); a[2 * i + 1] = (float)ah[i].y * (1.f / SV8); }
    typedef unsigned u32x2_t __attribute__((ext_vector_type(2)));
#pragma unroll
    for (int i = 0; i < 8; ++i) {
      const u32x2_t sw = __builtin_amdgcn_permlane32_swap(__float_as_uint(a[i]), __float_as_uint(a[i + 8]), false, false);
      a[i] = __uint_as_float(sw.x) + __uint_as_float(sw.y);
    }
#pragma unroll
    for (int i = 0; i < 4; ++i) {
      const u32x2_t sw = __builtin_amdgcn_permlane16_swap(__float_as_uint(a[i]), __float_as_uint(a[i + 4]), false, false);
      a[i] = __uint_as_float(sw.x) + __uint_as_float(sw.y);
    }
#pragma unroll
    for (int i = 0; i < 2; ++i) { const bool hi = g8 & 1; const float keep = hi ? a[i + 2] : a[i], send = hi ? a[i] : a[i + 2]; a[i] = keep + dpp_ror<8>(send); }
    const unsigned x2p = *(const unsigned*)(X2B + (size_t)t * DM + coff + 2 * g8);
    *(float2*)(p.out + (size_t)t * DM + coff + 2 * g8) = make_float2(bflo(x2p) + a[0], bfhi(x2p) + a[1]);
  }
}

template <int WHICH>
DI void phase_peer_queue(const Params& p, int bid, int nblk, char* smem) {
  unsigned* ctr = (unsigned*)(p.ws + OFF_QCTR) + WHICH * NSL * 64;
  const unsigned x = xcc_id_() & 7u;
  const int lane = tid_() & 63;
  for (int rr = 0; rr < NSL; ++rr) {
    const int s = (int)((x + (unsigned)rr) & 7u);
    for (;;) {
      int item = 0;
      if (lane == 0) item = (int)atomicAdd(&ctr[s * 64], 1u);
      item = __builtin_amdgcn_readfirstlane(item);
      if (item >= T / 16) break;
      if (WHICH == 0 || WHICH == 2) peer_u_item(p, s, item * 16); else peer_v_item(p, s, item * 16);
    }
  }
}

DI void phase_peer_w(const Params& p, int bid, int nblk, char* smem) {
  char* ws = p.ws;
  const float* PART = (const float*)(ws + OFF_PART);
  const float* GATE = (const float*)(ws + OFF_GATE);
  float* WGT = (float*)(ws + OFF_WGT);
  for (size_t i = (size_t)bid * NTHR + threadIdx.x; i < (size_t)T * 128; i += (size_t)nblk * NTHR) {
    float sum = 0.f;
#pragma unroll
    for (int s = 0; s < NSL; ++s) sum += PART[(size_t)s * T * 128 + i];
    const float d = sum * (1.f / (SUI * SXI));
    { const float wv_ = GATE[i] * 0.5f * d * (1.f + erff(d * 0.70710678118654752f)); ((unsigned*)WGT)[i] = pack2h(wv_, wv_); }
  }
}

#define XB_TMO      128
#define XB_XCNT(j)  (256  + 64 * (j))
#define XB_XSUB(j)  (1280 + 64 * (j))
#define XB_XGEN(j)  (2304 + 64 * (j))
#define XB_TOP      3328
#define XB_TOPGEN   3392
#define XCD_BAR_WORDS 3456
#define XB_SPIN_CAP (1u << 20)
#define LAS __attribute__((address_space(3)))
DI unsigned xb_ld(unsigned* p) { return __hip_atomic_load(p, __ATOMIC_RELAXED, __HIP_MEMORY_SCOPE_AGENT); }
DI unsigned xb_add(unsigned* p, unsigned v) { return __hip_atomic_fetch_add(p, v, __ATOMIC_RELAXED, __HIP_MEMORY_SCOPE_AGENT); }
DI unsigned xb_xcc_id() { return (unsigned)__builtin_amdgcn_s_getreg((3 << 11) | 20) & 0xFu; }
#define XB_SPIN(cond, bar) do { unsigned _sp = 0; while (cond) { __builtin_amdgcn_s_sleep(1); \
    if ((++_sp & 255u) == 0u) { if (xb_ld(&(bar)[XB_TMO])) break; if (_sp > XB_SPIN_CAP) { atomicAdd(&(bar)[XB_TMO], 1u); break; } } } } while (0)
struct XcdBarrier { unsigned* bar; unsigned x; volatile LAS unsigned* st; };
DI XcdBarrier xcd_barrier_post(unsigned* bar, volatile LAS unsigned* st) {
  XcdBarrier b; b.bar = bar; b.x = xb_xcc_id(); b.st = st;
  if (threadIdx.x == 0) (void)xb_add(&bar[XB_XCNT(b.x)], 1u);
  return b;
}
DI void xcd_barrier_complete(unsigned* bar, unsigned x, unsigned& nloc, unsigned& nx) {
  const unsigned G = gridDim.x * gridDim.y * gridDim.z;
  unsigned sum, cnt, mine, sp = 0u;
  for (;;) {
    sum = 0u; cnt = 0u; mine = 0u;
#pragma unroll
    for (unsigned j = 0; j < 16; ++j) { const unsigned c = xb_ld(&bar[XB_XCNT(j)]); sum += c; cnt += (c > 0u) ? 1u : 0u; mine = (j == x) ? c : mine; }
    if (sum == G) break;
    __builtin_amdgcn_s_sleep(1);
    if ((++sp & 255u) == 0u) { if (xb_ld(&bar[XB_TMO])) break; if (sp > XB_SPIN_CAP) { atomicAdd(&bar[XB_TMO], 1u); break; } }
  }
  nloc = mine > 0u ? mine : 1u; nx = cnt > 0u ? cnt : 1u;
}
DI void xcd_barrier(const XcdBarrier& b) {
  asm volatile("s_waitcnt vmcnt(0)" ::: "memory");
  __syncthreads();
  if (threadIdx.x == 0) {
    unsigned* bar = b.bar;
    __builtin_amdgcn_s_waitcnt(0);
    unsigned nloc = b.st[0], nx = b.st[1];
    if (nloc == 0u) { xcd_barrier_complete(bar, b.x, nloc, nx); b.st[0] = nloc; b.st[1] = nx; }
    const unsigned old = xb_add(&bar[XB_XSUB(b.x)], 1u);
    const unsigned gen = old / nloc;
    if (old + 1u == (gen + 1u) * nloc) {
      __builtin_amdgcn_fence(__ATOMIC_RELEASE, "agent");
      asm volatile("s_waitcnt vmcnt(0)" ::: "memory");
      const unsigned og = xb_add(&bar[XB_TOP], 1u);
      const unsigned tg = og / nx;
      if (og + 1u == (tg + 1u) * nx) xb_add(&bar[XB_TOPGEN], 1u);
      else XB_SPIN(xb_ld(&bar[XB_TOPGEN]) == tg, bar);
      __builtin_amdgcn_fence(__ATOMIC_ACQUIRE, "agent");
      xb_add(&bar[XB_XGEN(b.x)], 1u);
      asm volatile("s_waitcnt vmcnt(0)" ::: "memory");
    } else {
      XB_SPIN(xb_ld(&bar[XB_XGEN(b.x)]) == gen, bar);
      __builtin_amdgcn_fence(__ATOMIC_ACQUIRE, "agent");
      asm volatile("s_waitcnt vmcnt(0)" ::: "memory");
    }
  }
  __syncthreads();
}

constexpr int NPHASE = 12;
template <int PH>
DI void run_phase(const Params& p, int bid, int nblk, char* smem) {
  if constexpr (PH == 0) phase_prep(p, bid, nblk, smem);
  else if constexpr (PH == 1) phase_gemm1(p, bid, nblk, smem);
  else if constexpr (PH == 2) phase_2a(p, bid, nblk, smem);
  else if constexpr (PH == 3) phase_2b(p, bid, nblk, smem);
  else if constexpr (PH == 4) { }
  else if constexpr (PH == 5) phase_mix(p, bid, nblk, smem);
  else if constexpr (PH == 6) { }
  else if constexpr (PH == 7) { }
  else if constexpr (PH == 8) phase_wo(p, bid, nblk, smem);
  else if constexpr (PH == 9) { }
  else if constexpr (PH == 10) phase_6(p, bid, nblk, smem);
  else if constexpr (PH == 11) { phase_7(p, bid, nblk, smem); }
  else if constexpr (PH == 12) phase_peer_queue<0>(p, bid, nblk, smem);
  else if constexpr (PH == 13) phase_peer_w(p, bid, nblk, smem);
  else phase_peer_queue<1>(p, bid, nblk, smem);
}

constexpr int SMEM_BYTES = 131072;

#if MEGA
__global__ void __launch_bounds__(NTHR, 2) mega_kernel(Params p) {
  extern __shared__ __attribute__((aligned(16))) char smem[];
  __shared__ uint4 xb_words;
  cg::grid_group grid = cg::this_grid();
  const int bid = blockIdx.x, nblk = gridDim.x;
  if (threadIdx.x == 0) xb_words = make_uint4(0u, 0u, 0u, 0u);
  __syncthreads();
  XcdBarrier xb = xcd_barrier_post((unsigned*)(p.ws + OFF_BAR), (volatile LAS unsigned*)&xb_words);
  run_phase<0>(p, bid, nblk, smem); xcd_barrier(xb);
  run_phase<1>(p, bid, nblk, smem); xcd_barrier(xb);
  run_phase<2>(p, bid, nblk, smem); xcd_barrier(xb);
  run_phase<3>(p, bid, nblk, smem); xcd_barrier(xb);
  run_phase<5>(p, bid, nblk, smem); xcd_barrier(xb);
  run_phase<8>(p, bid, nblk, smem); xcd_barrier(xb);
  run_phase<10>(p, bid, nblk, smem); xcd_barrier(xb);
  run_phase<11>(p, bid, nblk, smem); xcd_barrier(xb);
  run_phase<12>(p, bid, nblk, smem); xcd_barrier(xb);
  run_phase<13>(p, bid, nblk, smem); xcd_barrier(xb);
  run_phase<14>(p, bid, nblk, smem);
}
#else
template <int PH>
__global__ void __launch_bounds__(NTHR, 2) phase_kernel(Params p) {
  extern __shared__ __attribute__((aligned(16))) char smem[];
  run_phase<PH>(p, blockIdx.x, gridDim.x, smem);
}
template <int PH> static void launch_phase(const Params& p, hipStream_t stream) {
  (void)hipFuncSetAttribute((const void*)phase_kernel<PH>, hipFuncAttributeMaxDynamicSharedMemorySize, SMEM_BYTES);
  phase_kernel<PH><<<256, NTHR, SMEM_BYTES, stream>>>(p);
}
#endif

extern "C" void kernel_launch(void* const* d_in, const int* in_sizes, int n_in, void* d_out, int out_size, void* d_ws,
                              size_t ws_size, hipStream_t stream) {
  Params p{};
  p.x = (const float*)d_in[0]; p.pos = (const int*)d_in[1];
  p.g_mix = (const float*)d_in[2]; p.w_in = (const float*)d_in[3]; p.rwkv_mu = (const float*)d_in[4];
  p.g_cq = (const float*)d_in[5]; p.g_ckv = (const float*)d_in[6]; p.w_uq = (const float*)d_in[7];
  p.w_uk = (const float*)d_in[8]; p.w_uv = (const float*)d_in[9]; p.g_qnorm = (const float*)d_in[10];
  p.g_knorm = (const float*)d_in[11]; p.g_attn_out = (const float*)d_in[12]; p.w0 = (const float*)d_in[13];
  p.w2 = (const float*)d_in[14]; p.a0 = (const float*)d_in[15]; p.a2 = (const float*)d_in[16];
  p.g2 = (const float*)d_in[17]; p.k_k = (const float*)d_in[18]; p.k_a = (const float*)d_in[19];
  p.r_k = (const float*)d_in[20]; p.ln_x_w = (const float*)d_in[21]; p.ln_x_b = (const float*)d_in[22];
  p.w_o = (const float*)d_in[23]; p.g_ffn = (const float*)d_in[24]; p.w_pq = (const float*)d_in[25];
  p.sub_keys = (const float*)d_in[26]; p.expert_u = (const float*)d_in[27]; p.expert_v = (const float*)d_in[28];
  p.out = (float*)d_out; p.ws = (char*)d_ws;
#if MEGA
  static int grid_blocks = 0;
  if (!grid_blocks) {
    int dev = 0, cus = 0, per_cu = 0;
    (void)hipGetDevice(&dev);
    (void)hipDeviceGetAttribute(&cus, hipDeviceAttributeMultiprocessorCount, dev);
    (void)hipFuncSetAttribute((const void*)mega_kernel, hipFuncAttributeMaxDynamicSharedMemorySize, SMEM_BYTES);
    (void)hipOccupancyMaxActiveBlocksPerMultiprocessor(&per_cu, mega_kernel, NTHR, SMEM_BYTES);
    if (per_cu > 1) per_cu = 1;
    grid_blocks = cus * per_cu;
  }
  (void)hipMemsetAsync((char*)d_ws + OFF_BAR, 0, 32768, stream);
  void* args[] = {&p};
  hipError_t e = hipLaunchCooperativeKernel((void*)mega_kernel, dim3(grid_blocks), dim3(NTHR), args, SMEM_BYTES, stream);
  if (e != hipSuccess) fprintf(stderr, "cooperative launch failed: %s (grid %d)\n", hipGetErrorString(e), grid_blocks);
#else
  (void)hipMemsetAsync((char*)d_ws + OFF_BAR, 0, 32768, stream);
  launch_phase<0>(p, stream); launch_phase<1>(p, stream); launch_phase<2>(p, stream); launch_phase<3>(p, stream);
  launch_phase<5>(p, stream);
  launch_phase<8>(p, stream); launch_phase<10>(p, stream); launch_phase<11>(p, stream);
  launch_phase<12>(p, stream); launch_phase<13>(p, stream); launch_phase<14>(p, stream);
#endif
}
```
